# Optimizing an MI355X kernel written in HIP

```python
import jax, jax.numpy as jnp
from jax import lax
import numpy as np

D_MODEL = 1024
BATCH = 16
SEQ = 2048
DEPTH = 4

N_META = 16
N_MIXERS = 3
BLOCK = 128
PAD = BLOCK - N_META
EPS = 1e-6

RET_HEADS = 8
RET_DK = D_MODEL // RET_HEADS
RET_DV = 2 * D_MODEL // RET_HEADS
ROPE_BASE = 10000.0

SB_HEADS = 16
SB_HD = D_MODEL // SB_HEADS

POOL_WINDOWS = (2, 4, 8, 16)
POOL_GROUPS = 4
POOL_GD = D_MODEL // POOL_GROUPS

FFN_DIM = 2816
N_EXPERTS = 8
TOP_K = 2

N_RET = (DEPTH + 2) // 3
N_SB = (DEPTH + 1) // 3
N_POOL = DEPTH // 3
N_DENSE = (DEPTH + 1) // 2
N_MOE = DEPTH // 2

kernel_name = "hybrid_retention_stickbreak_pool_moe"


def _rmsnorm(x, g):
    xf = x.astype(jnp.float32)
    y = xf * lax.rsqrt(jnp.mean(jnp.square(xf), axis=-1, keepdims=True) + EPS) * g.astype(jnp.float32)
    return y.astype(x.dtype)


def _rotary(x, pos):
    half = x.shape[-1] // 2
    inv = ROPE_BASE ** (-jnp.arange(half, dtype=jnp.float32) / half)
    ang = pos.astype(jnp.float32)[:, None] * inv[None, :]
    cos = jnp.cos(ang)[None, :, None, :]
    sin = jnp.sin(ang)[None, :, None, :]
    x1, x2 = x[..., :half], x[..., half:]
    return jnp.concatenate([x1 * cos - x2 * sin, x1 * sin + x2 * cos], axis=-1)


def _retention(a, w_q, w_k, w_v, w_g, w_o, gn_g):
    f32 = jnp.float32
    B, L, _ = a.shape
    pos = jnp.arange(L)
    q = _rotary((a @ w_q).astype(f32).reshape(B, L, RET_HEADS, RET_DK), pos)
    k = _rotary((a @ w_k).astype(f32).reshape(B, L, RET_HEADS, RET_DK), pos) * (RET_DK ** -0.5)
    v = (a @ w_v).astype(f32).reshape(B, L, RET_HEADS, RET_DV)
    pad = ((0, 0), (PAD, 0), (0, 0), (0, 0))
    n = (L + PAD) // BLOCK
    qc = jnp.pad(q, pad).reshape(B, n, BLOCK, RET_HEADS, RET_DK)
    kc = jnp.pad(k, pad).reshape(B, n, BLOCK, RET_HEADS, RET_DK)
    vc = jnp.pad(v, pad).reshape(B, n, BLOCK, RET_HEADS, RET_DV)

    log_g = jnp.log1p(-jnp.exp2(-5.0 - jnp.arange(RET_HEADS, dtype=f32)))
    idx = jnp.arange(BLOCK, dtype=f32)
    diff = idx[:, None] - idx[None, :]
    decay = jnp.where(diff >= 0, jnp.exp(jnp.maximum(diff, 0.0)[None] * log_g[:, None, None]), 0.0)

    scores = jnp.einsum('bnchd,bnshd->bnhcs', qc, kc) * decay
    intra = jnp.einsum('bnhcs,bnshe->bnche', scores, vc)

    zeta = jnp.exp((BLOCK - 1 - idx)[:, None] * log_g[None, :])
    kv = jnp.einsum('bnshd,bnshe->bnhde', kc * zeta[None, None, :, :, None], vc)
    xi = jnp.exp((idx + 1)[:, None] * log_g[None, :])
    chunk_decay = jnp.exp(BLOCK * log_g)[None, :, None, None]

    def step(state, inp):
        q_i, kv_i = inp
        out = jnp.einsum('bchd,bhde->bche', q_i, state) * xi[None, :, :, None]
        return state * chunk_decay + kv_i, out

    state0 = jnp.zeros((B, RET_HEADS, RET_DK, RET_DV), f32)
    _, cross = lax.scan(step, state0, (jnp.moveaxis(qc, 1, 0), jnp.moveaxis(kv, 1, 0)))
    y = intra + jnp.moveaxis(cross, 0, 1)
    y = y.reshape(B, n * BLOCK, RET_HEADS, RET_DV)[:, PAD:]

    mu = jnp.mean(y, axis=-1, keepdims=True)
    var = jnp.mean(jnp.square(y - mu), axis=-1, keepdims=True)
    y = ((y - mu) * lax.rsqrt(var + EPS)).reshape(B, L, RET_HEADS * RET_DV) * gn_g.astype(f32)
    gate = jax.nn.silu((a @ w_g).astype(f32))
    return (gate * y).astype(a.dtype) @ w_o


def _stick_breaking(a, w_qkv, w_o):
    f32 = jnp.float32
    B, L, _ = a.shape
    qkv = (a @ w_qkv).astype(f32)
    q, k, v = jnp.split(qkv, 3, axis=-1)
    pad = ((0, 0), (PAD, 0), (0, 0), (0, 0))
    q = jnp.pad(q.reshape(B, L, SB_HEADS, SB_HD), pad)
    k = jnp.pad(k.reshape(B, L, SB_HEADS, SB_HD), pad)
    v = jnp.pad(v.reshape(B, L, SB_HEADS, SB_HD), pad)
    Lp = L + PAD
    n = Lp // BLOCK
    q_blocks = jnp.moveaxis(q.reshape(B, n, BLOCK, SB_HEADS, SB_HD), 1, 0)
    key_pos = jnp.arange(Lp)
    key_valid = key_pos >= PAD
    scale = SB_HD ** -0.5

    def block(args):
        qb, i = args
        qpos = i * BLOCK + jnp.arange(BLOCK)
        z = jnp.einsum('bchd,bshd->bhcs', qb, k) * scale
        mask = ((key_pos[None, :] < qpos[:, None]) & key_valid[None, :])[None, None]
        log_beta = jax.nn.log_sigmoid(z)
        log_1m = jnp.where(mask, jax.nn.log_sigmoid(-z), 0.0)
        suffix = lax.cumsum(log_1m, axis=3, reverse=True) - log_1m
        w = jnp.where(mask, jnp.exp(log_beta + suffix), 0.0)
        return jnp.einsum('bhcs,bshd->bchd', w, v)

    out = lax.map(block, (q_blocks, jnp.arange(n)))
    out = jnp.moveaxis(out, 0, 1).reshape(B, Lp, D_MODEL)[:, PAD:]
    return out.astype(a.dtype) @ w_o


def _pool_mixer(a, w_pool, scale):
    f32 = jnp.float32
    B, L, _ = a.shape
    af = a.astype(f32)
    cs = jnp.pad(jnp.cumsum(af, axis=1), ((0, 0), (1, 0), (0, 0)))
    t = jnp.arange(L)
    outs = []
    for g, w in enumerate(POOL_WINDOWS):
        sl = slice(g * POOL_GD, (g + 1) * POOL_GD)
        cs_g = cs[..., sl]
        lo = jnp.maximum(t + 1 - w, 0)
        cnt = (t + 1 - lo).astype(f32)
        mean = (cs_g[:, 1:] - cs_g[:, lo]) / cnt[None, :, None]
        outs.append((mean - af[..., sl]) @ w_pool[g].astype(f32))
    y = jnp.concatenate(outs, axis=-1) * scale.astype(f32)
    return y.astype(a.dtype)


def _swiglu(a, w1, w3, w2):
    return (jax.nn.silu(a @ w1) * (a @ w3)) @ w2


def _moe(a, w_router, w1, w3, w2):
    logits = (a @ w_router).astype(jnp.float32)
    top_v, top_i = lax.top_k(logits, TOP_K)
    gates = jax.nn.softmax(top_v, axis=-1)
    combine = jnp.sum(jax.nn.one_hot(top_i, N_EXPERTS, dtype=jnp.float32) * gates[..., None], axis=-2)
    out = jnp.zeros(a.shape, jnp.float32)
    for e in range(N_EXPERTS):
        out = out + combine[..., e:e + 1] * _swiglu(a, w1[e], w3[e], w2[e]).astype(jnp.float32)
    return out.astype(a.dtype)


def setup_inputs(seed: int = 0) -> dict:
    key = jax.random.key(seed)
    ks = jax.random.split(key, 24)
    f32 = jnp.float32

    def nrm(k, shape, fan_in):
        return jax.random.normal(k, shape, f32) * (fan_in ** -0.5)

    def gain(k, shape):
        return 1.0 + 0.02 * jax.random.normal(k, shape, f32)

    D = D_MODEL
    return {
        "x": jax.random.normal(ks[0], (BATCH, SEQ, D), f32),
        "meta_tokens": jax.random.normal(ks[1], (N_META, D), f32),
        "norm_mix_g": gain(ks[2], (DEPTH, D)),
        "norm_ffn_g": gain(ks[3], (DEPTH, D)),
        "ret_wq": nrm(ks[4], (N_RET, D, D), D),
        "ret_wk": nrm(ks[5], (N_RET, D, D), D),
        "ret_wv": nrm(ks[6], (N_RET, D, 2 * D), D),
        "ret_wg": nrm(ks[7], (N_RET, D, 2 * D), D),
        "ret_wo": nrm(ks[8], (N_RET, 2 * D, D), 2 * D),
        "ret_gn_g": gain(ks[9], (N_RET, 2 * D)),
        "sb_wqkv": nrm(ks[10], (N_SB, D, 3 * D), D),
        "sb_wo": nrm(ks[11], (N_SB, D, D), D),
        "pool_w": nrm(ks[12], (N_POOL, POOL_GROUPS, POOL_GD, POOL_GD), POOL_GD),
        "pool_scale": 1.0 + 0.1 * jax.random.normal(ks[13], (N_POOL, D), f32),
        "ffn_w1": nrm(ks[14], (N_DENSE, D, FFN_DIM), D),
        "ffn_w3": nrm(ks[15], (N_DENSE, D, FFN_DIM), D),
        "ffn_w2": nrm(ks[16], (N_DENSE, FFN_DIM, D), FFN_DIM),
        "moe_router": nrm(ks[17], (N_MOE, D, N_EXPERTS), D),
        "moe_w1": nrm(ks[18], (N_MOE, N_EXPERTS, D, FFN_DIM), D),
        "moe_w3": nrm(ks[19], (N_MOE, N_EXPERTS, D, FFN_DIM), D),
        "moe_w2": nrm(ks[20], (N_MOE, N_EXPERTS, FFN_DIM, D), FFN_DIM),
        "final_norm_g": gain(ks[21], (D,)),
    }


def reference(x, meta_tokens, norm_mix_g, norm_ffn_g, ret_wq, ret_wk, ret_wv, ret_wg, ret_wo, ret_gn_g,
              sb_wqkv, sb_wo, pool_w, pool_scale, ffn_w1, ffn_w3, ffn_w2,
              moe_router, moe_w1, moe_w3, moe_w2, final_norm_g):
    B = x.shape[0]
    meta = jnp.broadcast_to(meta_tokens.astype(x.dtype)[None], (B, N_META, D_MODEL))
    h = jnp.concatenate([meta, x], axis=1)
    for i in range(DEPTH):
        m = i % N_MIXERS
        j = i // N_MIXERS
        a = _rmsnorm(h, norm_mix_g[i])
        if m == 0:
            y = _retention(a, ret_wq[j], ret_wk[j], ret_wv[j], ret_wg[j], ret_wo[j], ret_gn_g[j])
        elif m == 1:
            y = _stick_breaking(a, sb_wqkv[j], sb_wo[j])
        else:
            y = _pool_mixer(a, pool_w[j], pool_scale[j])
        h = h + y
        a = _rmsnorm(h, norm_ffn_g[i])
        c = i // 2
        if i % 2 == 0:
            y = _swiglu(a, ffn_w1[c], ffn_w3[c], ffn_w2[c])
        else:
            y = _moe(a, moe_router[c], moe_w1[c], moe_w3[c], moe_w2[c])
        h = h + y
    h = _rmsnorm(h, final_norm_g)
    return h[:, N_META:]
```

```cpp
#include <hip/hip_runtime.h>
#include <cstdio>
#include <cstdint>

#ifndef MK_PER_PHASE
#define MK_PER_PHASE 0
#endif
#ifndef NAIVE_RET
#define NAIVE_RET 1
#endif
#ifndef NAIVE_SB
#define NAIVE_SB 1
#endif

#define GAS __attribute__((address_space(1)))
#define LAS __attribute__((address_space(3)))
typedef unsigned short bf16_t;
typedef short bf16x8 __attribute__((ext_vector_type(8)));
typedef float f32x4 __attribute__((ext_vector_type(4)));
typedef float f32x2 __attribute__((ext_vector_type(2)));
typedef unsigned u32x4 __attribute__((ext_vector_type(4)));
typedef unsigned u32x2 __attribute__((ext_vector_type(2)));

constexpr int D = 1024, NBATCH = 16, SEQ = 2048, NMETA = 16;
constexpr int MREAL = NBATCH * SEQ;
constexpr int MVALID = MREAL + NMETA;
constexpr int MROWS = 33024;
constexpr int FF = 2816, NE = 8;
constexpr int LPOS = SEQ + NMETA;
constexpr float EPS = 1e-6f;
constexpr int MOE_ROWS = 67840;

constexpr size_t MiB = 1u << 20;
constexpr size_t WS_CTL = 0, CTL_BYTES = 1 * MiB;
constexpr int CW_BAR = 4096;
constexpr size_t CTL_MOE = 512 * 1024;
constexpr size_t WS_SSQ = 1 * MiB;
constexpr size_t WS_GST = 20 * MiB;
constexpr size_t WS_WA = 29 * MiB, WS_WB = 185 * MiB, WS_H = 221 * MiB, WS_TAB = 289 * MiB, WS_MISC = 291 * MiB, WS_POOL = 297 * MiB, WS_END = 795 * MiB;
static_assert(WS_SSQ + (size_t)9 * MROWS * 64 <= WS_GST && WS_GST + (size_t)MROWS * 8 * 8 * 4 <= WS_WA, "ssq/gst");
constexpr size_t WA_MOE13 = 0, WA_MOE2 = (size_t)NE * 5632 * 1024, WA_MIX = WA_MOE2 + (size_t)NE * 1024 * 2816;
constexpr size_t WA_MIX_WO_SB = WA_MIX + (size_t)3072 * 1024, WA_MIX_WO_RET = WA_MIX + (size_t)6144 * 1024;
constexpr size_t WB_MIX = 0, WB_WO = (size_t)6144 * 1024, WB_W13 = WB_WO + (size_t)1024 * 2048, WB_W2 = WB_W13 + (size_t)5632 * 1024;
static_assert((WA_MIX + 8388608) * 2 <= 156 * MiB && (WB_W2 + (size_t)1024 * 2816) * 2 <= 36 * MiB, "weight regions");
constexpr size_t MISC_TOKE = 0, MISC_TOKG = 512 * 1024, MISC_TOKR = 1024 * 1024, MISC_TOKP = 1536 * 1024, MISC_RSTDS = 2 * MiB, MISC_GATES = 2 * MiB + 512 * 1024, MISC_YM = 3 * MiB;
constexpr size_t ACT1 = (size_t)MROWS * 1024 * 2;
constexpr size_t PO_Q = 0, PO_K = ACT1, PO_V = 2 * ACT1, PO_G = 4 * ACT1;
constexpr size_t PO_HID = 0, PO_D = 0;
constexpr size_t PO_XS = 0, PO_MHID = 133 * MiB;
static_assert(PO_G + 2 * ACT1 <= 498 * MiB && PO_MHID + (size_t)MOE_ROWS * FF * 2 <= 498 * MiB && (size_t)MOE_ROWS * 2048 <= 133 * MiB, "pool");

constexpr int RING_BYTES = 131072;
constexpr int LDSCTL_OFF = RING_BYTES;
constexpr int LDS_PEXP = LDSCTL_OFF + 256;
constexpr int LDS_BYTES = 147456;

__device__ __forceinline__ unsigned f2bf(float f) { unsigned u = __builtin_bit_cast(unsigned, f); return (u + 0x7fffu + ((u >> 16) & 1u)) >> 16; }
__device__ __forceinline__ unsigned pk2(float lo, float hi) { unsigned r; asm volatile("v_cvt_pk_bf16_f32 %0, %1, %2" : "=v"(r) : "v"(lo), "v"(hi)); return r; }
__device__ __forceinline__ float bflo(unsigned u) { return __builtin_bit_cast(float, u << 16); }
__device__ __forceinline__ float bfhi(unsigned u) { return __builtin_bit_cast(float, u & 0xffff0000u); }
__device__ __forceinline__ float bf1(bf16_t u) { return __builtin_bit_cast(float, ((unsigned)u) << 16); }
__device__ __forceinline__ float fast_rcp(float x) { return __builtin_amdgcn_rcpf(x); }
__device__ __forceinline__ float fast_exp2(float x) { return __builtin_amdgcn_exp2f(x); }
__device__ __forceinline__ float silu_f(float v) { return v * fast_rcp(1.0f + fast_exp2(-1.4426950408889634f * v)); }
__device__ __forceinline__ float wave_sum(float v) {
#pragma unroll
    for (int o = 1; o < 64; o <<= 1) v += __shfl_xor(v, o);
    return v;
}
__device__ __forceinline__ int row_pos(int row) { return row < MREAL ? NMETA + (row & (SEQ - 1)) : (row - MREAL < NMETA ? row - MREAL : NMETA - 1); }
__device__ __forceinline__ int pos_row(int b, int p) { return p < NMETA ? MREAL + p : b * SEQ + p - NMETA; }
#define LDS_WAIT() asm volatile("s_waitcnt lgkmcnt(0)" ::: "memory")

namespace pg8 {
constexpr int BM = 256, BK = 64, HALF = 128, HTB = HALF * BK * 2, NXCD = 8, WGM = 8;
__host__ __device__ __forceinline__ int lds_byte(int r, int c) { const int st = (r >> 4) * 2 + (c >> 5), rr = r & 15, cc = c & 31, ob = rr * 64 + cc * 2; return st * 1024 + (ob ^ (((ob >> 9) & 1) << 5)); }
__host__ __device__ __forceinline__ void stage_rc(int b, int& R, int& C) { const int st = b / 1024, sb = b % 1024, swz = sb ^ (((sb >> 9) & 1) << 5); R = (st >> 1) * 16 + swz / 64; C = (st & 1) * 32 + (swz % 64) / 2; }
__host__ __device__ __forceinline__ int perm32(int rho) { const int n = rho >> 4, i = rho & 15; return 8 * (i >> 2) + 4 * n + (i & 3); }
struct Unit { int pm, pn; };

template <bool MOE> struct Sched {
    int nM, nN, nwg, G, c; const char* A; const char* Bt; size_t a_pm, a_pn, b_pn, b_e; const LAS int* pexp;
    __device__ __forceinline__ bool next(int i, Unit& u) const {
        const long L = (long)i * G + c; if (L >= nwg) return false;
        int wgid = (int)L; { const int q = nwg / NXCD, r = nwg % NXCD, xcd = wgid % NXCD, off = wgid / NXCD; wgid = (xcd < r ? xcd * (q + 1) : r * (q + 1) + (xcd - r) * q) + off; }
        const int nig = WGM * nN, gid = wgid / nig, fm = gid * WGM, gsz = (nM - fm) < WGM ? (nM - fm) : WGM;
        u.pm = fm + ((wgid % nig) % gsz); u.pn = (wgid % nig) / gsz; return true;
    }
    __device__ __forceinline__ const char* aptr(const Unit& u) const { return A + (size_t)u.pm * a_pm + (size_t)u.pn * a_pn; }
    __device__ __forceinline__ const char* bptr(const Unit& u) const { const char* b = Bt + (size_t)u.pn * b_pn; if constexpr (MOE) b += (size_t)pexp[u.pm] * b_e; return b; }
};

template <class Epi, class SchedT>
__device__ __forceinline__ void gemm_phase(LAS unsigned char* lds, const int K, const int lda, const SchedT& S, const Epi& E) {
    const int tid = threadIdx.x, wid = __builtin_amdgcn_readfirstlane(tid >> 6), lane = tid & 63, wr = wid >> 2, wc = wid & 3, fr = lane & 15, fq = lane >> 4;
    const int nt = K / BK;
    unsigned voffA[2], voffB[2];
#pragma unroll
    for (int i = 0; i < 2; ++i) { int R, C; stage_rc(tid * 16 + i * 8192, R, C); const int Rb = (R & ~31) + perm32(R & 31);
        voffA[i] = (unsigned)(R * lda + C) * 2u; voffB[i] = (unsigned)(Rb * K + C) * 2u; }
    const size_t kstep = (size_t)(BK * 2);
    const size_t hstepA = (size_t)HALF * lda * 2, hstepB = (size_t)HALF * K * 2;
    const unsigned ldsw = (unsigned)wid * 1024u;
    const int aoff = lds_byte(wr * 64 + fr, fq * 8), boff = lds_byte(wc * 32 + fr, fq * 8);
#define PG8_SA(b, h) (((b) * 2 + (h)) * HTB)
#define PG8_SB(b, h) ((4 + (b) * 2 + (h)) * HTB)
#define PG8_STAGE(bufoff, gbase, voff) do { _Pragma("unroll") for (int _i = 0; _i < 2; ++_i) \
        __builtin_amdgcn_global_load_lds((const unsigned*)((const char*)(gbase) + (voff)[_i]), (LAS unsigned*)(lds + (bufoff) + ldsw + _i * 8192), 16, 0, 0); } while (0)
#define PG8_LDA(dst, b, h) do { _Pragma("unroll") for (int m = 0; m < 4; ++m) _Pragma("unroll") for (int k = 0; k < 2; ++k) dst[m][k] = *(const LAS bf16x8*)(lds + PG8_SA(b, h) + aoff + m * 2048 + k * 1024); } while (0)
#define PG8_LDB(dst, b, h) do { _Pragma("unroll") for (int n = 0; n < 2; ++n) _Pragma("unroll") for (int k = 0; k < 2; ++k) dst[n][k] = *(const LAS bf16x8*)(lds + PG8_SB(b, h) + boff + n * 2048 + k * 1024); } while (0)
#define PG8_MMA(ai, bj, At, Bt) do { __builtin_amdgcn_s_setprio(1); _Pragma("unroll") for (int m = 0; m < 4; ++m) _Pragma("unroll") for (int n = 0; n < 2; ++n) _Pragma("unroll") for (int k = 0; k < 2; ++k) \
        acc[ai][bj][m][n] = __builtin_amdgcn_mfma_f32_16x16x32_bf16(Bt[n][k], At[m][k], acc[ai][bj][m][n], 0, 0, 0); __builtin_amdgcn_s_setprio(0); } while (0)
#define PG8_WAIT_V(n) asm volatile("s_waitcnt vmcnt(" #n ")" ::: "memory")
#define PG8_WAIT_L(n) asm volatile("s_waitcnt lgkmcnt(" #n ")" ::: "memory")
#define PG8_BAR __builtin_amdgcn_s_barrier()
#define PG8_SCHED __builtin_amdgcn_sched_barrier(0)
    Unit cur, nxt; int ui = 0;
    if (!S.next(0, cur)) return;
    f32x4 acc[2][2][4][2];
#pragma unroll
    for (int a = 0; a < 2; ++a)
#pragma unroll
        for (int b = 0; b < 2; ++b)
#pragma unroll
            for (int m = 0; m < 4; ++m)
#pragma unroll
                for (int n = 0; n < 2; ++n) acc[a][b][m][n] = (f32x4){0.f, 0.f, 0.f, 0.f};
    bf16x8 At[4][2], B0[2][2], B1[2][2];
    const char* cA = S.aptr(cur); const char* cB = S.bptr(cur);
    PG8_STAGE(PG8_SB(0, 0), cB, voffB); PG8_STAGE(PG8_SB(0, 1), cB + hstepB, voffB); PG8_STAGE(PG8_SA(0, 0), cA, voffA); PG8_STAGE(PG8_SA(0, 1), cA + hstepA, voffA);
    if (wr == 1) PG8_BAR;
    PG8_WAIT_V(2); PG8_BAR;
    PG8_STAGE(PG8_SB(1, 0), cB + kstep, voffB); PG8_STAGE(PG8_SA(1, 0), cA + kstep, voffA); PG8_STAGE(PG8_SB(1, 1), cB + hstepB + kstep, voffB);
    PG8_WAIT_V(6); PG8_BAR;
    for (;;) {
        const bool has_next = S.next(ui + 1, nxt);
        const char* nA = has_next ? S.aptr(nxt) : cA; const char* nB = has_next ? S.bptr(nxt) : cB;
        for (int t = 0; t < nt; t += 2) {
            const bool last = (t == nt - 2);
            const char* a1 = cA + (size_t)(t + 1) * kstep;
            const char* a2 = last ? nA : cA + (size_t)(t + 2) * kstep; const char* b2 = last ? nB : cB + (size_t)(t + 2) * kstep;
            const char* a3 = a2 + kstep; const char* b3 = b2 + kstep;
            PG8_LDB(B0, 0, 0); PG8_LDB(B1, 0, 1); PG8_SCHED; PG8_LDA(At, 0, 0); PG8_STAGE(PG8_SA(1, 1), a1 + hstepA, voffA);
            PG8_WAIT_V(8); PG8_WAIT_L(0); PG8_BAR; PG8_MMA(0, 0, At, B0); PG8_MMA(0, 1, At, B1); PG8_BAR; PG8_SCHED;
            PG8_LDA(At, 0, 1); PG8_STAGE(PG8_SB(0, 0), b2, voffB); PG8_STAGE(PG8_SB(0, 1), b2 + hstepB, voffB); PG8_STAGE(PG8_SA(0, 0), a2, voffA);
            PG8_WAIT_V(8); PG8_WAIT_L(0); PG8_BAR; PG8_MMA(1, 0, At, B0); PG8_MMA(1, 1, At, B1); PG8_BAR; PG8_SCHED;
            PG8_LDB(B0, 1, 0); PG8_LDB(B1, 1, 1); PG8_SCHED; PG8_LDA(At, 1, 0); PG8_STAGE(PG8_SA(0, 1), a2 + hstepA, voffA);
            PG8_WAIT_V(8); PG8_WAIT_L(0); PG8_BAR; PG8_MMA(0, 0, At, B0); PG8_MMA(0, 1, At, B1); PG8_BAR; PG8_SCHED;
            PG8_LDA(At, 1, 1); PG8_STAGE(PG8_SB(1, 0), b3, voffB); PG8_STAGE(PG8_SB(1, 1), b3 + hstepB, voffB); PG8_STAGE(PG8_SA(1, 0), a3, voffA);
            PG8_WAIT_V(8); PG8_WAIT_L(0); PG8_BAR; PG8_MMA(1, 0, At, B0); PG8_MMA(1, 1, At, B1); PG8_BAR; PG8_SCHED;
        }
        if (wr == 0) PG8_BAR;
        E(acc, cur, wr, wc, fr, fq);
        if (!has_next) break;
#pragma unroll
        for (int a = 0; a < 2; ++a)
#pragma unroll
            for (int b = 0; b < 2; ++b)
#pragma unroll
                for (int m = 0; m < 4; ++m)
#pragma unroll
                    for (int n = 0; n < 2; ++n) acc[a][b][m][n] = (f32x4){0.f, 0.f, 0.f, 0.f};
        cur = nxt; cA = nA; cB = nB; ++ui;
        if (wr == 1) PG8_BAR;
    }
    PG8_WAIT_V(0);
    PG8_BAR;
#undef PG8_SA
#undef PG8_SB
#undef PG8_STAGE
#undef PG8_LDA
#undef PG8_LDB
#undef PG8_MMA
#undef PG8_WAIT_V
#undef PG8_WAIT_L
#undef PG8_BAR
#undef PG8_SCHED
}

typedef f32x4 Acc[2][2][4][2];
__device__ __forceinline__ float rstd_of(const float* ssqp, int row) {
    const f32x4* p = (const f32x4*)(ssqp + (size_t)row * 16); const f32x4 a = p[0], b = p[1], c = p[2], d = p[3];
    const float s = ((a[0] + a[1]) + (a[2] + a[3])) + ((b[0] + b[1]) + (b[2] + b[3])) + ((c[0] + c[1]) + (c[2] + c[3])) + ((d[0] + d[1]) + (d[2] + d[3]));
    return __builtin_amdgcn_rsqf(s * (1.0f / D) + EPS); }
__device__ __forceinline__ void ssq_store_single(float* ssqp, int row, float ss, int lane) { if (lane < 16) ssqp[(size_t)row * 16 + lane] = (lane == 0) ? ss : 0.f; }

template <int MODE> struct EpiProj {
    const float* ssq; const f32x2* tab; bf16_t* Q; bf16_t* Kk; bf16_t* V; bf16_t* Gt;
    __device__ __forceinline__ void operator()(const Acc& acc, const Unit& u, int wr, int wc, int fr, int fq) const {
        const int row0 = u.pm * BM + wr * 64 + fr; const int pn = u.pn;
        int seg, colt, ld; bf16_t* base;
        if (MODE == 0) { if (pn < 4) { seg = 0; colt = pn * 256; ld = 1024; base = Q; } else if (pn < 8) { seg = 1; colt = (pn - 4) * 256; ld = 1024; base = Kk; }
                         else if (pn < 16) { seg = 2; colt = (pn - 8) * 256; ld = 2048; base = V; } else { seg = 3; colt = (pn - 16) * 256; ld = 2048; base = Gt; } }
        else { ld = 1024; if (pn < 4) { seg = 2; colt = pn * 256; base = Q; } else if (pn < 8) { seg = 2; colt = (pn - 4) * 256; base = Kk; } else { seg = 2; colt = (pn - 8) * 256; base = V; } }
        const int col0 = colt + wc * 32 + 8 * fq;
#pragma unroll
        for (int ai = 0; ai < 2; ++ai)
#pragma unroll
            for (int m = 0; m < 4; ++m) {
                const int row = row0 + ai * HALF + m * 16;
                const float rs = rstd_of(ssq, row);
                const int p = row_pos(row);
#pragma unroll
                for (int bj = 0; bj < 2; ++bj) {
                    f32x4 v0 = acc[ai][bj][m][0] * rs, v1 = acc[ai][bj][m][1] * rs;
                    const int col = col0 + bj * HALF;
                    if (MODE == 0 && seg < 2) {
                        const int i0 = (col & 127) >> 1;
                        const f32x4 t0 = *(const f32x4*)(tab + p * 64 + i0), t1 = *(const f32x4*)(tab + p * 64 + i0 + 2);
                        f32x4 o0, o1;
                        o0[0] = v0[0] * t0[0] - v0[1] * t0[1]; o0[1] = v0[0] * t0[1] + v0[1] * t0[0];
                        o0[2] = v0[2] * t0[2] - v0[3] * t0[3]; o0[3] = v0[2] * t0[3] + v0[3] * t0[2];
                        o1[0] = v1[0] * t1[0] - v1[1] * t1[1]; o1[1] = v1[0] * t1[1] + v1[1] * t1[0];
                        o1[2] = v1[2] * t1[2] - v1[3] * t1[3]; o1[3] = v1[2] * t1[3] + v1[3] * t1[2];
                        const float ks = (seg == 1) ? 0.08838834764831845f : 1.0f;
                        v0 = o0 * ks; v1 = o1 * ks;
                    }
                    if (MODE == 0 && seg == 3) {
#pragma unroll
                        for (int j = 0; j < 4; ++j) { v0[j] = silu_f(v0[j]); v1[j] = silu_f(v1[j]); }
                    }
                    u32x4 w; w.x = pk2(v0[0], v0[1]); w.y = pk2(v0[2], v0[3]); w.z = pk2(v1[0], v1[1]); w.w = pk2(v1[2], v1[3]);
                    *(u32x4*)(base + (size_t)row * ld + col) = w;
                }
            }
    }
};
struct EpiResid {
    bf16_t* H; float* ssq_out; const float* colscale;
    __device__ __forceinline__ void operator()(const Acc& acc, const Unit& u, int wr, int wc, int fr, int fq) const {
        const int row0 = u.pm * BM + wr * 64 + fr; const int col0 = u.pn * BM + wc * 32 + 8 * fq;
        f32x4 cs[2][2];
#pragma unroll
        for (int bj = 0; bj < 2; ++bj)
#pragma unroll
            for (int n = 0; n < 2; ++n) cs[bj][n] = colscale ? *(const f32x4*)(colscale + col0 + bj * HALF + 4 * n) : (f32x4){1.f, 1.f, 1.f, 1.f};
#pragma unroll
        for (int ai = 0; ai < 2; ++ai)
#pragma unroll
            for (int m = 0; m < 4; ++m) {
                const int row = row0 + ai * HALF + m * 16; float ss = 0.f;
#pragma unroll
                for (int bj = 0; bj < 2; ++bj) {
                    bf16_t* hp = H + (size_t)row * D + col0 + bj * HALF;
                    const u32x4 hv = *(const u32x4*)hp;
                    const f32x4 a0 = acc[ai][bj][m][0] * cs[bj][0], a1 = acc[ai][bj][m][1] * cs[bj][1];
                    u32x4 w;
                    w.x = pk2(bflo(hv.x) + a0[0], bfhi(hv.x) + a0[1]); w.y = pk2(bflo(hv.y) + a0[2], bfhi(hv.y) + a0[3]);
                    w.z = pk2(bflo(hv.z) + a1[0], bfhi(hv.z) + a1[1]); w.w = pk2(bflo(hv.w) + a1[2], bfhi(hv.w) + a1[3]);
                    *(u32x4*)hp = w;
                    ss += bflo(w.x) * bflo(w.x) + bfhi(w.x) * bfhi(w.x) + bflo(w.y) * bflo(w.y) + bfhi(w.y) * bfhi(w.y)
                        + bflo(w.z) * bflo(w.z) + bfhi(w.z) * bfhi(w.z) + bflo(w.w) * bflo(w.w) + bfhi(w.w) * bfhi(w.w);
                }
                ss += __shfl_xor(ss, 16); ss += __shfl_xor(ss, 32);
                if (fq == 0) ssq_out[(size_t)row * 16 + u.pn * 4 + wc] = ss;
            }
    }
};
template <bool ROWRSTD> struct EpiSwiglu {
    const float* rsrc; bf16_t* HID;
    __device__ __forceinline__ void operator()(const Acc& acc, const Unit& u, int wr, int wc, int fr, int fq) const {
        const int row0 = u.pm * BM + wr * 64 + fr; const int col0 = u.pn * HALF + wc * 32 + 8 * fq;
#pragma unroll
        for (int ai = 0; ai < 2; ++ai)
#pragma unroll
            for (int m = 0; m < 4; ++m) {
                const int row = row0 + ai * HALF + m * 16;
                const float rs = ROWRSTD ? rsrc[row] : rstd_of(rsrc, row);
                float o[8];
#pragma unroll
                for (int n = 0; n < 2; ++n)
#pragma unroll
                    for (int j = 0; j < 4; ++j) { const float uu = acc[ai][0][m][n][j] * rs, vv = acc[ai][1][m][n][j] * rs; o[4 * n + j] = silu_f(uu) * vv; }
                u32x4 w; w.x = pk2(o[0], o[1]); w.y = pk2(o[2], o[3]); w.z = pk2(o[4], o[5]); w.w = pk2(o[6], o[7]);
                *(u32x4*)(HID + (size_t)row * FF + col0) = w;
            }
    }
};
struct EpiMoeW2 {
    const float* gate; bf16_t* YS;
    __device__ __forceinline__ void operator()(const Acc& acc, const Unit& u, int wr, int wc, int fr, int fq) const {
        const int row0 = u.pm * BM + wr * 64 + fr; const int col0 = u.pn * BM + wc * 32 + 8 * fq;
#pragma unroll
        for (int ai = 0; ai < 2; ++ai)
#pragma unroll
            for (int m = 0; m < 4; ++m) {
                const int row = row0 + ai * HALF + m * 16; const float g = gate[row];
#pragma unroll
                for (int bj = 0; bj < 2; ++bj) {
                    const f32x4 v0 = acc[ai][bj][m][0] * g, v1 = acc[ai][bj][m][1] * g;
                    u32x4 w; w.x = pk2(v0[0], v0[1]); w.y = pk2(v0[2], v0[3]); w.z = pk2(v1[0], v1[1]); w.w = pk2(v1[2], v1[3]);
                    *(u32x4*)(YS + (size_t)row * D + col0 + bj * HALF) = w;
                }
            }
    }
};
}

#define XB_TMO      128
#define XB_XCNT(j)  (256  + 64 * (j))
#define XB_XSUB(j)  (1280 + 64 * (j))
#define XB_XGEN(j)  (2304 + 64 * (j))
#define XB_TOP      3328
#define XB_TOPGEN   3392
#define XCD_BAR_WORDS 3456
#define XB_SPIN_CAP (1u << 18)
__device__ __forceinline__ unsigned xb_ld(unsigned* p)              { return __hip_atomic_load(p, __ATOMIC_RELAXED, __HIP_MEMORY_SCOPE_AGENT); }
__device__ __forceinline__ unsigned xb_add(unsigned* p, unsigned v) { return __hip_atomic_fetch_add(p, v, __ATOMIC_RELAXED, __HIP_MEMORY_SCOPE_AGENT); }
__device__ __forceinline__ unsigned xb_xcc_id() { return (unsigned)__builtin_amdgcn_s_getreg((3 << 11) | 20) & 0xFu; }
#define XB_SPIN(cond, bar) do { unsigned _sp = 0; while (cond) { __builtin_amdgcn_s_sleep(1); \
    if ((++_sp & 255u) == 0u) { if (xb_ld(&(bar)[XB_TMO])) break; if (_sp > XB_SPIN_CAP) { atomicAdd(&(bar)[XB_TMO], 1u); break; } } } } while (0)
struct XcdBarrier { unsigned* bar; unsigned x; volatile LAS unsigned* st; };
__device__ __forceinline__ XcdBarrier xcd_barrier_post(unsigned* bar, volatile LAS unsigned* st) {
    XcdBarrier b; b.bar = bar; b.x = xb_xcc_id(); b.st = st;
    if (threadIdx.x == 0) (void)xb_add(&bar[XB_XCNT(b.x)], 1u);
    return b;
}
__device__ __forceinline__ void xcd_barrier_complete(unsigned* bar, unsigned x, unsigned& nloc, unsigned& nx) {
    const unsigned G = gridDim.x * gridDim.y * gridDim.z;
    unsigned sum, cnt, mine, sp = 0u;
    for (;;) {
        sum = 0u; cnt = 0u; mine = 0u;
#pragma unroll
        for (unsigned j = 0; j < 16; ++j) { const unsigned c = xb_ld(&bar[XB_XCNT(j)]); sum += c; cnt += (c > 0u) ? 1u : 0u; mine = (j == x) ? c : mine; }
        if (sum == G) break;
        __builtin_amdgcn_s_sleep(1);
        if ((++sp & 255u) == 0u) { if (xb_ld(&bar[XB_TMO])) break; if (sp > XB_SPIN_CAP) { atomicAdd(&bar[XB_TMO], 1u); break; } }
    }
    nloc = mine > 0u ? mine : 1u; nx = cnt > 0u ? cnt : 1u;
}
__device__ __forceinline__ void xcd_barrier(const XcdBarrier& b) {
    asm volatile("s_waitcnt vmcnt(0)" ::: "memory");
    __syncthreads();
    if (threadIdx.x == 0) {
        unsigned* bar = b.bar;
        __builtin_amdgcn_s_waitcnt(0);
        unsigned nloc = b.st[0], nx = b.st[1];
        if (nloc == 0u) { xcd_barrier_complete(bar, b.x, nloc, nx); b.st[0] = nloc; b.st[1] = nx; }
        const unsigned old = xb_add(&bar[XB_XSUB(b.x)], 1u);
        const unsigned gen = old / nloc;
        if (old + 1u == (gen + 1u) * nloc) {
            __builtin_amdgcn_fence(__ATOMIC_RELEASE, "agent");
            asm volatile("s_waitcnt vmcnt(0)" ::: "memory");
            const unsigned og = xb_add(&bar[XB_TOP], 1u);
            const unsigned tg = og / nx;
            if (og + 1u == (tg + 1u) * nx) xb_add(&bar[XB_TOPGEN], 1u);
            else XB_SPIN(xb_ld(&bar[XB_TOPGEN]) == tg, bar);
            __builtin_amdgcn_fence(__ATOMIC_ACQUIRE, "agent");
            xb_add(&bar[XB_XGEN(b.x)], 1u);
            asm volatile("s_waitcnt vmcnt(0)" ::: "memory");
        } else {
            XB_SPIN(xb_ld(&bar[XB_XGEN(b.x)]) == gen, bar);
            __builtin_amdgcn_fence(__ATOMIC_ACQUIRE, "agent");
            asm volatile("s_waitcnt vmcnt(0)" ::: "memory");
        }
    }
    __syncthreads();
}

struct Args { const float* in[22]; float* out; unsigned char* ws; int ph_lo, ph_hi; };

template <int MAP> __device__ __forceinline__ int map_row(int n) {
    if (MAP == 1) { const int i = n & 127; return (n & ~127) + 2 * (i & 63) + (i >> 6); }
    if (MAP == 2) return (n >> 7) * 256 + (n & 127);
    if (MAP == 3) return (n >> 7) * 256 + 128 + (n & 127);
    return n;
}
template <int MAP> __device__ __forceinline__ void wt_item(const float* W, int K, int ldw, int N, bf16_t* WT, const float* gain, LAS float* scr, int item, int lane) {
    const int nblk = N / 32, kb = item / nblk, nb = item % nblk, k0 = 64 * kb, n0 = 32 * nb;
#pragma unroll 8
    for (int i = 0; i < 32; ++i) { const int kk = 2 * i + (lane >> 5); const float g = gain ? gain[k0 + kk] : 1.0f; scr[kk * 33 + (lane & 31)] = W[(size_t)(k0 + kk) * ldw + n0 + (lane & 31)] * g; }
    LDS_WAIT(); asm volatile("" ::: "memory");
    const int c = lane & 7;
#pragma unroll
    for (int j = 0; j < 4; ++j) { const int n = (lane >> 3) + 8 * j; const LAS float* s = scr + (8 * c) * 33 + n;
        u32x4 o; o.x = pk2(s[0 * 33], s[1 * 33]); o.y = pk2(s[2 * 33], s[3 * 33]); o.z = pk2(s[4 * 33], s[5 * 33]); o.w = pk2(s[6 * 33], s[7 * 33]);
        *(u32x4*)(WT + (size_t)map_row<MAP>(n0 + n) * K + k0 + 8 * c) = o; }
    LDS_WAIT(); asm volatile("" ::: "memory");
}
template <int MAP> __device__ __forceinline__ void wt_matrix(const float* W, int K, int ldw, int N, bf16_t* WT, const float* gain, LAS float* scr, int gw, int NGW, int lane) {
    const int nitems = (K / 64) * (N / 32);
    for (int it = gw; it < nitems; it += NGW) wt_item<MAP>(W, K, ldw, N, WT, gain, scr, it, lane);
}

enum Phase { P_PRO = 0,
    P0_QKVG, P0_RET, P0_FIN, P0_WO, P0_W13, P0_W2,
    P1_QKV, P1_SB, P1_WO, P1_RA, P1_RB, P1_M13, P1_M2, P1_CMB,
    P2_PREP, P2_POOL, P2_W13, P2_W2,
    P3_QKVG, P3_RET, P3_FIN, P3_WO, P3_RA, P3_RB, P3_M13, P3_M2, P3_CMB,
    P_FINAL, P_COUNT };

struct Ctx {
    LAS unsigned char* lds; int tid, lane, wave, G, gw, NGW;
    const float* const* in; float* out; unsigned char* ws;
    bf16_t* H; float* ssq; float* gst; bf16_t* WA; bf16_t* WB; unsigned char* pool; unsigned char* misc; f32x2* tab; int* moe;
};

__device__ __forceinline__ void conv_ret(const Ctx& C, int j, int layer, bf16_t* mix, bf16_t* wo) {
    LAS float* scr = (LAS float*)(C.lds + C.wave * 16384);
    const float* g = C.in[2] + (size_t)layer * D;
    wt_matrix<1>(C.in[4] + (size_t)j * D * D, D, D, D, mix, g, scr, C.gw, C.NGW, C.lane);
    wt_matrix<1>(C.in[5] + (size_t)j * D * D, D, D, D, mix + (size_t)1024 * D, g, scr, C.gw, C.NGW, C.lane);
    wt_matrix<0>(C.in[6] + (size_t)j * D * 2 * D, D, 2 * D, 2 * D, mix + (size_t)2048 * D, g, scr, C.gw, C.NGW, C.lane);
    wt_matrix<0>(C.in[7] + (size_t)j * D * 2 * D, D, 2 * D, 2 * D, mix + (size_t)4096 * D, g, scr, C.gw, C.NGW, C.lane);
    wt_matrix<0>(C.in[8] + (size_t)j * 2 * D * D, 2 * D, D, D, wo, nullptr, scr, C.gw, C.NGW, C.lane);
}
__device__ __forceinline__ void conv_dense(const Ctx& C, int c, int layer, bf16_t* w13, bf16_t* w2) {
    LAS float* scr = (LAS float*)(C.lds + C.wave * 16384);
    const float* g = C.in[3] + (size_t)layer * D;
    wt_matrix<2>(C.in[14] + (size_t)c * D * FF, D, FF, FF, w13, g, scr, C.gw, C.NGW, C.lane);
    wt_matrix<3>(C.in[15] + (size_t)c * D * FF, D, FF, FF, w13, g, scr, C.gw, C.NGW, C.lane);
    wt_matrix<0>(C.in[16] + (size_t)c * FF * D, FF, D, D, w2, nullptr, scr, C.gw, C.NGW, C.lane);
}
__device__ __forceinline__ void conv_moe(const Ctx& C, int c, int layer, bf16_t* w13, bf16_t* w2) {
    LAS float* scr = (LAS float*)(C.lds + C.wave * 16384);
    const float* g = C.in[3] + (size_t)layer * D;
    for (int e = 0; e < NE; ++e) {
        wt_matrix<2>(C.in[18] + ((size_t)c * NE + e) * D * FF, D, FF, FF, w13 + (size_t)e * 5632 * D, g, scr, C.gw, C.NGW, C.lane);
        wt_matrix<3>(C.in[19] + ((size_t)c * NE + e) * D * FF, D, FF, FF, w13 + (size_t)e * 5632 * D, g, scr, C.gw, C.NGW, C.lane);
        wt_matrix<0>(C.in[20] + ((size_t)c * NE + e) * FF * D, FF, D, D, w2 + (size_t)e * D * FF, nullptr, scr, C.gw, C.NGW, C.lane);
    }
}

template <class Epi> __device__ __forceinline__ void run_dense(const Ctx& C, const bf16_t* A, int lda, size_t a_pn_bytes, const bf16_t* Bt, int K, int N, const Epi& E) {
    pg8::Sched<false> S; S.nM = MROWS / 256; S.nN = N / 256; S.nwg = S.nM * S.nN; S.G = C.G; S.c = (int)blockIdx.x;
    S.A = (const char*)A; S.Bt = (const char*)Bt; S.a_pm = (size_t)256 * lda * 2; S.a_pn = a_pn_bytes; S.b_pn = (size_t)256 * K * 2; S.b_e = 0; S.pexp = nullptr;
    pg8::gemm_phase(C.lds, K, lda, S, E);
}
template <class Epi> __device__ __forceinline__ void run_moe(const Ctx& C, const int* seg, const bf16_t* A, const bf16_t* Bt, size_t b_e_bytes, int K, int N, const Epi& E) {
    LAS int* pexp = (LAS int*)(C.lds + LDS_PEXP);
    const int total = seg[8] / 256;
    for (int p = C.tid; p < total; p += 512) { int e = 0;
#pragma unroll
        for (int j = 1; j < 8; ++j) e += (p * 256 >= seg[j]) ? 1 : 0;
        pexp[p] = e; }
    __syncthreads();
    pg8::Sched<true> S; S.nM = total; S.nN = N / 256; S.nwg = S.nM * S.nN; S.G = C.G; S.c = (int)blockIdx.x;
    S.A = (const char*)A; S.Bt = (const char*)Bt; S.a_pm = (size_t)256 * K * 2; S.a_pn = 0; S.b_pn = (size_t)256 * K * 2; S.b_e = b_e_bytes; S.pexp = pexp;
    pg8::gemm_phase(C.lds, K, K, S, E);
    __syncthreads();
}

__device__ __forceinline__ void ret_finalize(const Ctx& C, int j, const bf16_t* Y, const bf16_t* YM, bf16_t* Gt, const float* gst) {
    const float* gn = C.in[9] + (size_t)j * 2 * D;
    for (int row = C.gw; row < MVALID; row += C.NGW) {
        const bf16_t* yrow = row < MREAL ? Y + (size_t)row * 2048 : YM + (size_t)(row - MREAL) * 2048;
#pragma unroll
        for (int q = 0; q < 4; ++q) {
            const int col = q * 512 + C.lane * 8, h = col >> 8;
            const f32x4 ga = *(const f32x4*)(gst + ((size_t)row * 8 + h) * 8), gb = *(const f32x4*)(gst + ((size_t)row * 8 + h) * 8 + 4);
            const float s1 = (ga[0] + ga[2]) + (gb[0] + gb[2]), s2 = (ga[1] + ga[3]) + (gb[1] + gb[3]);
            const float mu = s1 * (1.0f / 256.0f); const float var = fmaxf(s2 * (1.0f / 256.0f) - mu * mu, 0.f); const float rs = __builtin_amdgcn_rsqf(var + EPS);
            const u32x4 yv = *(const u32x4*)(yrow + col); const u32x4 gv = *(const u32x4*)(Gt + (size_t)row * 2048 + col);
            const f32x4 g0 = *(const f32x4*)(gn + col), g1 = *(const f32x4*)(gn + col + 4);
            u32x4 w;
            w.x = pk2(bflo(gv.x) * (bflo(yv.x) - mu) * rs * g0[0], bfhi(gv.x) * (bfhi(yv.x) - mu) * rs * g0[1]);
            w.y = pk2(bflo(gv.y) * (bflo(yv.y) - mu) * rs * g0[2], bfhi(gv.y) * (bfhi(yv.y) - mu) * rs * g0[3]);
            w.z = pk2(bflo(gv.z) * (bflo(yv.z) - mu) * rs * g1[0], bfhi(gv.z) * (bfhi(yv.z) - mu) * rs * g1[1]);
            w.w = pk2(bflo(gv.w) * (bflo(yv.w) - mu) * rs * g1[2], bfhi(gv.w) * (bfhi(yv.w) - mu) * rs * g1[3]);
            *(u32x4*)(Gt + (size_t)row * 2048 + col) = w;
        }
    }
}

__device__ __forceinline__ void ret_naive(const Ctx& C, const bf16_t* Q, const bf16_t* Kk, bf16_t* V, bf16_t* YM, float* gst) {
    for (int item = blockIdx.x; item < NBATCH * 8 * 2; item += C.G) {
        const int half = item & 1, h = (item >> 1) & 7, b = item >> 4;
        if (C.tid < 128) {
            const int e = half * 128 + C.tid;
            const float gamma = 1.0f - exp2f(-5.0f - (float)h);
            float S[128];
#pragma unroll
            for (int d = 0; d < 128; ++d) S[d] = 0.f;
            for (int p = 0; p < LPOS; ++p) {
                const int row = pos_row(b, p);
                const u32x4* qp = (const u32x4*)(Q + (size_t)row * D + h * 128);
                const u32x4* kp = (const u32x4*)(Kk + (size_t)row * D + h * 128);
                bf16_t* vp = V + (size_t)row * 2048 + h * 256 + e;
                const float v = bf1(*vp);
                float y = 0.f;
#pragma unroll
                for (int jj = 0; jj < 16; ++jj) {
                    const u32x4 kq = kp[jj], qq = qp[jj];
                    const unsigned kw[4] = {kq.x, kq.y, kq.z, kq.w}, qw[4] = {qq.x, qq.y, qq.z, qq.w};
#pragma unroll
                    for (int i = 0; i < 4; ++i) {
                        S[8 * jj + 2 * i] = gamma * S[8 * jj + 2 * i] + bflo(kw[i]) * v; y += bflo(qw[i]) * S[8 * jj + 2 * i];
                        S[8 * jj + 2 * i + 1] = gamma * S[8 * jj + 2 * i + 1] + bfhi(kw[i]) * v; y += bfhi(qw[i]) * S[8 * jj + 2 * i + 1];
                    }
                }
                if (p >= NMETA || b == 0) {
                    if (p >= NMETA) *vp = (bf16_t)f2bf(y); else YM[(size_t)p * 2048 + h * 256 + e] = (bf16_t)f2bf(y);
                    const float s1 = wave_sum(y), s2 = wave_sum(y * y);
                    if (C.lane == 0) { *(f32x2*)(gst + ((size_t)row * 8 + h) * 8 + (half * 2 + C.wave) * 2) = (f32x2){s1, s2}; }
                }
            }
        }
    }
}

__device__ __forceinline__ void sb_naive(const Ctx& C, bf16_t* Q, const bf16_t* Kk, const bf16_t* V) {
    const int NIT = NBATCH * 16 * 32 + 16;
    for (int it = C.gw; it < NIT; it += C.NGW) {
        int b, h, p0, nq;
        if (it < NBATCH * 16 * 32) { const int bh = it & 255, qb = it >> 8; b = bh >> 4; h = bh & 15; p0 = NMETA + qb * 64; nq = 64; }
        else { b = 0; h = it - NBATCH * 16 * 32; p0 = 0; nq = 16; }
        const int p = p0 + C.lane; const bool valid = C.lane < nq;
        const int row = pos_row(b, valid ? p : p0);
        float q[64], o[64];
        { const u32x4* qp = (const u32x4*)(Q + (size_t)row * D + h * 64);
#pragma unroll
          for (int jj = 0; jj < 8; ++jj) { const u32x4 t = qp[jj]; q[8 * jj] = bflo(t.x); q[8 * jj + 1] = bfhi(t.x); q[8 * jj + 2] = bflo(t.y); q[8 * jj + 3] = bfhi(t.y); q[8 * jj + 4] = bflo(t.z); q[8 * jj + 5] = bfhi(t.z); q[8 * jj + 6] = bflo(t.w); q[8 * jj + 7] = bfhi(t.w); } }
#pragma unroll
        for (int d = 0; d < 64; ++d) o[d] = 0.f;
        float P = 1.0f;
        for (int s = p0 + nq - 2; s >= 0; --s) {
            const int krow = pos_row(b, s);
            const u32x4* kp = (const u32x4*)(Kk + (size_t)krow * D + h * 64);
            const u32x4* vp = (const u32x4*)(V + (size_t)krow * D + h * 64);
            float z = 0.f;
#pragma unroll
            for (int jj = 0; jj < 8; ++jj) { const u32x4 t = kp[jj];
                z += q[8 * jj] * bflo(t.x) + q[8 * jj + 1] * bfhi(t.x) + q[8 * jj + 2] * bflo(t.y) + q[8 * jj + 3] * bfhi(t.y) + q[8 * jj + 4] * bflo(t.z) + q[8 * jj + 5] * bfhi(t.z) + q[8 * jj + 6] * bflo(t.w) + q[8 * jj + 7] * bfhi(t.w); }
            z = fminf(z * 0.125f, 60.f);
            const float E = fast_exp2(z * 1.4426950408889634f), r = fast_rcp(1.0f + E);
            const bool act = valid && (s < p);
            const float w = act ? E * r * P : 0.f;
            P = act ? P * r : P;
#pragma unroll
            for (int jj = 0; jj < 8; ++jj) { const u32x4 t = vp[jj];
                o[8 * jj] += w * bflo(t.x); o[8 * jj + 1] += w * bfhi(t.x); o[8 * jj + 2] += w * bflo(t.y); o[8 * jj + 3] += w * bfhi(t.y); o[8 * jj + 4] += w * bflo(t.z); o[8 * jj + 5] += w * bfhi(t.z); o[8 * jj + 6] += w * bflo(t.w); o[8 * jj + 7] += w * bfhi(t.w); }
        }
        if (valid) { u32x4* op = (u32x4*)(Q + (size_t)row * D + h * 64);
#pragma unroll
            for (int jj = 0; jj < 8; ++jj) { u32x4 t; t.x = pk2(o[8 * jj], o[8 * jj + 1]); t.y = pk2(o[8 * jj + 2], o[8 * jj + 3]); t.z = pk2(o[8 * jj + 4], o[8 * jj + 5]); t.w = pk2(o[8 * jj + 6], o[8 * jj + 7]); op[jj] = t; } }
    }
}

constexpr int ROWS_PER_WG = 129;
__device__ __forceinline__ void router_a(const Ctx& C, int c, int layer, const float* ssq, int* cnt_wg) {
    LAS float* wr = (LAS float*)C.lds;
    LAS int* lcnt = (LAS int*)(C.lds + 32768);
    const float* Wr = C.in[17] + (size_t)c * D * NE; const float* g = C.in[3] + (size_t)layer * D;
    for (int i = C.tid; i < D * NE; i += 512) { const int k = i >> 3, e = i & 7; wr[e * D + k] = Wr[i] * g[k]; }
    if (C.tid < NE) lcnt[C.tid] = 0;
    __syncthreads();
    int2* toke = (int2*)(C.misc + MISC_TOKE); f32x2* tokg = (f32x2*)(C.misc + MISC_TOKG); int2* tokr = (int2*)(C.misc + MISC_TOKR);
    const int r0 = (int)blockIdx.x * ROWS_PER_WG;
    for (int rr = C.wave; rr < ROWS_PER_WG; rr += 8) {
        const int row = r0 + rr; if (row >= MVALID) break;
        float hv[16];
#pragma unroll
        for (int q = 0; q < 2; ++q) { const u32x4 t = *(const u32x4*)(C.H + (size_t)row * D + q * 512 + C.lane * 8);
            hv[8 * q] = bflo(t.x); hv[8 * q + 1] = bfhi(t.x); hv[8 * q + 2] = bflo(t.y); hv[8 * q + 3] = bfhi(t.y); hv[8 * q + 4] = bflo(t.z); hv[8 * q + 5] = bfhi(t.z); hv[8 * q + 6] = bflo(t.w); hv[8 * q + 7] = bfhi(t.w); }
        float lg[NE];
#pragma unroll
        for (int e = 0; e < NE; ++e) { float s = 0.f;
#pragma unroll
            for (int q = 0; q < 2; ++q) { const f32x4 w0 = *(const LAS f32x4*)(wr + e * D + q * 512 + C.lane * 8), w1 = *(const LAS f32x4*)(wr + e * D + q * 512 + C.lane * 8 + 4);
                s += hv[8 * q] * w0[0] + hv[8 * q + 1] * w0[1] + hv[8 * q + 2] * w0[2] + hv[8 * q + 3] * w0[3] + hv[8 * q + 4] * w1[0] + hv[8 * q + 5] * w1[1] + hv[8 * q + 6] * w1[2] + hv[8 * q + 7] * w1[3]; }
            lg[e] = wave_sum(s); }
        if (C.lane == 0) {
            const float rs = pg8::rstd_of(ssq, row);
            int e0 = 0; float v0 = lg[0];
#pragma unroll
            for (int e = 1; e < NE; ++e) if (lg[e] > v0) { v0 = lg[e]; e0 = e; }
            int e1 = -1; float v1 = -3.0e38f;
#pragma unroll
            for (int e = 0; e < NE; ++e) if (e != e0 && lg[e] > v1) { v1 = lg[e]; e1 = e; }
            const float g1 = fast_rcp(1.0f + __expf((v0 - v1) * rs)), g0 = 1.0f - g1;
            const int k0 = atomicAdd((int*)&lcnt[e0], 1), k1 = atomicAdd((int*)&lcnt[e1], 1);
            toke[row] = make_int2(e0, e1); tokg[row] = (f32x2){g0, g1}; tokr[row] = make_int2(k0, k1);
        }
    }
    __syncthreads();
    if (C.tid < NE) cnt_wg[(int)blockIdx.x * NE + C.tid] = lcnt[C.tid];
    __syncthreads();
}
__device__ __forceinline__ void router_b(const Ctx& C, const float* ssq, const int* cnt_wg, int* seg_out, bf16_t* XS) {
    LAS int* tot = (LAS int*)C.lds;
    LAS int* part = (LAS int*)(C.lds + 1024);
    { const int e = C.tid & 7, sl = C.tid >> 3; int all = 0, before = 0;
#pragma unroll
      for (int j = 0; j < 4; ++j) { const int w = sl * 4 + j; const int v = cnt_wg[w * NE + e]; all += v; before += (w < (int)blockIdx.x) ? v : 0; }
      all += __shfl_xor(all, 8); all += __shfl_xor(all, 16); all += __shfl_xor(all, 32);
      before += __shfl_xor(before, 8); before += __shfl_xor(before, 16); before += __shfl_xor(before, 32);
      if (C.lane < 8) { part[C.wave * 16 + C.lane] = all; part[C.wave * 16 + 8 + C.lane] = before; } }
    __syncthreads();
    if (C.tid < NE) { int all = 0, before = 0;
#pragma unroll
        for (int w = 0; w < 8; ++w) { all += part[w * 16 + C.tid]; before += part[w * 16 + 8 + C.tid]; }
        tot[C.tid] = all; tot[8 + C.tid] = before; }
    __syncthreads();
    if (C.tid == 0) { int s = 0;
        for (int e = 0; e < NE; ++e) { tot[16 + e] = s; s += (tot[e] + 255) & ~255; }
        tot[24] = s;
        if (blockIdx.x == 0) for (int e = 0; e <= NE; ++e) seg_out[e] = tot[16 + e]; }
    __syncthreads();
    const int2* toke = (const int2*)(C.misc + MISC_TOKE); const f32x2* tokg = (const f32x2*)(C.misc + MISC_TOKG); const int2* tokr = (const int2*)(C.misc + MISC_TOKR);
    int2* tokp = (int2*)(C.misc + MISC_TOKP); float* rstds = (float*)(C.misc + MISC_RSTDS); float* gates = (float*)(C.misc + MISC_GATES);
    const int r0 = (int)blockIdx.x * ROWS_PER_WG;
    for (int rr = C.wave; rr < ROWS_PER_WG; rr += 8) {
        const int row = r0 + rr; if (row >= MVALID) break;
        const int2 e = toke[row], k = tokr[row]; const f32x2 g = tokg[row];
        const int p0 = tot[16 + e.x] + tot[8 + e.x] + k.x, p1 = tot[16 + e.y] + tot[8 + e.y] + k.y;
        const u32x4 a = *(const u32x4*)(C.H + (size_t)row * D + C.lane * 8), bq = *(const u32x4*)(C.H + (size_t)row * D + 512 + C.lane * 8);
        *(u32x4*)(XS + (size_t)p0 * D + C.lane * 8) = a; *(u32x4*)(XS + (size_t)p0 * D + 512 + C.lane * 8) = bq;
        *(u32x4*)(XS + (size_t)p1 * D + C.lane * 8) = a; *(u32x4*)(XS + (size_t)p1 * D + 512 + C.lane * 8) = bq;
        if (C.lane == 0) { const float rs = pg8::rstd_of(ssq, row); tokp[row] = make_int2(p0, p1); rstds[p0] = rs; rstds[p1] = rs; gates[p0] = g.x; gates[p1] = g.y; }
    }
    __syncthreads();
}
__device__ __forceinline__ void moe_combine(const Ctx& C, const bf16_t* YS, float* ssq_out) {
    const int2* tokp = (const int2*)(C.misc + MISC_TOKP);
    for (int row = C.gw; row < MVALID; row += C.NGW) {
        const int2 p = tokp[row]; float ss = 0.f;
#pragma unroll
        for (int q = 0; q < 2; ++q) {
            const int col = q * 512 + C.lane * 8;
            const u32x4 hv = *(const u32x4*)(C.H + (size_t)row * D + col), y0 = *(const u32x4*)(YS + (size_t)p.x * D + col), y1 = *(const u32x4*)(YS + (size_t)p.y * D + col);
            u32x4 w;
            w.x = pk2(bflo(hv.x) + bflo(y0.x) + bflo(y1.x), bfhi(hv.x) + bfhi(y0.x) + bfhi(y1.x));
            w.y = pk2(bflo(hv.y) + bflo(y0.y) + bflo(y1.y), bfhi(hv.y) + bfhi(y0.y) + bfhi(y1.y));
            w.z = pk2(bflo(hv.z) + bflo(y0.z) + bflo(y1.z), bfhi(hv.z) + bfhi(y0.z) + bfhi(y1.z));
            w.w = pk2(bflo(hv.w) + bflo(y0.w) + bflo(y1.w), bfhi(hv.w) + bfhi(y0.w) + bfhi(y1.w));
            *(u32x4*)(C.H + (size_t)row * D + col) = w;
            ss += bflo(w.x) * bflo(w.x) + bfhi(w.x) * bfhi(w.x) + bflo(w.y) * bflo(w.y) + bfhi(w.y) * bfhi(w.y) + bflo(w.z) * bflo(w.z) + bfhi(w.z) * bfhi(w.z) + bflo(w.w) * bflo(w.w) + bfhi(w.w) * bfhi(w.w);
        }
        ss = wave_sum(ss);
        pg8::ssq_store_single(ssq_out, row, ss, C.lane);
    }
}
__device__ __forceinline__ void pool_prep(const Ctx& C, const float* ssq, const float* gain, bf16_t* Dm) {
    for (int row = C.gw; row < MROWS; row += C.NGW) {
        if (row >= MVALID) { const u32x4 z = {0u, 0u, 0u, 0u}; *(u32x4*)(Dm + (size_t)row * D + C.lane * 8) = z; *(u32x4*)(Dm + (size_t)row * D + 512 + C.lane * 8) = z; continue; }
        const int b = row < MREAL ? row >> 11 : 0, p = row_pos(row);
#pragma unroll
        for (int q = 0; q < 2; ++q) {
            const int col = q * 512 + C.lane * 8, grp = col >> 8, w = 2 << grp;
            const int cnt = (p + 1 < w) ? p + 1 : w;
            float acc[8], self[8];
#pragma unroll
            for (int j = 0; j < 8; ++j) acc[j] = 0.f;
            for (int d = 0; d < 16; ++d) {
                if (d < cnt) {
                    const int r2 = pos_row(b, p - d); const float rs = pg8::rstd_of(ssq, r2);
                    const u32x4 t = *(const u32x4*)(C.H + (size_t)r2 * D + col);
                    const float v[8] = {bflo(t.x) * rs, bfhi(t.x) * rs, bflo(t.y) * rs, bfhi(t.y) * rs, bflo(t.z) * rs, bfhi(t.z) * rs, bflo(t.w) * rs, bfhi(t.w) * rs};
#pragma unroll
                    for (int j = 0; j < 8; ++j) { acc[j] += v[j]; if (d == 0) self[j] = v[j]; }
                }
            }
            const float ic = 1.0f / (float)cnt;
            const f32x4 g0 = *(const f32x4*)(gain + col), g1 = *(const f32x4*)(gain + col + 4);
            u32x4 o;
            o.x = pk2((acc[0] * ic - self[0]) * g0[0], (acc[1] * ic - self[1]) * g0[1]); o.y = pk2((acc[2] * ic - self[2]) * g0[2], (acc[3] * ic - self[3]) * g0[3]);
            o.z = pk2((acc[4] * ic - self[4]) * g1[0], (acc[5] * ic - self[5]) * g1[1]); o.w = pk2((acc[6] * ic - self[6]) * g1[2], (acc[7] * ic - self[7]) * g1[3]);
            *(u32x4*)(Dm + (size_t)row * D + col) = o;
        }
    }
}

__global__ void __launch_bounds__(512, 2) fwd_kernel(Args args) {
    extern __shared__ __attribute__((aligned(16))) unsigned char lds_raw[];
    Ctx C;
    C.lds = (LAS unsigned char*)lds_raw;
    C.tid = threadIdx.x; C.lane = C.tid & 63; C.wave = __builtin_amdgcn_readfirstlane(C.tid >> 6);
    C.G = gridDim.x; C.gw = (int)blockIdx.x * 8 + C.wave; C.NGW = C.G * 8;
    C.in = args.in; C.out = args.out; C.ws = args.ws;
    C.H = (bf16_t*)(args.ws + WS_H); C.ssq = (float*)(args.ws + WS_SSQ); C.gst = (float*)(args.ws + WS_GST);
    C.WA = (bf16_t*)(args.ws + WS_WA); C.WB = (bf16_t*)(args.ws + WS_WB); C.pool = args.ws + WS_POOL; C.misc = args.ws + WS_MISC; C.tab = (f32x2*)(args.ws + WS_TAB);
    C.moe = (int*)(args.ws + WS_CTL + CTL_MOE);
    for (int u = C.tid; u < (LDS_BYTES - LDSCTL_OFF) / 4; u += 512) ((LAS unsigned*)(C.lds + LDSCTL_OFF))[u] = 0u;
    __syncthreads();
    unsigned* barw = (unsigned*)(args.ws + WS_CTL) + CW_BAR;
    XcdBarrier bar; bar.bar = barw; bar.x = 0; bar.st = nullptr;
    if (!MK_PER_PHASE) bar = xcd_barrier_post(barw, (volatile LAS unsigned*)(C.lds + LDSCTL_OFF + 32));
    const int lo = args.ph_lo, hi = args.ph_hi;
#define IN(k) (lo <= (k) && (k) < hi)
#define SEAM(k) do { if (!MK_PER_PHASE && (k) + 1 < hi) xcd_barrier(bar); } while (0)

    bf16_t* const PQ = (bf16_t*)(C.pool + PO_Q); bf16_t* const PK = (bf16_t*)(C.pool + PO_K); bf16_t* const PV = (bf16_t*)(C.pool + PO_V); bf16_t* const PG = (bf16_t*)(C.pool + PO_G);
    bf16_t* const HID = (bf16_t*)(C.pool + PO_HID); bf16_t* const XS = (bf16_t*)(C.pool + PO_XS); bf16_t* const MHID = (bf16_t*)(C.pool + PO_MHID);
    bf16_t* const YM = (bf16_t*)(C.misc + MISC_YM);
    float* const rstds = (float*)(C.misc + MISC_RSTDS); float* const gates = (float*)(C.misc + MISC_GATES);
#define SSQ(i) (C.ssq + (size_t)(i) * MROWS * 16)

    if (IN(P_PRO)) {
        conv_ret(C, 0, 0, C.WB + WB_MIX, C.WB + WB_WO);
        conv_dense(C, 0, 0, C.WB + WB_W13, C.WB + WB_W2);
        { LAS float* scr = (LAS float*)(C.lds + C.wave * 16384);
          wt_matrix<0>(C.in[10], D, 3 * D, 3 * D, C.WA + WA_MIX, C.in[2] + 1 * D, scr, C.gw, C.NGW, C.lane);
          wt_matrix<0>(C.in[11], D, D, D, C.WA + WA_MIX_WO_SB, nullptr, scr, C.gw, C.NGW, C.lane); }
        conv_moe(C, 0, 1, C.WA + WA_MOE13, C.WA + WA_MOE2);
        for (int i = C.gw * 64 + C.lane; i < LPOS * 64; i += C.NGW * 64) {
            const int p = i >> 6, f = i & 63;
            const float inv = exp2f(-(float)f * (13.287712379549449f / 64.0f));
            const float ang = (float)p * inv;
            const double rev = (double)ang * 0.15915494309189535; const float fr = (float)(rev - __builtin_rint(rev));
            C.tab[i] = (f32x2){__builtin_amdgcn_cosf(fr), __builtin_amdgcn_sinf(fr)};
        }
        for (int row = C.gw; row < MROWS; row += C.NGW) {
            float ss = 0.f;
            if (row < MVALID) {
                const float* src = row < MREAL ? C.in[0] + (size_t)row * D : C.in[1] + (size_t)(row - MREAL) * D;
#pragma unroll
                for (int q = 0; q < 2; ++q) { const int col = q * 512 + C.lane * 8; const f32x4 a = *(const f32x4*)(src + col), b2 = *(const f32x4*)(src + col + 4);
                    u32x4 w; w.x = pk2(a[0], a[1]); w.y = pk2(a[2], a[3]); w.z = pk2(b2[0], b2[1]); w.w = pk2(b2[2], b2[3]);
                    *(u32x4*)(C.H + (size_t)row * D + col) = w;
                    ss += bflo(w.x) * bflo(w.x) + bfhi(w.x) * bfhi(w.x) + bflo(w.y) * bflo(w.y) + bfhi(w.y) * bfhi(w.y) + bflo(w.z) * bflo(w.z) + bfhi(w.z) * bfhi(w.z) + bflo(w.w) * bflo(w.w) + bfhi(w.w) * bfhi(w.w); }
                ss = wave_sum(ss);
            } else { const u32x4 z = {0u, 0u, 0u, 0u}; *(u32x4*)(C.H + (size_t)row * D + C.lane * 8) = z; *(u32x4*)(C.H + (size_t)row * D + 512 + C.lane * 8) = z; }
            pg8::ssq_store_single(SSQ(0), row, ss, C.lane);
        }
        SEAM(P_PRO);
    }
    if (IN(P0_QKVG)) { pg8::EpiProj<0> E{SSQ(0), C.tab, PQ, PK, PV, PG}; run_dense(C, C.H, D, 0, C.WB + WB_MIX, D, 6144, E); SEAM(P0_QKVG); }
    if (IN(P0_RET)) { ret_naive(C, PQ, PK, PV, YM, C.gst); SEAM(P0_RET); }
    if (IN(P0_FIN)) { ret_finalize(C, 0, PV, YM, PG, C.gst); SEAM(P0_FIN); }
    if (IN(P0_WO)) { pg8::EpiResid E{C.H, SSQ(1), nullptr}; run_dense(C, PG, 2048, 0, C.WB + WB_WO, 2048, 1024, E); SEAM(P0_WO); }
    if (IN(P0_W13)) { pg8::EpiSwiglu<false> E{SSQ(1), HID}; run_dense(C, C.H, D, 0, C.WB + WB_W13, D, 5632, E); SEAM(P0_W13); }
    if (IN(P0_W2)) { pg8::EpiResid E{C.H, SSQ(2), nullptr}; run_dense(C, HID, FF, 0, C.WB + WB_W2, FF, 1024, E); SEAM(P0_W2); }
    if (IN(P1_QKV)) { pg8::EpiProj<1> E{SSQ(2), C.tab, PQ, PK, PV, PG}; run_dense(C, C.H, D, 0, C.WA + WA_MIX, D, 3072, E); SEAM(P1_QKV); }
    if (IN(P1_SB)) { sb_naive(C, PQ, PK, PV); SEAM(P1_SB); }
    if (IN(P1_WO)) { pg8::EpiResid E{C.H, SSQ(3), nullptr}; run_dense(C, PQ, D, 0, C.WA + WA_MIX_WO_SB, D, 1024, E); SEAM(P1_WO); }
    if (IN(P1_RA)) {
        router_a(C, 0, 1, SSQ(3), C.moe);
        { LAS float* scr = (LAS float*)(C.lds + C.wave * 16384);
          for (int g = 0; g < 4; ++g) wt_matrix<0>(C.in[12] + (size_t)g * 256 * 256, 256, 256, 256, C.WB + WB_MIX + (size_t)g * 256 * 256, nullptr, scr, C.gw, C.NGW, C.lane); }
        conv_dense(C, 1, 2, C.WB + WB_W13, C.WB + WB_W2);
        SEAM(P1_RA);
    }
    if (IN(P1_RB)) { router_b(C, SSQ(3), C.moe, C.moe + 2 * 256 * NE, XS); SEAM(P1_RB); }
    if (IN(P1_M13)) { pg8::EpiSwiglu<true> E{rstds, MHID}; run_moe(C, C.moe + 2 * 256 * NE, XS, C.WA + WA_MOE13, (size_t)5632 * D * 2, D, 5632, E); SEAM(P1_M13); }
    if (IN(P1_M2)) { pg8::EpiMoeW2 E{gates, XS}; run_moe(C, C.moe + 2 * 256 * NE, MHID, C.WA + WA_MOE2, (size_t)D * FF * 2, FF, 1024, E); SEAM(P1_M2); }
    if (IN(P1_CMB)) {
        moe_combine(C, XS, SSQ(4));
        conv_ret(C, 1, 3, C.WA + WA_MIX, C.WA + WA_MIX_WO_RET);
        conv_moe(C, 1, 3, C.WA + WA_MOE13, C.WA + WA_MOE2);
        SEAM(P1_CMB);
    }
    if (IN(P2_PREP)) { pool_prep(C, SSQ(4), C.in[2] + 2 * D, PQ); SEAM(P2_PREP); }
    if (IN(P2_POOL)) { pg8::EpiResid E{C.H, SSQ(5), C.in[13]}; run_dense(C, PQ, D, 512, C.WB + WB_MIX, 256, 1024, E); SEAM(P2_POOL); }
    if (IN(P2_W13)) { pg8::EpiSwiglu<false> E{SSQ(5), HID}; run_dense(C, C.H, D, 0, C.WB + WB_W13, D, 5632, E); SEAM(P2_W13); }
    if (IN(P2_W2)) { pg8::EpiResid E{C.H, SSQ(6), nullptr}; run_dense(C, HID, FF, 0, C.WB + WB_W2, FF, 1024, E); SEAM(P2_W2); }
    if (IN(P3_QKVG)) { pg8::EpiProj<0> E{SSQ(6), C.tab, PQ, PK, PV, PG}; run_dense(C, C.H, D, 0, C.WA + WA_MIX, D, 6144, E); SEAM(P3_QKVG); }
    if (IN(P3_RET)) { ret_naive(C, PQ, PK, PV, YM, C.gst); SEAM(P3_RET); }
    if (IN(P3_FIN)) { ret_finalize(C, 1, PV, YM, PG, C.gst); SEAM(P3_FIN); }
    if (IN(P3_WO)) { pg8::EpiResid E{C.H, SSQ(7), nullptr}; run_dense(C, PG, 2048, 0, C.WA + WA_MIX_WO_RET, 2048, 1024, E); SEAM(P3_WO); }
    if (IN(P3_RA)) { router_a(C, 1, 3, SSQ(7), C.moe + 256 * NE); SEAM(P3_RA); }
    if (IN(P3_RB)) { router_b(C, SSQ(7), C.moe + 256 * NE, C.moe + 2 * 256 * NE + 16, XS); SEAM(P3_RB); }
    if (IN(P3_M13)) { pg8::EpiSwiglu<true> E{rstds, MHID}; run_moe(C, C.moe + 2 * 256 * NE + 16, XS, C.WA + WA_MOE13, (size_t)5632 * D * 2, D, 5632, E); SEAM(P3_M13); }
    if (IN(P3_M2)) { pg8::EpiMoeW2 E{gates, XS}; run_moe(C, C.moe + 2 * 256 * NE + 16, MHID, C.WA + WA_MOE2, (size_t)D * FF * 2, FF, 1024, E); SEAM(P3_M2); }
    if (IN(P3_CMB)) { moe_combine(C, XS, SSQ(8)); SEAM(P3_CMB); }
    if (IN(P_FINAL)) {
        const float* g = C.in[21];
        for (int row = C.gw; row < MREAL; row += C.NGW) {
            const float rs = pg8::rstd_of(SSQ(8), row);
#pragma unroll
            for (int q = 0; q < 2; ++q) { const int col = q * 512 + C.lane * 8; const u32x4 t = *(const u32x4*)(C.H + (size_t)row * D + col);
                const f32x4 g0 = *(const f32x4*)(g + col), g1 = *(const f32x4*)(g + col + 4);
                f32x4 o0 = {bflo(t.x) * rs * g0[0], bfhi(t.x) * rs * g0[1], bflo(t.y) * rs * g0[2], bfhi(t.y) * rs * g0[3]};
                f32x4 o1 = {bflo(t.z) * rs * g1[0], bfhi(t.z) * rs * g1[1], bflo(t.w) * rs * g1[2], bfhi(t.w) * rs * g1[3]};
                *(f32x4*)(C.out + (size_t)row * D + col) = o0; *(f32x4*)(C.out + (size_t)row * D + col + 4) = o1; }
        }
    }
#undef IN
#undef SEAM
#undef SSQ
}

extern "C" void kernel_launch(void* const* d_in, const int* in_sizes, int n_in, void* d_out, int out_size, void* d_ws, size_t ws_size, hipStream_t stream) {
    static int grid = 0;
    if (grid == 0) {
        if (n_in != 22 || out_size != MREAL * D || ws_size < WS_END) { fprintf(stderr, "kernel_launch: unexpected shapes (n_in %d out %d ws %zu)\n", n_in, out_size, ws_size); grid = -1; return; }
        int dev = 0, cus = 0;
        if (hipGetDevice(&dev) != hipSuccess || hipDeviceGetAttribute(&cus, hipDeviceAttributeMultiprocessorCount, dev) != hipSuccess) { grid = -1; return; }
        if (hipFuncSetAttribute((const void*)fwd_kernel, hipFuncAttributeMaxDynamicSharedMemorySize, LDS_BYTES) != hipSuccess) { grid = -1; return; }
        int per_cu = 0;
        if (hipOccupancyMaxActiveBlocksPerMultiprocessor(&per_cu, (const void*)fwd_kernel, 512, LDS_BYTES) != hipSuccess || per_cu < 1) { fprintf(stderr, "kernel_launch: occupancy query says %d\n", per_cu); }
        (void)hipGetLastError();
        grid = cus;
    }
    if (grid < 0) return;
    (void)hipMemsetAsync((char*)d_ws + WS_CTL, 0, CTL_BYTES, stream);
    Args a{};
    for (int i = 0; i < 22; ++i) a.in[i] = (const float*)d_in[i];
    a.out = (float*)d_out; a.ws = (unsigned char*)d_ws;
#if MK_PER_PHASE
    for (int k = 0; k < P_COUNT; ++k) { a.ph_lo = k; a.ph_hi = k + 1; hipLaunchKernelGGL(fwd_kernel, dim3(grid), dim3(512), LDS_BYTES, stream, a); }
#else
    a.ph_lo = 0; a.ph_hi = P_COUNT;
    hipLaunchKernelGGL(fwd_kernel, dim3(grid), dim3(512), LDS_BYTES, stream, a);
#endif
}
```

```cpp
#include <hip/hip_runtime.h>
#include <cstdio>
#include <cstdint>

#ifndef MK_PER_PHASE
#define MK_PER_PHASE 0
#endif
#ifndef NAIVE_RET
#define NAIVE_RET 0
#endif
#ifndef NAIVE_SB
#define NAIVE_SB 0
#endif

#define GAS __attribute__((address_space(1)))
#define LAS __attribute__((address_space(3)))
typedef unsigned short bf16_t;
typedef short bf16x8 __attribute__((ext_vector_type(8)));
typedef float f32x4 __attribute__((ext_vector_type(4)));
typedef float f32x2 __attribute__((ext_vector_type(2)));
typedef unsigned u32x4 __attribute__((ext_vector_type(4)));
typedef unsigned u32x2 __attribute__((ext_vector_type(2)));

constexpr int D = 1024, NBATCH = 16, SEQ = 2048, NMETA = 16;
constexpr int MREAL = NBATCH * SEQ;
constexpr int MVALID = MREAL + NMETA;
constexpr int MROWS = 33024;
constexpr int FF = 2816, NE = 8;
constexpr int LPOS = SEQ + NMETA;
constexpr float EPS = 1e-6f;
constexpr int MOE_ROWS = 67840;

constexpr size_t MiB = 1u << 20;
constexpr size_t WS_CTL = 0, CTL_BYTES = 1 * MiB;
constexpr int CW_BAR = 4096;
constexpr size_t CTL_MOE = 512 * 1024;
constexpr size_t WS_SSQ = 1 * MiB;
constexpr size_t WS_GST = 20 * MiB;
constexpr size_t WS_WA = 29 * MiB, WS_WB = 185 * MiB, WS_H = 221 * MiB, WS_TAB = 289 * MiB, WS_MISC = 291 * MiB, WS_POOL = 297 * MiB, WS_END = 795 * MiB;
static_assert(WS_SSQ + (size_t)9 * MROWS * 64 <= WS_GST && WS_GST + (size_t)MROWS * 8 * 8 * 4 <= WS_WA, "ssq/gst");
constexpr size_t WA_MOE13 = 0, WA_MOE2 = (size_t)NE * 5632 * 1024, WA_MIX = WA_MOE2 + (size_t)NE * 1024 * 2816;
constexpr size_t WA_MIX_WO_SB = WA_MIX + (size_t)3072 * 1024, WA_MIX_WO_RET = WA_MIX + (size_t)6144 * 1024;
constexpr size_t WB_MIX = 0, WB_WO = (size_t)6144 * 1024, WB_W13 = WB_WO + (size_t)1024 * 2048, WB_W2 = WB_W13 + (size_t)5632 * 1024;
static_assert((WA_MIX + 8388608) * 2 <= 156 * MiB && (WB_W2 + (size_t)1024 * 2816) * 2 <= 36 * MiB, "weight regions");
constexpr size_t MISC_TOKE = 0, MISC_TOKG = 512 * 1024, MISC_TOKR = 1024 * 1024, MISC_TOKP = 1536 * 1024, MISC_RSTDS = 2 * MiB, MISC_GATES = 2 * MiB + 512 * 1024, MISC_YM = 3 * MiB;
constexpr size_t ACT1 = (size_t)MROWS * 1024 * 2;
constexpr size_t PO_Q = 0, PO_K = ACT1, PO_V = 2 * ACT1, PO_G = 4 * ACT1;
constexpr size_t PO_HID = 0, PO_D = 0;
constexpr size_t PO_XS = 0, PO_MHID = 133 * MiB;
static_assert(PO_G + 2 * ACT1 <= 498 * MiB && PO_MHID + (size_t)MOE_ROWS * FF * 2 <= 498 * MiB && (size_t)MOE_ROWS * 2048 <= 133 * MiB, "pool");

constexpr int RING_BYTES = 131072;
constexpr int LDSCTL_OFF = RING_BYTES;
constexpr int LDS_PEXP = LDSCTL_OFF + 256;
constexpr int LDS_BYTES = 147456;

__device__ __forceinline__ unsigned f2bf(float f) { unsigned u = __builtin_bit_cast(unsigned, f); return (u + 0x7fffu + ((u >> 16) & 1u)) >> 16; }
typedef __bf16 bf16x2_t __attribute__((ext_vector_type(2)));
__device__ __forceinline__ unsigned pk2(float lo, float hi) { const f32x2 v = {lo, hi}; const bf16x2_t b = __builtin_convertvector(v, bf16x2_t); return __builtin_bit_cast(unsigned, b); }
__device__ __forceinline__ float bflo(unsigned u) { return __builtin_bit_cast(float, u << 16); }
__device__ __forceinline__ float bfhi(unsigned u) { return __builtin_bit_cast(float, u & 0xffff0000u); }
__device__ __forceinline__ float bf1(bf16_t u) { return __builtin_bit_cast(float, ((unsigned)u) << 16); }
__device__ __forceinline__ float fast_rcp(float x) { return __builtin_amdgcn_rcpf(x); }
__device__ __forceinline__ float fast_exp2(float x) { return __builtin_amdgcn_exp2f(x); }
__device__ __forceinline__ float silu_f(float v) { return v * fast_rcp(1.0f + fast_exp2(-1.4426950408889634f * v)); }
__device__ __forceinline__ float wave_sum(float v) {
#pragma unroll
    for (int o = 1; o < 64; o <<= 1) v += __shfl_xor(v, o);
    return v;
}
__device__ __forceinline__ int row_pos(int row) { return row < MREAL ? NMETA + (row & (SEQ - 1)) : (row - MREAL < NMETA ? row - MREAL : NMETA - 1); }
__device__ __forceinline__ int pos_row(int b, int p) { return p < NMETA ? MREAL + p : b * SEQ + p - NMETA; }
#define LDS_WAIT() asm volatile("s_waitcnt lgkmcnt(0)" ::: "memory")

namespace pg8 {
constexpr int BM = 256, BK = 64, HALF = 128, HTB = HALF * BK * 2, NXCD = 8, WGM = 8;
__host__ __device__ __forceinline__ int lds_byte(int r, int c) { const int st = (r >> 4) * 2 + (c >> 5), rr = r & 15, cc = c & 31, ob = rr * 64 + cc * 2; return st * 1024 + (ob ^ (((ob >> 9) & 1) << 5)); }
__host__ __device__ __forceinline__ void stage_rc(int b, int& R, int& C) { const int st = b / 1024, sb = b % 1024, swz = sb ^ (((sb >> 9) & 1) << 5); R = (st >> 1) * 16 + swz / 64; C = (st & 1) * 32 + (swz % 64) / 2; }
__host__ __device__ __forceinline__ int perm32(int rho) { const int n = rho >> 4, i = rho & 15; return 8 * (i >> 2) + 4 * n + (i & 3); }
struct Unit { int pm, pn; };

template <bool MOE> struct Sched {
    int nM, nN, nwg, G, c; const char* A; const char* Bt; size_t a_pm, a_pn, b_pn, b_e; const LAS int* pexp;
    __device__ __forceinline__ bool next(int i, Unit& u) const {
        const long L = (long)i * G + c; if (L >= nwg) return false;
        int wgid = (int)L; { const int q = nwg / NXCD, r = nwg % NXCD, xcd = wgid % NXCD, off = wgid / NXCD; wgid = (xcd < r ? xcd * (q + 1) : r * (q + 1) + (xcd - r) * q) + off; }
        const int nig = WGM * nN, gid = wgid / nig, fm = gid * WGM, gsz = (nM - fm) < WGM ? (nM - fm) : WGM;
        u.pm = fm + ((wgid % nig) % gsz); u.pn = (wgid % nig) / gsz; return true;
    }
    __device__ __forceinline__ const char* aptr(const Unit& u) const { return A + (size_t)u.pm * a_pm + (size_t)u.pn * a_pn; }
    __device__ __forceinline__ const char* bptr(const Unit& u) const { const char* b = Bt + (size_t)u.pn * b_pn; if constexpr (MOE) b += (size_t)pexp[u.pm] * b_e; return b; }
};

template <class Epi, class SchedT>
__device__ __forceinline__ void gemm_phase(LAS unsigned char* lds, const int K, const int lda, const SchedT& S, const Epi& E) {
    const int tid = threadIdx.x, wid = __builtin_amdgcn_readfirstlane(tid >> 6), lane = tid & 63, wr = wid >> 2, wc = wid & 3, fr = lane & 15, fq = lane >> 4;
    const int nt = K / BK;
    unsigned voffA[2], voffB[2];
#pragma unroll
    for (int i = 0; i < 2; ++i) { int R, C; stage_rc(tid * 16 + i * 8192, R, C); const int Rb = (R & ~31) + perm32(R & 31);
        voffA[i] = (unsigned)(R * lda + C) * 2u; voffB[i] = (unsigned)(Rb * K + C) * 2u; }
    const size_t kstep = (size_t)(BK * 2);
    const size_t hstepA = (size_t)HALF * lda * 2, hstepB = (size_t)HALF * K * 2;
    const unsigned ldsw = (unsigned)wid * 1024u;
    const int aoff = lds_byte(wr * 64 + fr, fq * 8), boff = lds_byte(wc * 32 + fr, fq * 8);
#define PG8_SA(b, h) (((b) * 2 + (h)) * HTB)
#define PG8_SB(b, h) ((4 + (b) * 2 + (h)) * HTB)
#define PG8_STAGE(bufoff, gbase, voff) do { _Pragma("unroll") for (int _i = 0; _i < 2; ++_i) \
        __builtin_amdgcn_global_load_lds((const unsigned*)((const char*)(gbase) + (voff)[_i]), (LAS unsigned*)(lds + (bufoff) + ldsw + _i * 8192), 16, 0, 0); } while (0)
#define PG8_LDA(dst, b, h) do { _Pragma("unroll") for (int m = 0; m < 4; ++m) _Pragma("unroll") for (int k = 0; k < 2; ++k) dst[m][k] = *(const LAS bf16x8*)(lds + PG8_SA(b, h) + aoff + m * 2048 + k * 1024); } while (0)
#define PG8_LDB(dst, b, h) do { _Pragma("unroll") for (int n = 0; n < 2; ++n) _Pragma("unroll") for (int k = 0; k < 2; ++k) dst[n][k] = *(const LAS bf16x8*)(lds + PG8_SB(b, h) + boff + n * 2048 + k * 1024); } while (0)
#define PG8_MMA(ai, bj, At, Bt) do { __builtin_amdgcn_s_setprio(1); _Pragma("unroll") for (int m = 0; m < 4; ++m) _Pragma("unroll") for (int n = 0; n < 2; ++n) _Pragma("unroll") for (int k = 0; k < 2; ++k) \
        acc[ai][bj][m][n] = __builtin_amdgcn_mfma_f32_16x16x32_bf16(Bt[n][k], At[m][k], acc[ai][bj][m][n], 0, 0, 0); __builtin_amdgcn_s_setprio(0); } while (0)
#define PG8_WAIT_V(n) asm volatile("s_waitcnt vmcnt(" #n ")" ::: "memory")
#define PG8_WAIT_L(n) asm volatile("s_waitcnt lgkmcnt(" #n ")" ::: "memory")
#define PG8_BAR __builtin_amdgcn_s_barrier()
#define PG8_SCHED __builtin_amdgcn_sched_barrier(0)
    Unit cur, nxt; int ui = 0;
    if (!S.next(0, cur)) return;
    f32x4 acc[2][2][4][2];
#pragma unroll
    for (int a = 0; a < 2; ++a)
#pragma unroll
        for (int b = 0; b < 2; ++b)
#pragma unroll
            for (int m = 0; m < 4; ++m)
#pragma unroll
                for (int n = 0; n < 2; ++n) acc[a][b][m][n] = (f32x4){0.f, 0.f, 0.f, 0.f};
    bf16x8 At[4][2], B0[2][2], B1[2][2];
    const char* cA = S.aptr(cur); const char* cB = S.bptr(cur);
    PG8_STAGE(PG8_SB(0, 0), cB, voffB); PG8_STAGE(PG8_SB(0, 1), cB + hstepB, voffB); PG8_STAGE(PG8_SA(0, 0), cA, voffA); PG8_STAGE(PG8_SA(0, 1), cA + hstepA, voffA);
    if (wr == 1) PG8_BAR;
    PG8_WAIT_V(2); PG8_BAR;
    PG8_STAGE(PG8_SB(1, 0), cB + kstep, voffB); PG8_STAGE(PG8_SA(1, 0), cA + kstep, voffA); PG8_STAGE(PG8_SB(1, 1), cB + hstepB + kstep, voffB);
    PG8_WAIT_V(6); PG8_BAR;
    for (;;) {
        const bool has_next = S.next(ui + 1, nxt);
        const char* nA = has_next ? S.aptr(nxt) : cA; const char* nB = has_next ? S.bptr(nxt) : cB;
        for (int t = 0; t < nt; t += 2) {
            const bool last = (t == nt - 2);
            const char* a1 = cA + (size_t)(t + 1) * kstep;
            const char* a2 = last ? nA : cA + (size_t)(t + 2) * kstep; const char* b2 = last ? nB : cB + (size_t)(t + 2) * kstep;
            const char* a3 = a2 + kstep; const char* b3 = b2 + kstep;
            PG8_LDB(B0, 0, 0); PG8_LDB(B1, 0, 1); PG8_SCHED; PG8_LDA(At, 0, 0); PG8_STAGE(PG8_SA(1, 1), a1 + hstepA, voffA);
            PG8_WAIT_V(8); PG8_WAIT_L(0); PG8_BAR; PG8_MMA(0, 0, At, B0); PG8_MMA(0, 1, At, B1); PG8_BAR; PG8_SCHED;
            PG8_LDA(At, 0, 1); PG8_STAGE(PG8_SB(0, 0), b2, voffB); PG8_STAGE(PG8_SB(0, 1), b2 + hstepB, voffB); PG8_STAGE(PG8_SA(0, 0), a2, voffA);
            PG8_WAIT_V(8); PG8_WAIT_L(0); PG8_BAR; PG8_MMA(1, 0, At, B0); PG8_MMA(1, 1, At, B1); PG8_BAR; PG8_SCHED;
            PG8_LDB(B0, 1, 0); PG8_LDB(B1, 1, 1); PG8_SCHED; PG8_LDA(At, 1, 0); PG8_STAGE(PG8_SA(0, 1), a2 + hstepA, voffA);
            PG8_WAIT_V(8); PG8_WAIT_L(0); PG8_BAR; PG8_MMA(0, 0, At, B0); PG8_MMA(0, 1, At, B1); PG8_BAR; PG8_SCHED;
            PG8_LDA(At, 1, 1); PG8_STAGE(PG8_SB(1, 0), b3, voffB); PG8_STAGE(PG8_SB(1, 1), b3 + hstepB, voffB); PG8_STAGE(PG8_SA(1, 0), a3, voffA);
            PG8_WAIT_V(8); PG8_WAIT_L(0); PG8_BAR; PG8_MMA(1, 0, At, B0); PG8_MMA(1, 1, At, B1); PG8_BAR; PG8_SCHED;
        }
        if (wr == 0) PG8_BAR;
        E(acc, cur, wr, wc, fr, fq);
        if (!has_next) break;
#pragma unroll
        for (int a = 0; a < 2; ++a)
#pragma unroll
            for (int b = 0; b < 2; ++b)
#pragma unroll
                for (int m = 0; m < 4; ++m)
#pragma unroll
                    for (int n = 0; n < 2; ++n) acc[a][b][m][n] = (f32x4){0.f, 0.f, 0.f, 0.f};
        cur = nxt; cA = nA; cB = nB; ++ui;
        if (wr == 1) PG8_BAR;
    }
    PG8_WAIT_V(0);
    PG8_BAR;
#undef PG8_SA
#undef PG8_SB
#undef PG8_STAGE
#undef PG8_LDA
#undef PG8_LDB
#undef PG8_MMA
#undef PG8_WAIT_V
#undef PG8_WAIT_L
#undef PG8_BAR
#undef PG8_SCHED
}

typedef f32x4 Acc[2][2][4][2];
__device__ __forceinline__ float rstd_of(const float* ssqp, int row) {
    const f32x4* p = (const f32x4*)(ssqp + (size_t)row * 16); const f32x4 a = p[0], b = p[1], c = p[2], d = p[3];
    const float s = ((a[0] + a[1]) + (a[2] + a[3])) + ((b[0] + b[1]) + (b[2] + b[3])) + ((c[0] + c[1]) + (c[2] + c[3])) + ((d[0] + d[1]) + (d[2] + d[3]));
    return __builtin_amdgcn_rsqf(s * (1.0f / D) + EPS); }
__device__ __forceinline__ void ssq_store_single(float* ssqp, int row, float ss, int lane) { if (lane < 16) ssqp[(size_t)row * 16 + lane] = (lane == 0) ? ss : 0.f; }

template <int MODE> struct EpiProj {
    const float* ssq; const f32x2* tab; bf16_t* Q; bf16_t* Kk; bf16_t* V; bf16_t* Gt;
    __device__ __forceinline__ void operator()(const Acc& acc, const Unit& u, int wr, int wc, int fr, int fq) const {
        const int row0 = u.pm * BM + wr * 64 + fr; const int pn = u.pn;
        int seg, colt, ld; bf16_t* base;
        if (MODE == 0) { if (pn < 4) { seg = 0; colt = pn * 256; ld = 1024; base = Q; } else if (pn < 8) { seg = 1; colt = (pn - 4) * 256; ld = 1024; base = Kk; }
                         else if (pn < 16) { seg = 2; colt = (pn - 8) * 256; ld = 2048; base = V; } else { seg = 3; colt = (pn - 16) * 256; ld = 2048; base = Gt; } }
        else { ld = 1024; if (pn < 4) { seg = 4; colt = pn * 256; base = Q; } else if (pn < 8) { seg = 2; colt = (pn - 4) * 256; base = Kk; } else { seg = 2; colt = (pn - 8) * 256; base = V; } }
        const int col0 = colt + wc * 32 + 8 * fq;
#pragma unroll
        for (int ai = 0; ai < 2; ++ai)
#pragma unroll
            for (int m = 0; m < 4; ++m) {
                const int row = row0 + ai * HALF + m * 16;
                const float rs = rstd_of(ssq, row) * ((MODE == 1 && seg == 4) ? 0.18033688011112042f : 1.0f);
                const int p = row_pos(row);
#pragma unroll
                for (int bj = 0; bj < 2; ++bj) {
                    f32x4 v0 = acc[ai][bj][m][0] * rs, v1 = acc[ai][bj][m][1] * rs;
                    const int col = col0 + bj * HALF;
                    if (MODE == 0 && seg < 2) {
                        const int i0 = (col & 127) >> 1;
                        const f32x4 t0 = *(const f32x4*)(tab + p * 64 + i0), t1 = *(const f32x4*)(tab + p * 64 + i0 + 2);
                        f32x4 o0, o1;
                        o0[0] = v0[0] * t0[0] - v0[1] * t0[1]; o0[1] = v0[0] * t0[1] + v0[1] * t0[0];
                        o0[2] = v0[2] * t0[2] - v0[3] * t0[3]; o0[3] = v0[2] * t0[3] + v0[3] * t0[2];
                        o1[0] = v1[0] * t1[0] - v1[1] * t1[1]; o1[1] = v1[0] * t1[1] + v1[1] * t1[0];
                        o1[2] = v1[2] * t1[2] - v1[3] * t1[3]; o1[3] = v1[2] * t1[3] + v1[3] * t1[2];
                        float ks = (seg == 1) ? 0.08838834764831845f : 1.0f;
                        if (!NAIVE_RET) {
                            const int hh = ((pn & 3) << 1) + bj; const float l2g = __builtin_amdgcn_logf(1.0f - fast_exp2(-5.0f - (float)hh));
                            const int cl = row < MREAL ? (row & 127) : 112 + ((row - MREAL) & 15);
                            ks *= fast_exp2((seg == 0 ? (float)cl : -(float)cl) * l2g);
                        }
                        v0 = o0 * ks; v1 = o1 * ks;
                    }
                    if (MODE == 0 && seg == 3) {
#pragma unroll
                        for (int j = 0; j < 4; ++j) { v0[j] = silu_f(v0[j]); v1[j] = silu_f(v1[j]); }
                    }
                    u32x4 w; w.x = pk2(v0[0], v0[1]); w.y = pk2(v0[2], v0[3]); w.z = pk2(v1[0], v1[1]); w.w = pk2(v1[2], v1[3]);
                    *(u32x4*)(base + (size_t)row * ld + col) = w;
                }
            }
    }
};
struct EpiResid {
    bf16_t* H; float* ssq_out; const float* colscale;
    __device__ __forceinline__ void operator()(const Acc& acc, const Unit& u, int wr, int wc, int fr, int fq) const {
        const int row0 = u.pm * BM + wr * 64 + fr; const int col0 = u.pn * BM + wc * 32 + 8 * fq;
        f32x4 cs[2][2];
#pragma unroll
        for (int bj = 0; bj < 2; ++bj)
#pragma unroll
            for (int n = 0; n < 2; ++n) cs[bj][n] = colscale ? *(const f32x4*)(colscale + col0 + bj * HALF + 4 * n) : (f32x4){1.f, 1.f, 1.f, 1.f};
#pragma unroll
        for (int ai = 0; ai < 2; ++ai)
#pragma unroll
            for (int m = 0; m < 4; ++m) {
                const int row = row0 + ai * HALF + m * 16; float ss = 0.f;
#pragma unroll
                for (int bj = 0; bj < 2; ++bj) {
                    bf16_t* hp = H + (size_t)row * D + col0 + bj * HALF;
                    const u32x4 hv = *(const u32x4*)hp;
                    const f32x4 a0 = acc[ai][bj][m][0] * cs[bj][0], a1 = acc[ai][bj][m][1] * cs[bj][1];
                    u32x4 w;
                    w.x = pk2(bflo(hv.x) + a0[0], bfhi(hv.x) + a0[1]); w.y = pk2(bflo(hv.y) + a0[2], bfhi(hv.y) + a0[3]);
                    w.z = pk2(bflo(hv.z) + a1[0], bfhi(hv.z) + a1[1]); w.w = pk2(bflo(hv.w) + a1[2], bfhi(hv.w) + a1[3]);
                    *(u32x4*)hp = w;
                    ss += bflo(w.x) * bflo(w.x) + bfhi(w.x) * bfhi(w.x) + bflo(w.y) * bflo(w.y) + bfhi(w.y) * bfhi(w.y)
                        + bflo(w.z) * bflo(w.z) + bfhi(w.z) * bfhi(w.z) + bflo(w.w) * bflo(w.w) + bfhi(w.w) * bfhi(w.w);
                }
                ss += __shfl_xor(ss, 16); ss += __shfl_xor(ss, 32);
                if (fq == 0) ssq_out[(size_t)row * 16 + u.pn * 4 + wc] = ss;
            }
    }
};
template <bool ROWRSTD> struct EpiSwiglu {
    const float* rsrc; bf16_t* HID;
    __device__ __forceinline__ void operator()(const Acc& acc, const Unit& u, int wr, int wc, int fr, int fq) const {
        const int row0 = u.pm * BM + wr * 64 + fr; const int col0 = u.pn * HALF + wc * 32 + 8 * fq;
#pragma unroll
        for (int ai = 0; ai < 2; ++ai)
#pragma unroll
            for (int m = 0; m < 4; ++m) {
                const int row = row0 + ai * HALF + m * 16;
                const float rs = ROWRSTD ? rsrc[row] : rstd_of(rsrc, row);
                float o[8];
#pragma unroll
                for (int n = 0; n < 2; ++n)
#pragma unroll
                    for (int j = 0; j < 4; ++j) { const float uu = acc[ai][0][m][n][j] * rs, vv = acc[ai][1][m][n][j] * rs; o[4 * n + j] = silu_f(uu) * vv; }
                u32x4 w; w.x = pk2(o[0], o[1]); w.y = pk2(o[2], o[3]); w.z = pk2(o[4], o[5]); w.w = pk2(o[6], o[7]);
                *(u32x4*)(HID + (size_t)row * FF + col0) = w;
            }
    }
};
struct EpiMoeW2 {
    const float* gate; bf16_t* YS;
    __device__ __forceinline__ void operator()(const Acc& acc, const Unit& u, int wr, int wc, int fr, int fq) const {
        const int row0 = u.pm * BM + wr * 64 + fr; const int col0 = u.pn * BM + wc * 32 + 8 * fq;
#pragma unroll
        for (int ai = 0; ai < 2; ++ai)
#pragma unroll
            for (int m = 0; m < 4; ++m) {
                const int row = row0 + ai * HALF + m * 16; const float g = gate[row];
#pragma unroll
                for (int bj = 0; bj < 2; ++bj) {
                    const f32x4 v0 = acc[ai][bj][m][0] * g, v1 = acc[ai][bj][m][1] * g;
                    u32x4 w; w.x = pk2(v0[0], v0[1]); w.y = pk2(v0[2], v0[3]); w.z = pk2(v1[0], v1[1]); w.w = pk2(v1[2], v1[3]);
                    *(u32x4*)(YS + (size_t)row * D + col0 + bj * HALF) = w;
                }
            }
    }
};
}

#define XB_TMO      128
#define XB_XCNT(j)  (256  + 64 * (j))
#define XB_XSUB(j)  (1280 + 64 * (j))
#define XB_XGEN(j)  (2304 + 64 * (j))
#define XB_TOP      3328
#define XB_TOPGEN   3392
#define XCD_BAR_WORDS 3456
#define XB_SPIN_CAP (1u << 18)
__device__ __forceinline__ unsigned xb_ld(unsigned* p)              { return __hip_atomic_load(p, __ATOMIC_RELAXED, __HIP_MEMORY_SCOPE_AGENT); }
__device__ __forceinline__ unsigned xb_add(unsigned* p, unsigned v) { return __hip_atomic_fetch_add(p, v, __ATOMIC_RELAXED, __HIP_MEMORY_SCOPE_AGENT); }
__device__ __forceinline__ unsigned xb_xcc_id() { return (unsigned)__builtin_amdgcn_s_getreg((3 << 11) | 20) & 0xFu; }
#define XB_SPIN(cond, bar) do { unsigned _sp = 0; while (cond) { __builtin_amdgcn_s_sleep(1); \
    if ((++_sp & 255u) == 0u) { if (xb_ld(&(bar)[XB_TMO])) break; if (_sp > XB_SPIN_CAP) { atomicAdd(&(bar)[XB_TMO], 1u); break; } } } } while (0)
struct XcdBarrier { unsigned* bar; unsigned x; volatile LAS unsigned* st; };
__device__ __forceinline__ XcdBarrier xcd_barrier_post(unsigned* bar, volatile LAS unsigned* st) {
    XcdBarrier b; b.bar = bar; b.x = xb_xcc_id(); b.st = st;
    if (threadIdx.x == 0) (void)xb_add(&bar[XB_XCNT(b.x)], 1u);
    return b;
}
__device__ __forceinline__ void xcd_barrier_complete(unsigned* bar, unsigned x, unsigned& nloc, unsigned& nx) {
    const unsigned G = gridDim.x * gridDim.y * gridDim.z;
    unsigned sum, cnt, mine, sp = 0u;
    for (;;) {
        sum = 0u; cnt = 0u; mine = 0u;
#pragma unroll
        for (unsigned j = 0; j < 16; ++j) { const unsigned c = xb_ld(&bar[XB_XCNT(j)]); sum += c; cnt += (c > 0u) ? 1u : 0u; mine = (j == x) ? c : mine; }
        if (sum == G) break;
        __builtin_amdgcn_s_sleep(1);
        if ((++sp & 255u) == 0u) { if (xb_ld(&bar[XB_TMO])) break; if (sp > XB_SPIN_CAP) { atomicAdd(&bar[XB_TMO], 1u); break; } }
    }
    nloc = mine > 0u ? mine : 1u; nx = cnt > 0u ? cnt : 1u;
}
__device__ __forceinline__ void xcd_barrier(const XcdBarrier& b) {
    asm volatile("s_waitcnt vmcnt(0)" ::: "memory");
    __syncthreads();
    if (threadIdx.x == 0) {
        unsigned* bar = b.bar;
        __builtin_amdgcn_s_waitcnt(0);
        unsigned nloc = b.st[0], nx = b.st[1];
        if (nloc == 0u) { xcd_barrier_complete(bar, b.x, nloc, nx); b.st[0] = nloc; b.st[1] = nx; }
        const unsigned old = xb_add(&bar[XB_XSUB(b.x)], 1u);
        const unsigned gen = old / nloc;
        if (old + 1u == (gen + 1u) * nloc) {
            __builtin_amdgcn_fence(__ATOMIC_RELEASE, "agent");
            asm volatile("s_waitcnt vmcnt(0)" ::: "memory");
            const unsigned og = xb_add(&bar[XB_TOP], 1u);
            const unsigned tg = og / nx;
            if (og + 1u == (tg + 1u) * nx) xb_add(&bar[XB_TOPGEN], 1u);
            else XB_SPIN(xb_ld(&bar[XB_TOPGEN]) == tg, bar);
            __builtin_amdgcn_fence(__ATOMIC_ACQUIRE, "agent");
            xb_add(&bar[XB_XGEN(b.x)], 1u);
            asm volatile("s_waitcnt vmcnt(0)" ::: "memory");
        } else {
            XB_SPIN(xb_ld(&bar[XB_XGEN(b.x)]) == gen, bar);
            __builtin_amdgcn_fence(__ATOMIC_ACQUIRE, "agent");
            asm volatile("s_waitcnt vmcnt(0)" ::: "memory");
        }
    }
    __syncthreads();
}

struct Args { const float* in[22]; float* out; unsigned char* ws; int ph_lo, ph_hi; };

template <int MAP> __device__ __forceinline__ int map_row(int n) {
    if (MAP == 1) { const int i = n & 127; return (n & ~127) + 2 * (i & 63) + (i >> 6); }
    if (MAP == 2) return (n >> 7) * 256 + (n & 127);
    if (MAP == 3) return (n >> 7) * 256 + 128 + (n & 127);
    return n;
}
template <int MAP> __device__ __forceinline__ void wt_item(const float* W, int K, int ldw, int N, bf16_t* WT, const float* gain, LAS float* scr, int item, int lane) {
    const int nblk = N / 32, kb = item / nblk, nb = item % nblk, k0 = 64 * kb, n0 = 32 * nb;
#pragma unroll 8
    for (int i = 0; i < 32; ++i) { const int kk = 2 * i + (lane >> 5); const float g = gain ? gain[k0 + kk] : 1.0f; scr[kk * 33 + (lane & 31)] = W[(size_t)(k0 + kk) * ldw + n0 + (lane & 31)] * g; }
    LDS_WAIT(); asm volatile("" ::: "memory");
    const int c = lane & 7;
#pragma unroll
    for (int j = 0; j < 4; ++j) { const int n = (lane >> 3) + 8 * j; const LAS float* s = scr + (8 * c) * 33 + n;
        u32x4 o; o.x = pk2(s[0 * 33], s[1 * 33]); o.y = pk2(s[2 * 33], s[3 * 33]); o.z = pk2(s[4 * 33], s[5 * 33]); o.w = pk2(s[6 * 33], s[7 * 33]);
        *(u32x4*)(WT + (size_t)map_row<MAP>(n0 + n) * K + k0 + 8 * c) = o; }
    LDS_WAIT(); asm volatile("" ::: "memory");
}
template <int MAP> __device__ __forceinline__ void wt_matrix(const float* W, int K, int ldw, int N, bf16_t* WT, const float* gain, LAS float* scr, int gw, int NGW, int lane) {
    const int nitems = (K / 64) * (N / 32);
    for (int it = gw; it < nitems; it += NGW) wt_item<MAP>(W, K, ldw, N, WT, gain, scr, it, lane);
}

enum Phase { P_PRO = 0,
    P0_QKVG, P0_RET, P0_FIN, P0_WO, P0_W13, P0_W2,
    P1_QKV, P1_SB, P1_WO, P1_RA, P1_RB, P1_M13, P1_M2, P1_CMB,
    P2_PREP, P2_POOL, P2_W13, P2_W2,
    P3_QKVG, P3_RET, P3_FIN, P3_WO, P3_RA, P3_RB, P3_M13, P3_M2, P3_CMB,
    P_FINAL, P_COUNT };

struct Ctx {
    LAS unsigned char* lds; int tid, lane, wave, G, gw, NGW;
    const float* const* in; float* out; unsigned char* ws;
    bf16_t* H; float* ssq; float* gst; bf16_t* WA; bf16_t* WB; unsigned char* pool; unsigned char* misc; f32x2* tab; int* moe;
};

__device__ __forceinline__ void conv_ret(const Ctx& C, int j, int layer, bf16_t* mix, bf16_t* wo) {
    LAS float* scr = (LAS float*)(C.lds + C.wave * 16384);
    const float* g = C.in[2] + (size_t)layer * D;
    wt_matrix<1>(C.in[4] + (size_t)j * D * D, D, D, D, mix, g, scr, C.gw, C.NGW, C.lane);
    wt_matrix<1>(C.in[5] + (size_t)j * D * D, D, D, D, mix + (size_t)1024 * D, g, scr, C.gw, C.NGW, C.lane);
    wt_matrix<0>(C.in[6] + (size_t)j * D * 2 * D, D, 2 * D, 2 * D, mix + (size_t)2048 * D, g, scr, C.gw, C.NGW, C.lane);
    wt_matrix<0>(C.in[7] + (size_t)j * D * 2 * D, D, 2 * D, 2 * D, mix + (size_t)4096 * D, g, scr, C.gw, C.NGW, C.lane);
    wt_matrix<0>(C.in[8] + (size_t)j * 2 * D * D, 2 * D, D, D, wo, nullptr, scr, C.gw, C.NGW, C.lane);
}
__device__ __forceinline__ void conv_dense(const Ctx& C, int c, int layer, bf16_t* w13, bf16_t* w2) {
    LAS float* scr = (LAS float*)(C.lds + C.wave * 16384);
    const float* g = C.in[3] + (size_t)layer * D;
    wt_matrix<2>(C.in[14] + (size_t)c * D * FF, D, FF, FF, w13, g, scr, C.gw, C.NGW, C.lane);
    wt_matrix<3>(C.in[15] + (size_t)c * D * FF, D, FF, FF, w13, g, scr, C.gw, C.NGW, C.lane);
    wt_matrix<0>(C.in[16] + (size_t)c * FF * D, FF, D, D, w2, nullptr, scr, C.gw, C.NGW, C.lane);
}
__device__ __forceinline__ void conv_moe(const Ctx& C, int c, int layer, bf16_t* w13, bf16_t* w2) {
    LAS float* scr = (LAS float*)(C.lds + C.wave * 16384);
    const float* g = C.in[3] + (size_t)layer * D;
    for (int e = 0; e < NE; ++e) {
        wt_matrix<2>(C.in[18] + ((size_t)c * NE + e) * D * FF, D, FF, FF, w13 + (size_t)e * 5632 * D, g, scr, C.gw, C.NGW, C.lane);
        wt_matrix<3>(C.in[19] + ((size_t)c * NE + e) * D * FF, D, FF, FF, w13 + (size_t)e * 5632 * D, g, scr, C.gw, C.NGW, C.lane);
        wt_matrix<0>(C.in[20] + ((size_t)c * NE + e) * FF * D, FF, D, D, w2 + (size_t)e * D * FF, nullptr, scr, C.gw, C.NGW, C.lane);
    }
}

template <class Epi> __device__ __forceinline__ void run_dense(const Ctx& C, const bf16_t* A, int lda, size_t a_pn_bytes, const bf16_t* Bt, int K, int N, const Epi& E) {
    pg8::Sched<false> S; S.nM = MROWS / 256; S.nN = N / 256; S.nwg = S.nM * S.nN; S.G = C.G; S.c = (int)blockIdx.x;
    S.A = (const char*)A; S.Bt = (const char*)Bt; S.a_pm = (size_t)256 * lda * 2; S.a_pn = a_pn_bytes; S.b_pn = (size_t)256 * K * 2; S.b_e = 0; S.pexp = nullptr;
    pg8::gemm_phase(C.lds, K, lda, S, E);
}
template <class Epi> __device__ __forceinline__ void run_moe(const Ctx& C, const int* seg, const bf16_t* A, const bf16_t* Bt, size_t b_e_bytes, int K, int N, const Epi& E) {
    LAS int* pexp = (LAS int*)(C.lds + LDS_PEXP);
    const int total = seg[8] / 256;
    for (int p = C.tid; p < total; p += 512) { int e = 0;
#pragma unroll
        for (int j = 1; j < 8; ++j) e += (p * 256 >= seg[j]) ? 1 : 0;
        pexp[p] = e; }
    __syncthreads();
    pg8::Sched<true> S; S.nM = total; S.nN = N / 256; S.nwg = S.nM * S.nN; S.G = C.G; S.c = (int)blockIdx.x;
    S.A = (const char*)A; S.Bt = (const char*)Bt; S.a_pm = (size_t)256 * K * 2; S.a_pn = 0; S.b_pn = (size_t)256 * K * 2; S.b_e = b_e_bytes; S.pexp = pexp;
    pg8::gemm_phase(C.lds, K, K, S, E);
    __syncthreads();
}

__device__ __forceinline__ void ret_finalize(const Ctx& C, int j, const bf16_t* Y, const bf16_t* YM, bf16_t* Gt, const float* gst) {
    const float* gn = C.in[9] + (size_t)j * 2 * D;
    for (int row = C.gw; row < MVALID; row += C.NGW) {
        const bf16_t* yrow = row < MREAL ? Y + (size_t)row * 2048 : YM + (size_t)(row - MREAL) * 2048;
#pragma unroll
        for (int q = 0; q < 4; ++q) {
            const int col = q * 512 + C.lane * 8, h = col >> 8;
            const f32x4 ga = *(const f32x4*)(gst + ((size_t)row * 8 + h) * 8), gb = *(const f32x4*)(gst + ((size_t)row * 8 + h) * 8 + 4);
            const float s1 = (ga[0] + ga[2]) + (gb[0] + gb[2]), s2 = (ga[1] + ga[3]) + (gb[1] + gb[3]);
            const float mu = s1 * (1.0f / 256.0f); const float var = fmaxf(s2 * (1.0f / 256.0f) - mu * mu, 0.f); const float rs = __builtin_amdgcn_rsqf(var + EPS);
            const u32x4 yv = *(const u32x4*)(yrow + col); const u32x4 gv = *(const u32x4*)(Gt + (size_t)row * 2048 + col);
            const f32x4 g0 = *(const f32x4*)(gn + col), g1 = *(const f32x4*)(gn + col + 4);
            u32x4 w;
            w.x = pk2(bflo(gv.x) * (bflo(yv.x) - mu) * rs * g0[0], bfhi(gv.x) * (bfhi(yv.x) - mu) * rs * g0[1]);
            w.y = pk2(bflo(gv.y) * (bflo(yv.y) - mu) * rs * g0[2], bfhi(gv.y) * (bfhi(yv.y) - mu) * rs * g0[3]);
            w.z = pk2(bflo(gv.z) * (bflo(yv.z) - mu) * rs * g1[0], bfhi(gv.z) * (bfhi(yv.z) - mu) * rs * g1[1]);
            w.w = pk2(bflo(gv.w) * (bflo(yv.w) - mu) * rs * g1[2], bfhi(gv.w) * (bfhi(yv.w) - mu) * rs * g1[3]);
            *(u32x4*)(Gt + (size_t)row * 2048 + col) = w;
        }
    }
}

__device__ __forceinline__ void ret_naive(const Ctx& C, const bf16_t* Q, const bf16_t* Kk, bf16_t* V, bf16_t* YM, float* gst) {
    for (int item = blockIdx.x; item < NBATCH * 8 * 2; item += C.G) {
        const int half = item & 1, h = (item >> 1) & 7, b = item >> 4;
        if (C.tid < 128) {
            const int e = half * 128 + C.tid;
            const float gamma = 1.0f - exp2f(-5.0f - (float)h);
            float S[128];
#pragma unroll
            for (int d = 0; d < 128; ++d) S[d] = 0.f;
            for (int p = 0; p < LPOS; ++p) {
                const int row = pos_row(b, p);
                const u32x4* qp = (const u32x4*)(Q + (size_t)row * D + h * 128);
                const u32x4* kp = (const u32x4*)(Kk + (size_t)row * D + h * 128);
                bf16_t* vp = V + (size_t)row * 2048 + h * 256 + e;
                const float v = bf1(*vp);
                float y = 0.f;
#pragma unroll
                for (int jj = 0; jj < 16; ++jj) {
                    const u32x4 kq = kp[jj], qq = qp[jj];
                    const unsigned kw[4] = {kq.x, kq.y, kq.z, kq.w}, qw[4] = {qq.x, qq.y, qq.z, qq.w};
#pragma unroll
                    for (int i = 0; i < 4; ++i) {
                        S[8 * jj + 2 * i] = gamma * S[8 * jj + 2 * i] + bflo(kw[i]) * v; y += bflo(qw[i]) * S[8 * jj + 2 * i];
                        S[8 * jj + 2 * i + 1] = gamma * S[8 * jj + 2 * i + 1] + bfhi(kw[i]) * v; y += bfhi(qw[i]) * S[8 * jj + 2 * i + 1];
                    }
                }
                if (p >= NMETA || b == 0) {
                    if (p >= NMETA) *vp = (bf16_t)f2bf(y); else YM[(size_t)p * 2048 + h * 256 + e] = (bf16_t)f2bf(y);
                    const float s1 = wave_sum(y), s2 = wave_sum(y * y);
                    if (C.lane == 0) { *(f32x2*)(gst + ((size_t)row * 8 + h) * 8 + (half * 2 + C.wave) * 2) = (f32x2){s1, s2}; }
                }
            }
        }
    }
}


namespace retm {
typedef float f32x16 __attribute__((ext_vector_type(16)));
typedef short s16x4 __attribute__((ext_vector_type(4)));
typedef short v4i16_t __attribute__((ext_vector_type(4)));
constexpr int L_KROW = 0, L_KTR = 32768, L_V = 65536, L_ST = 98304;
__device__ __forceinline__ int crow(int r, int hi) { return (r & 3) + 8 * (r >> 2) + 4 * hi; }
__device__ __forceinline__ s16x4 vtr(const LAS unsigned char* p) { return __builtin_bit_cast(s16x4, __builtin_amdgcn_ds_read_tr16_b64_v4i16((LAS v4i16_t*)p)); }
__device__ __forceinline__ float partner32(float x, int hi) { auto rr = __builtin_amdgcn_permlane32_swap(__float_as_uint(x), __float_as_uint(x), false, false); return __uint_as_float(hi ? rr[0] : rr[1]); }
__device__ __forceinline__ int grow(int b, int i, int j) { return i == 0 ? (j >= 112 ? MREAL + (j - 112) : MVALID) : b * SEQ + (i - 1) * 128 + j; }
__device__ __forceinline__ bf16x8 pack8(const f32x16& v, int o) { u32x4 a; a.x = pk2(v[o], v[o + 1]); a.y = pk2(v[o + 2], v[o + 3]); a.z = pk2(v[o + 4], v[o + 5]); a.w = pk2(v[o + 6], v[o + 7]); return __builtin_bit_cast(bf16x8, a); }
__device__ __forceinline__ bf16x8 trfrag(const LAS unsigned char* p) { const s16x4 a = vtr(p), c = vtr(p + 512); return (bf16x8){a[0], a[1], a[2], a[3], c[0], c[1], c[2], c[3]}; }

__device__ __forceinline__ void stats_flush(const LAS float* st, int b, int h, int half, int i, float* gst, int tid) {
    if (tid < 128) {
        const int j = tid; const bool ok = (i > 0) || (j >= 112 && b == 0);
        if (ok) { const int row = grow(b, i, j);
            const LAS f32x2* p = (const LAS f32x2*)(st + j * 8);
            const f32x2 a = p[0], c = p[1], d = p[2], e = p[3];
            *(f32x4*)(gst + ((size_t)row * 8 + h) * 8 + half * 4) = (f32x4){a[0] + c[0], a[1] + c[1], d[0] + e[0], d[1] + e[1]}; }
    }
}

__device__ __forceinline__ void ret_item(LAS unsigned char* lds, int b, int h, int half, const bf16_t* Q, const bf16_t* K, bf16_t* V, bf16_t* YM, float* gst, int wid, int lane, int tid) {
    const int r32 = lane & 31, hi = lane >> 5, et = wid & 3;
    const float gamma = 1.0f - exp2f(-5.0f - (float)h); const float g128 = exp2f(128.0f * log2f(gamma));
    f32x16 T[4];
#pragma unroll
    for (int d = 0; d < 4; ++d) T[d] = (f32x16){};
    LAS float* st = (LAS float*)(lds + L_ST);
    const int trq = (lane & 15) >> 2, trp = lane & 3, trb = (lane >> 4) & 1;
    const int troff = (4 * hi + trq) * 64 + trb * 32 + trp * 8;
    for (int i = 0; i < 17; ++i) {
        asm volatile("s_waitcnt lgkmcnt(0)" ::: "memory"); __builtin_amdgcn_s_barrier(); asm volatile("" ::: "memory");
        if (i > 0) stats_flush(st, b, h, half, i - 1, gst, tid);
#pragma unroll
        for (int u = 0; u < 4; ++u) {
            const int pc = wid * 4 + u;
            { const int ch = pc >> 1, rh = pc & 1; const int row = grow(b, i, rh * 64 + lane);
              __builtin_amdgcn_global_load_lds((const unsigned*)(K + (size_t)row * D + h * 128 + ch * 8), (LAS unsigned*)(lds + L_KROW + pc * 1024), 16, 0, 0); }
            { const int cbk = pc >> 3, rg = pc & 7; const int row = grow(b, i, rg * 16 + (lane >> 2));
              __builtin_amdgcn_global_load_lds((const unsigned*)(K + (size_t)row * D + h * 128 + cbk * 32 + (lane & 3) * 8), (LAS unsigned*)(lds + L_KTR + pc * 1024), 16, 0, 0);
              __builtin_amdgcn_global_load_lds((const unsigned*)(V + (size_t)row * 2048 + h * 256 + half * 128 + cbk * 32 + (lane & 3) * 8), (LAS unsigned*)(lds + L_V + pc * 1024), 16, 0, 0); }
        }
        asm volatile("s_waitcnt vmcnt(0)" ::: "memory"); __builtin_amdgcn_s_barrier(); asm volatile("" ::: "memory");
#pragma unroll
        for (int d = 0; d < 4; ++d) T[d] *= g128;
#pragma unroll
        for (int cbi = 0; cbi < 2; ++cbi) {
            const int cb = (wid < 4) ? (cbi ? 3 : 0) : (cbi ? 2 : 1);
            const int jrow = 32 * cb + r32; const int row = grow(b, i, jrow);
            bf16x8 qf[8];
            { const bf16_t* qp = Q + (size_t)row * D + h * 128 + 4 * hi;
#pragma unroll
              for (int ks = 0; ks < 8; ++ks) { const u32x2 a = *(const u32x2*)(qp + 16 * ks), c = *(const u32x2*)(qp + 16 * ks + 8); const u32x4 t = {a.x, a.y, c.x, c.y}; qf[ks] = __builtin_bit_cast(bf16x8, t); } }
            f32x16 yT = {};
#pragma unroll
            for (int db = 0; db < 4; ++db) {
                yT = __builtin_amdgcn_mfma_f32_32x32x16_bf16(pack8(T[db], 0), qf[2 * db], yT, 0, 0, 0);
                yT = __builtin_amdgcn_mfma_f32_32x32x16_bf16(pack8(T[db], 8), qf[2 * db + 1], yT, 0, 0, 0);
            }
            for (int sb = 0; sb <= cb; ++sb) {
                f32x16 sc = {};
                const LAS unsigned char* kr = lds + L_KROW + (32 * sb + r32) * 16 + 8 * hi;
#pragma unroll
                for (int ks = 0; ks < 8; ++ks) { const u32x2 a = *(const LAS u32x2*)(kr + (2 * ks) * 2048), c = *(const LAS u32x2*)(kr + (2 * ks + 1) * 2048); const u32x4 t = {a.x, a.y, c.x, c.y};
                    sc = __builtin_amdgcn_mfma_f32_32x32x16_bf16(__builtin_bit_cast(bf16x8, t), qf[ks], sc, 0, 0, 0); }
                if (sb == cb) {
#pragma unroll
                    for (int r = 0; r < 16; ++r) if (crow(r, hi) > r32) sc[r] = 0.f;
                }
                const LAS unsigned char* vb = lds + L_V + et * 8192 + (32 * sb) * 64 + troff;
                yT = __builtin_amdgcn_mfma_f32_32x32x16_bf16(trfrag(vb), pack8(sc, 0), yT, 0, 0, 0);
                yT = __builtin_amdgcn_mfma_f32_32x32x16_bf16(trfrag(vb + 1024), pack8(sc, 8), yT, 0, 0, 0);
            }
            float s1 = 0.f, s2 = 0.f;
#pragma unroll
            for (int r = 0; r < 16; ++r) { s1 += yT[r]; s2 += yT[r] * yT[r]; }
            s1 += partner32(s1, hi); s2 += partner32(s2, hi);
            if (hi == 0) *(LAS f32x2*)(st + jrow * 8 + et * 2) = (f32x2){s1, s2};
            const bool ok = (i > 0) || (jrow >= 112 && b == 0);
            if (ok) {
                bf16_t* yp = (i > 0 ? V + (size_t)row * 2048 : YM + (size_t)(row - MREAL) * 2048) + h * 256 + half * 128 + et * 32 + 4 * hi;
#pragma unroll
                for (int g = 0; g < 4; ++g) { u32x2 w; w.x = pk2(yT[4 * g], yT[4 * g + 1]); w.y = pk2(yT[4 * g + 2], yT[4 * g + 3]); *(u32x2*)(yp + 8 * g) = w; }
            }
        }
#pragma unroll
        for (int ks = 0; ks < 8; ++ks) {
            const bf16x8 vf = trfrag(lds + L_V + et * 8192 + (16 * ks) * 64 + troff);
#pragma unroll
            for (int db = 0; db < 4; ++db) T[db] = __builtin_amdgcn_mfma_f32_32x32x16_bf16(trfrag(lds + L_KTR + db * 8192 + (16 * ks) * 64 + troff), vf, T[db], 0, 0, 0);
        }
    }
    asm volatile("s_waitcnt lgkmcnt(0)" ::: "memory"); __builtin_amdgcn_s_barrier(); asm volatile("" ::: "memory");
    stats_flush(st, b, h, half, 16, gst, tid);
}
}
__device__ __forceinline__ void ret_mfma(const Ctx& C, const bf16_t* Q, const bf16_t* Kk, bf16_t* V, bf16_t* YM, float* gst) {
    for (int item = blockIdx.x; item < NBATCH * 8 * 2; item += C.G) {
        const int half = item & 1, h = (item >> 1) & 7, b = item >> 4;
        retm::ret_item(C.lds, b, h, half, Q, Kk, V, YM, gst, C.wave, C.lane, C.tid);
    }
    asm volatile("s_waitcnt vmcnt(0)" ::: "memory");
    __syncthreads();
}

__device__ __forceinline__ void sb_naive(const Ctx& C, bf16_t* Q, const bf16_t* Kk, const bf16_t* V) {
    const int NIT = NBATCH * 16 * 32 + 16;
    for (int it = (NAIVE_SB ? C.gw : NBATCH * 16 * 32 + C.gw); it < NIT; it += C.NGW) {
        int b, h, p0, nq;
        if (it < NBATCH * 16 * 32) { const int bh = it & 255, qb = it >> 8; b = bh >> 4; h = bh & 15; p0 = NMETA + qb * 64; nq = 64; }
        else { b = 0; h = it - NBATCH * 16 * 32; p0 = 0; nq = 16; }
        const int p = p0 + C.lane; const bool valid = C.lane < nq;
        const int row = pos_row(b, valid ? p : p0);
        float q[64], o[64];
        { const u32x4* qp = (const u32x4*)(Q + (size_t)row * D + h * 64);
#pragma unroll
          for (int jj = 0; jj < 8; ++jj) { const u32x4 t = qp[jj]; q[8 * jj] = bflo(t.x); q[8 * jj + 1] = bfhi(t.x); q[8 * jj + 2] = bflo(t.y); q[8 * jj + 3] = bfhi(t.y); q[8 * jj + 4] = bflo(t.z); q[8 * jj + 5] = bfhi(t.z); q[8 * jj + 6] = bflo(t.w); q[8 * jj + 7] = bfhi(t.w); } }
#pragma unroll
        for (int d = 0; d < 64; ++d) o[d] = 0.f;
        float P = 1.0f;
        for (int s = p0 + nq - 2; s >= 0; --s) {
            const int krow = pos_row(b, s);
            const u32x4* kp = (const u32x4*)(Kk + (size_t)krow * D + h * 64);
            const u32x4* vp = (const u32x4*)(V + (size_t)krow * D + h * 64);
            float z = 0.f;
#pragma unroll
            for (int jj = 0; jj < 8; ++jj) { const u32x4 t = kp[jj];
                z += q[8 * jj] * bflo(t.x) + q[8 * jj + 1] * bfhi(t.x) + q[8 * jj + 2] * bflo(t.y) + q[8 * jj + 3] * bfhi(t.y) + q[8 * jj + 4] * bflo(t.z) + q[8 * jj + 5] * bfhi(t.z) + q[8 * jj + 6] * bflo(t.w) + q[8 * jj + 7] * bfhi(t.w); }
            z = fminf(z, 100.f);
            const float E = fast_exp2(z), r = fast_rcp(1.0f + E);
            const bool act = valid && (s < p);
            const float w = act ? E * r * P : 0.f;
            P = act ? P * r : P;
#pragma unroll
            for (int jj = 0; jj < 8; ++jj) { const u32x4 t = vp[jj];
                o[8 * jj] += w * bflo(t.x); o[8 * jj + 1] += w * bfhi(t.x); o[8 * jj + 2] += w * bflo(t.y); o[8 * jj + 3] += w * bfhi(t.y); o[8 * jj + 4] += w * bflo(t.z); o[8 * jj + 5] += w * bfhi(t.z); o[8 * jj + 6] += w * bflo(t.w); o[8 * jj + 7] += w * bfhi(t.w); }
        }
        if (valid) { u32x4* op = (u32x4*)(Q + (size_t)row * D + h * 64);
#pragma unroll
            for (int jj = 0; jj < 8; ++jj) { u32x4 t; t.x = pk2(o[8 * jj], o[8 * jj + 1]); t.y = pk2(o[8 * jj + 2], o[8 * jj + 3]); t.z = pk2(o[8 * jj + 4], o[8 * jj + 5]); t.w = pk2(o[8 * jj + 6], o[8 * jj + 7]); op[jj] = t; } }
    }
}


namespace sbm {
typedef float f32x16 __attribute__((ext_vector_type(16)));
typedef short s16x4 __attribute__((ext_vector_type(4)));
typedef short v4i16_t __attribute__((ext_vector_type(4)));
constexpr int SLOTB = 8192, LDS_K = 0, LDS_V = 3 * SLOTB;
__device__ __forceinline__ int crow(int r, int hi) { return (r & 3) + 8 * (r >> 2) + 4 * hi; }
__device__ __forceinline__ s16x4 vtr(const LAS unsigned char* p) { return __builtin_bit_cast(s16x4, __builtin_amdgcn_ds_read_tr16_b64_v4i16((LAS v4i16_t*)p)); }
__device__ __forceinline__ float partner32(float x, int hi) { auto rr = __builtin_amdgcn_permlane32_swap(__float_as_uint(x), __float_as_uint(x), false, false); return __uint_as_float(hi ? rr[0] : rr[1]); }

__device__ __forceinline__ void sb_block(const f32x16& p, float& Pin, int hi, bf16x8& f0, bf16x8& f1) {
    float rr[16], be[16];
#pragma unroll
    for (int r = 0; r < 16; ++r) { const float E = fast_exp2(fminf(p[r], 100.f)); rr[r] = fast_rcp(1.0f + E); be[r] = E * rr[r]; }
    float G[4], PG[4];
#pragma unroll
    for (int g = 0; g < 4; ++g) { G[g] = (rr[4 * g] * rr[4 * g + 1]) * (rr[4 * g + 2] * rr[4 * g + 3]); PG[g] = partner32(G[g], hi); }
    float R[4]; R[3] = 1.0f; R[2] = G[3] * PG[3]; R[1] = R[2] * (G[2] * PG[2]); R[0] = R[1] * (G[1] * PG[1]);
    const float tot = R[0] * (G[0] * PG[0]);
    float w[16];
#pragma unroll
    for (int g = 0; g < 4; ++g) {
        float sfx = Pin * R[g] * (hi ? 1.0f : PG[g]);
        w[4 * g + 3] = be[4 * g + 3] * sfx; sfx *= rr[4 * g + 3];
        w[4 * g + 2] = be[4 * g + 2] * sfx; sfx *= rr[4 * g + 2];
        w[4 * g + 1] = be[4 * g + 1] * sfx; sfx *= rr[4 * g + 1];
        w[4 * g] = be[4 * g] * sfx;
    }
    Pin *= tot;
    u32x4 a, b;
    a.x = pk2(w[0], w[1]); a.y = pk2(w[2], w[3]); a.z = pk2(w[4], w[5]); a.w = pk2(w[6], w[7]);
    b.x = pk2(w[8], w[9]); b.y = pk2(w[10], w[11]); b.z = pk2(w[12], w[13]); b.w = pk2(w[14], w[15]);
    f0 = __builtin_bit_cast(bf16x8, a); f1 = __builtin_bit_cast(bf16x8, b);
}

__device__ __forceinline__ void sb_unit(LAS unsigned char* lds, int b, int h, int qi, bf16_t* Q, const bf16_t* K, const bf16_t* V, int wid, int lane) {
    const int r32 = lane & 31, hi = lane >> 5;
    const size_t rowbase = (size_t)b * SEQ;
    const int q0 = qi * 256, NT = 4 * (qi + 1);
    bf16_t* qrow = Q + (rowbase + q0 + wid * 32 + r32) * D + h * 64;
    bf16x8 qf[4];
#pragma unroll
    for (int d0 = 0; d0 < 4; ++d0) qf[d0] = *(const bf16x8*)(qrow + d0 * 16 + hi * 8);
    const int vkey = 16 * (wid & 3) + (lane >> 2);
    const bf16_t* ksrc = K + (rowbase + lane) * D + h * 64 + wid * 8;
    const bf16_t* vsrc = V + (rowbase + vkey) * D + h * 64 + (wid >> 2) * 32 + (lane & 3) * 8;
    const bf16_t* ksrc_m = K + (size_t)(MREAL + (lane < 16 ? lane : 15)) * D + h * 64 + wid * 8;
    const bf16_t* vsrc_m = V + (size_t)(MREAL + (vkey < 16 ? vkey : 15)) * D + h * 64 + (wid >> 2) * 32 + (lane & 3) * 8;
#define SB_ISSUE(step) do { const int _st = (step); const int _sl = _st % 3; const int _tt = NT - 1 - _st; \
        const bf16_t* _k = _tt >= 0 ? ksrc + (size_t)_tt * 64 * D : ksrc_m; const bf16_t* _v = _tt >= 0 ? vsrc + (size_t)_tt * 64 * D : vsrc_m; \
        __builtin_amdgcn_global_load_lds((const unsigned*)_k, (LAS unsigned*)(lds + LDS_K + _sl * SLOTB + wid * 1024), 16, 0, 0); \
        __builtin_amdgcn_global_load_lds((const unsigned*)_v, (LAS unsigned*)(lds + LDS_V + _sl * SLOTB + wid * 1024), 16, 0, 0); } while (0)
    SB_ISSUE(0); SB_ISSUE(1);
    f32x16 o0 = {}, o1 = {};
    float Pin = 1.0f;
    const int qrel = wid * 32 + r32;
    for (int st = 0; st <= NT; ++st) {
        if (st < NT) asm volatile("s_waitcnt vmcnt(2)" ::: "memory"); else asm volatile("s_waitcnt vmcnt(0)" ::: "memory");
        __builtin_amdgcn_s_barrier(); asm volatile("" ::: "memory");
        if (st + 2 <= NT) SB_ISSUE(st + 2);
        const int sl = st % 3;
        const bool meta = (st == NT);
        const int jb = 3 - st;
        if (st < 4 && 64 * jb > wid * 32 + 31) continue;
        const LAS unsigned char* kb = lds + LDS_K + sl * SLOTB + hi * 1024 + r32 * 16;
        const LAS unsigned char* vb = lds + LDS_V + sl * SLOTB + ((lane >> 4) & 1) * 32 + (lane & 3) * 8 + (4 * hi + ((lane & 15) >> 2)) * 64;
        f32x16 p0 = {}, p1 = {};
#pragma unroll
        for (int d0 = 0; d0 < 4; ++d0) {
            const bf16x8 k0 = *(const LAS bf16x8*)(kb + d0 * 2048), k1 = *(const LAS bf16x8*)(kb + d0 * 2048 + 512);
            p0 = __builtin_amdgcn_mfma_f32_32x32x16_bf16(k0, qf[d0], p0, 0, 0, 0);
            p1 = __builtin_amdgcn_mfma_f32_32x32x16_bf16(k1, qf[d0], p1, 0, 0, 0);
        }
        if (st < 4) {
#pragma unroll
            for (int r = 0; r < 16; ++r) { const int kv = 64 * jb + crow(r, hi); if (kv >= qrel) p0[r] = -1.0e30f; if (kv + 32 >= qrel) p1[r] = -1.0e30f; }
        }
        if (meta) {
#pragma unroll
            for (int r = 0; r < 16; ++r) { if (crow(r, hi) >= NMETA) p0[r] = -1.0e30f; p1[r] = -1.0e30f; }
        }
        bf16x8 pf[4];
        sb_block(p1, Pin, hi, pf[2], pf[3]);
        sb_block(p0, Pin, hi, pf[0], pf[1]);
#pragma unroll
        for (int ks = 0; ks < 4; ++ks) {
            const s16x4 a0 = vtr(vb + ks * 1024), a1 = vtr(vb + ks * 1024 + 512), c0 = vtr(vb + 4096 + ks * 1024), c1 = vtr(vb + 4096 + ks * 1024 + 512);
            const bf16x8 va = {a0[0], a0[1], a0[2], a0[3], a1[0], a1[1], a1[2], a1[3]}, vc = {c0[0], c0[1], c0[2], c0[3], c1[0], c1[1], c1[2], c1[3]};
            o0 = __builtin_amdgcn_mfma_f32_32x32x16_bf16(va, pf[ks], o0, 0, 0, 0);
            o1 = __builtin_amdgcn_mfma_f32_32x32x16_bf16(vc, pf[ks], o1, 0, 0, 0);
        }
    }
#undef SB_ISSUE
#pragma unroll
    for (int g = 0; g < 4; ++g) {
        u32x2 w0, w1; w0.x = pk2(o0[4 * g], o0[4 * g + 1]); w0.y = pk2(o0[4 * g + 2], o0[4 * g + 3]); w1.x = pk2(o1[4 * g], o1[4 * g + 1]); w1.y = pk2(o1[4 * g + 2], o1[4 * g + 3]);
        *(u32x2*)(qrow + 8 * g + 4 * hi) = w0; *(u32x2*)(qrow + 32 + 8 * g + 4 * hi) = w1;
    }
    asm volatile("s_waitcnt lgkmcnt(0)" ::: "memory");
    __builtin_amdgcn_s_barrier(); asm volatile("" ::: "memory");
}
}
__device__ __forceinline__ void sb_mfma(const Ctx& C, bf16_t* Q, const bf16_t* Kk, const bf16_t* V) {
    const int bx = (int)blockIdx.x, vcu = (C.G % 8 == 0) ? (bx % 8) * (C.G / 8) + bx / 8 : bx;
    for (int pi = vcu; pi < NBATCH * 16 * 4; pi += C.G) {
        const int bh = pi >> 2, s4 = pi & 3;
        sbm::sb_unit(C.lds, bh >> 4, bh & 15, 7 - s4, Q, Kk, V, C.wave, C.lane);
        sbm::sb_unit(C.lds, bh >> 4, bh & 15, s4, Q, Kk, V, C.wave, C.lane);
    }
    asm volatile("s_waitcnt vmcnt(0)" ::: "memory");
    __syncthreads();
}

constexpr int ROWS_PER_WG = 129;
__device__ __forceinline__ void router_a(const Ctx& C, int c, int layer, const float* ssq, int* cnt_wg) {
    LAS float* wr = (LAS float*)C.lds;
    LAS int* lcnt = (LAS int*)(C.lds + 32768);
    const float* Wr = C.in[17] + (size_t)c * D * NE; const float* g = C.in[3] + (size_t)layer * D;
    for (int i = C.tid; i < D * NE; i += 512) { const int k = i >> 3, e = i & 7; wr[e * D + k] = Wr[i] * g[k]; }
    if (C.tid < NE) lcnt[C.tid] = 0;
    __syncthreads();
    int2* toke = (int2*)(C.misc + MISC_TOKE); f32x2* tokg = (f32x2*)(C.misc + MISC_TOKG); int2* tokr = (int2*)(C.misc + MISC_TOKR);
    const int r0 = (int)blockIdx.x * ROWS_PER_WG;
    for (int rr = C.wave; rr < ROWS_PER_WG; rr += 8) {
        const int row = r0 + rr; if (row >= MVALID) break;
        float hv[16];
#pragma unroll
        for (int q = 0; q < 2; ++q) { const u32x4 t = *(const u32x4*)(C.H + (size_t)row * D + q * 512 + C.lane * 8);
            hv[8 * q] = bflo(t.x); hv[8 * q + 1] = bfhi(t.x); hv[8 * q + 2] = bflo(t.y); hv[8 * q + 3] = bfhi(t.y); hv[8 * q + 4] = bflo(t.z); hv[8 * q + 5] = bfhi(t.z); hv[8 * q + 6] = bflo(t.w); hv[8 * q + 7] = bfhi(t.w); }
        float lg[NE];
#pragma unroll
        for (int e = 0; e < NE; ++e) { float s = 0.f;
#pragma unroll
            for (int q = 0; q < 2; ++q) { const f32x4 w0 = *(const LAS f32x4*)(wr + e * D + q * 512 + C.lane * 8), w1 = *(const LAS f32x4*)(wr + e * D + q * 512 + C.lane * 8 + 4);
                s += hv[8 * q] * w0[0] + hv[8 * q + 1] * w0[1] + hv[8 * q + 2] * w0[2] + hv[8 * q + 3] * w0[3] + hv[8 * q + 4] * w1[0] + hv[8 * q + 5] * w1[1] + hv[8 * q + 6] * w1[2] + hv[8 * q + 7] * w1[3]; }
            lg[e] = wave_sum(s); }
        if (C.lane == 0) {
            const float rs = pg8::rstd_of(ssq, row);
            int e0 = 0; float v0 = lg[0];
#pragma unroll
            for (int e = 1; e < NE; ++e) if (lg[e] > v0) { v0 = lg[e]; e0 = e; }
            int e1 = -1; float v1 = -3.0e38f;
#pragma unroll
            for (int e = 0; e < NE; ++e) if (e != e0 && lg[e] > v1) { v1 = lg[e]; e1 = e; }
            const float g1 = fast_rcp(1.0f + __expf((v0 - v1) * rs)), g0 = 1.0f - g1;
            const int k0 = atomicAdd((int*)&lcnt[e0], 1), k1 = atomicAdd((int*)&lcnt[e1], 1);
            toke[row] = make_int2(e0, e1); tokg[row] = (f32x2){g0, g1}; tokr[row] = make_int2(k0, k1);
        }
    }
    __syncthreads();
    if (C.tid < NE) cnt_wg[(int)blockIdx.x * NE + C.tid] = lcnt[C.tid];
    __syncthreads();
}
__device__ __forceinline__ void router_b(const Ctx& C, const float* ssq, const int* cnt_wg, int* seg_out, bf16_t* XS) {
    LAS int* tot = (LAS int*)C.lds;
    LAS int* part = (LAS int*)(C.lds + 1024);
    { const int e = C.tid & 7, sl = C.tid >> 3; int all = 0, before = 0;
#pragma unroll
      for (int j = 0; j < 4; ++j) { const int w = sl * 4 + j; const int v = cnt_wg[w * NE + e]; all += v; before += (w < (int)blockIdx.x) ? v : 0; }
      all += __shfl_xor(all, 8); all += __shfl_xor(all, 16); all += __shfl_xor(all, 32);
      before += __shfl_xor(before, 8); before += __shfl_xor(before, 16); before += __shfl_xor(before, 32);
      if (C.lane < 8) { part[C.wave * 16 + C.lane] = all; part[C.wave * 16 + 8 + C.lane] = before; } }
    __syncthreads();
    if (C.tid < NE) { int all = 0, before = 0;
#pragma unroll
        for (int w = 0; w < 8; ++w) { all += part[w * 16 + C.tid]; before += part[w * 16 + 8 + C.tid]; }
        tot[C.tid] = all; tot[8 + C.tid] = before; }
    __syncthreads();
    if (C.tid == 0) { int s = 0;
        for (int e = 0; e < NE; ++e) { tot[16 + e] = s; s += (tot[e] + 255) & ~255; }
        tot[24] = s;
        if (blockIdx.x == 0) for (int e = 0; e <= NE; ++e) seg_out[e] = tot[16 + e]; }
    __syncthreads();
    const int2* toke = (const int2*)(C.misc + MISC_TOKE); const f32x2* tokg = (const f32x2*)(C.misc + MISC_TOKG); const int2* tokr = (const int2*)(C.misc + MISC_TOKR);
    int2* tokp = (int2*)(C.misc + MISC_TOKP); float* rstds = (float*)(C.misc + MISC_RSTDS); float* gates = (float*)(C.misc + MISC_GATES);
    const int r0 = (int)blockIdx.x * ROWS_PER_WG;
    for (int rr = C.wave; rr < ROWS_PER_WG; rr += 8) {
        const int row = r0 + rr; if (row >= MVALID) break;
        const int2 e = toke[row], k = tokr[row]; const f32x2 g = tokg[row];
        const int p0 = tot[16 + e.x] + tot[8 + e.x] + k.x, p1 = tot[16 + e.y] + tot[8 + e.y] + k.y;
        const u32x4 a = *(const u32x4*)(C.H + (size_t)row * D + C.lane * 8), bq = *(const u32x4*)(C.H + (size_t)row * D + 512 + C.lane * 8);
        *(u32x4*)(XS + (size_t)p0 * D + C.lane * 8) = a; *(u32x4*)(XS + (size_t)p0 * D + 512 + C.lane * 8) = bq;
        *(u32x4*)(XS + (size_t)p1 * D + C.lane * 8) = a; *(u32x4*)(XS + (size_t)p1 * D + 512 + C.lane * 8) = bq;
        if (C.lane == 0) { const float rs = pg8::rstd_of(ssq, row); tokp[row] = make_int2(p0, p1); rstds[p0] = rs; rstds[p1] = rs; gates[p0] = g.x; gates[p1] = g.y; }
    }
    __syncthreads();
}
__device__ __forceinline__ void moe_combine(const Ctx& C, const bf16_t* YS, float* ssq_out) {
    const int2* tokp = (const int2*)(C.misc + MISC_TOKP);
    for (int row = C.gw; row < MVALID; row += C.NGW) {
        const int2 p = tokp[row]; float ss = 0.f;
#pragma unroll
        for (int q = 0; q < 2; ++q) {
            const int col = q * 512 + C.lane * 8;
            const u32x4 hv = *(const u32x4*)(C.H + (size_t)row * D + col), y0 = *(const u32x4*)(YS + (size_t)p.x * D + col), y1 = *(const u32x4*)(YS + (size_t)p.y * D + col);
            u32x4 w;
            w.x = pk2(bflo(hv.x) + bflo(y0.x) + bflo(y1.x), bfhi(hv.x) + bfhi(y0.x) + bfhi(y1.x));
            w.y = pk2(bflo(hv.y) + bflo(y0.y) + bflo(y1.y), bfhi(hv.y) + bfhi(y0.y) + bfhi(y1.y));
            w.z = pk2(bflo(hv.z) + bflo(y0.z) + bflo(y1.z), bfhi(hv.z) + bfhi(y0.z) + bfhi(y1.z));
            w.w = pk2(bflo(hv.w) + bflo(y0.w) + bflo(y1.w), bfhi(hv.w) + bfhi(y0.w) + bfhi(y1.w));
            *(u32x4*)(C.H + (size_t)row * D + col) = w;
            ss += bflo(w.x) * bflo(w.x) + bfhi(w.x) * bfhi(w.x) + bflo(w.y) * bflo(w.y) + bfhi(w.y) * bfhi(w.y) + bflo(w.z) * bflo(w.z) + bfhi(w.z) * bfhi(w.z) + bflo(w.w) * bflo(w.w) + bfhi(w.w) * bfhi(w.w);
        }
        ss = wave_sum(ss);
        pg8::ssq_store_single(ssq_out, row, ss, C.lane);
    }
}
__device__ __forceinline__ void pool_prep(const Ctx& C, const float* ssq, const float* gain, bf16_t* Dm) {
    for (int row = C.gw; row < MROWS; row += C.NGW) {
        if (row >= MVALID) { const u32x4 z = {0u, 0u, 0u, 0u}; *(u32x4*)(Dm + (size_t)row * D + C.lane * 8) = z; *(u32x4*)(Dm + (size_t)row * D + 512 + C.lane * 8) = z; continue; }
        const int b = row < MREAL ? row >> 11 : 0, p = row_pos(row);
#pragma unroll
        for (int q = 0; q < 2; ++q) {
            const int col = q * 512 + C.lane * 8, grp = col >> 8, w = 2 << grp;
            const int cnt = (p + 1 < w) ? p + 1 : w;
            float acc[8], self[8];
#pragma unroll
            for (int j = 0; j < 8; ++j) acc[j] = 0.f;
            for (int d = 0; d < 16; ++d) {
                if (d < cnt) {
                    const int r2 = pos_row(b, p - d); const float rs = pg8::rstd_of(ssq, r2);
                    const u32x4 t = *(const u32x4*)(C.H + (size_t)r2 * D + col);
                    const float v[8] = {bflo(t.x) * rs, bfhi(t.x) * rs, bflo(t.y) * rs, bfhi(t.y) * rs, bflo(t.z) * rs, bfhi(t.z) * rs, bflo(t.w) * rs, bfhi(t.w) * rs};
#pragma unroll
                    for (int j = 0; j < 8; ++j) { acc[j] += v[j]; if (d == 0) self[j] = v[j]; }
                }
            }
            const float ic = 1.0f / (float)cnt;
            const f32x4 g0 = *(const f32x4*)(gain + col), g1 = *(const f32x4*)(gain + col + 4);
            u32x4 o;
            o.x = pk2((acc[0] * ic - self[0]) * g0[0], (acc[1] * ic - self[1]) * g0[1]); o.y = pk2((acc[2] * ic - self[2]) * g0[2], (acc[3] * ic - self[3]) * g0[3]);
            o.z = pk2((acc[4] * ic - self[4]) * g1[0], (acc[5] * ic - self[5]) * g1[1]); o.w = pk2((acc[6] * ic - self[6]) * g1[2], (acc[7] * ic - self[7]) * g1[3]);
            *(u32x4*)(Dm + (size_t)row * D + col) = o;
        }
    }
}

__global__ void __launch_bounds__(512, 2) fwd_kernel(Args args) {
    extern __shared__ __attribute__((aligned(16))) unsigned char lds_raw[];
    Ctx C;
    C.lds = (LAS unsigned char*)lds_raw;
    C.tid = threadIdx.x; C.lane = C.tid & 63; C.wave = __builtin_amdgcn_readfirstlane(C.tid >> 6);
    C.G = gridDim.x; C.gw = (int)blockIdx.x * 8 + C.wave; C.NGW = C.G * 8;
    C.in = args.in; C.out = args.out; C.ws = args.ws;
    C.H = (bf16_t*)(args.ws + WS_H); C.ssq = (float*)(args.ws + WS_SSQ); C.gst = (float*)(args.ws + WS_GST);
    C.WA = (bf16_t*)(args.ws + WS_WA); C.WB = (bf16_t*)(args.ws + WS_WB); C.pool = args.ws + WS_POOL; C.misc = args.ws + WS_MISC; C.tab = (f32x2*)(args.ws + WS_TAB);
    C.moe = (int*)(args.ws + WS_CTL + CTL_MOE);
    for (int u = C.tid; u < (LDS_BYTES - LDSCTL_OFF) / 4; u += 512) ((LAS unsigned*)(C.lds + LDSCTL_OFF))[u] = 0u;
    __syncthreads();
    unsigned* barw = (unsigned*)(args.ws + WS_CTL) + CW_BAR;
    XcdBarrier bar; bar.bar = barw; bar.x = 0; bar.st = nullptr;
    if (!MK_PER_PHASE) bar = xcd_barrier_post(barw, (volatile LAS unsigned*)(C.lds + LDSCTL_OFF + 32));
    const int lo = args.ph_lo, hi = args.ph_hi;
#define IN(k) (lo <= (k) && (k) < hi)
#define SEAM(k) do { if (!MK_PER_PHASE && (k) + 1 < hi) xcd_barrier(bar); } while (0)

    bf16_t* const PQ = (bf16_t*)(C.pool + PO_Q); bf16_t* const PK = (bf16_t*)(C.pool + PO_K); bf16_t* const PV = (bf16_t*)(C.pool + PO_V); bf16_t* const PG = (bf16_t*)(C.pool + PO_G);
    bf16_t* const HID = (bf16_t*)(C.pool + PO_HID); bf16_t* const XS = (bf16_t*)(C.pool + PO_XS); bf16_t* const MHID = (bf16_t*)(C.pool + PO_MHID);
    bf16_t* const YM = (bf16_t*)(C.misc + MISC_YM);
    float* const rstds = (float*)(C.misc + MISC_RSTDS); float* const gates = (float*)(C.misc + MISC_GATES);
#define SSQ(i) (C.ssq + (size_t)(i) * MROWS * 16)

    if (IN(P_PRO)) {
        conv_ret(C, 0, 0, C.WB + WB_MIX, C.WB + WB_WO);
        conv_dense(C, 0, 0, C.WB + WB_W13, C.WB + WB_W2);
        { LAS float* scr = (LAS float*)(C.lds + C.wave * 16384);
          wt_matrix<0>(C.in[10], D, 3 * D, 3 * D, C.WA + WA_MIX, C.in[2] + 1 * D, scr, C.gw, C.NGW, C.lane);
          wt_matrix<0>(C.in[11], D, D, D, C.WA + WA_MIX_WO_SB, nullptr, scr, C.gw, C.NGW, C.lane); }
        conv_moe(C, 0, 1, C.WA + WA_MOE13, C.WA + WA_MOE2);
        for (int i = C.gw * 64 + C.lane; i < LPOS * 64; i += C.NGW * 64) {
            const int p = i >> 6, f = i & 63;
            const float inv = exp2f(-(float)f * (13.287712379549449f / 64.0f));
            const float ang = (float)p * inv;
            const double rev = (double)ang * 0.15915494309189535; const float fr = (float)(rev - __builtin_rint(rev));
            C.tab[i] = (f32x2){__builtin_amdgcn_cosf(fr), __builtin_amdgcn_sinf(fr)};
        }
        for (int row = C.gw; row < MROWS; row += C.NGW) {
            float ss = 0.f;
            if (row < MVALID) {
                const float* src = row < MREAL ? C.in[0] + (size_t)row * D : C.in[1] + (size_t)(row - MREAL) * D;
#pragma unroll
                for (int q = 0; q < 2; ++q) { const int col = q * 512 + C.lane * 8; const f32x4 a = *(const f32x4*)(src + col), b2 = *(const f32x4*)(src + col + 4);
                    u32x4 w; w.x = pk2(a[0], a[1]); w.y = pk2(a[2], a[3]); w.z = pk2(b2[0], b2[1]); w.w = pk2(b2[2], b2[3]);
                    *(u32x4*)(C.H + (size_t)row * D + col) = w;
                    ss += bflo(w.x) * bflo(w.x) + bfhi(w.x) * bfhi(w.x) + bflo(w.y) * bflo(w.y) + bfhi(w.y) * bfhi(w.y) + bflo(w.z) * bflo(w.z) + bfhi(w.z) * bfhi(w.z) + bflo(w.w) * bflo(w.w) + bfhi(w.w) * bfhi(w.w); }
                ss = wave_sum(ss);
            } else { const u32x4 z = {0u, 0u, 0u, 0u}; *(u32x4*)(C.H + (size_t)row * D + C.lane * 8) = z; *(u32x4*)(C.H + (size_t)row * D + 512 + C.lane * 8) = z; }
            pg8::ssq_store_single(SSQ(0), row, ss, C.lane);
        }
        SEAM(P_PRO);
    }
    if (IN(P0_QKVG)) { pg8::EpiProj<0> E{SSQ(0), C.tab, PQ, PK, PV, PG}; run_dense(C, C.H, D, 0, C.WB + WB_MIX, D, 6144, E); SEAM(P0_QKVG); }
    if (IN(P0_RET)) { if (NAIVE_RET) ret_naive(C, PQ, PK, PV, YM, C.gst); else ret_mfma(C, PQ, PK, PV, YM, C.gst); SEAM(P0_RET); }
    if (IN(P0_FIN)) { ret_finalize(C, 0, PV, YM, PG, C.gst); SEAM(P0_FIN); }
    if (IN(P0_WO)) { pg8::EpiResid E{C.H, SSQ(1), nullptr}; run_dense(C, PG, 2048, 0, C.WB + WB_WO, 2048, 1024, E); SEAM(P0_WO); }
    if (IN(P0_W13)) { pg8::EpiSwiglu<false> E{SSQ(1), HID}; run_dense(C, C.H, D, 0, C.WB + WB_W13, D, 5632, E); SEAM(P0_W13); }
    if (IN(P0_W2)) { pg8::EpiResid E{C.H, SSQ(2), nullptr}; run_dense(C, HID, FF, 0, C.WB + WB_W2, FF, 1024, E); SEAM(P0_W2); }
    if (IN(P1_QKV)) { pg8::EpiProj<1> E{SSQ(2), C.tab, PQ, PK, PV, PG}; run_dense(C, C.H, D, 0, C.WA + WA_MIX, D, 3072, E); SEAM(P1_QKV); }
    if (IN(P1_SB)) { sb_naive(C, PQ, PK, PV); if (!NAIVE_SB) sb_mfma(C, PQ, PK, PV); SEAM(P1_SB); }
    if (IN(P1_WO)) { pg8::EpiResid E{C.H, SSQ(3), nullptr}; run_dense(C, PQ, D, 0, C.WA + WA_MIX_WO_SB, D, 1024, E); SEAM(P1_WO); }
    if (IN(P1_RA)) {
        router_a(C, 0, 1, SSQ(3), C.moe);
        { LAS float* scr = (LAS float*)(C.lds + C.wave * 16384);
          for (int g = 0; g < 4; ++g) wt_matrix<0>(C.in[12] + (size_t)g * 256 * 256, 256, 256, 256, C.WB + WB_MIX + (size_t)g * 256 * 256, nullptr, scr, C.gw, C.NGW, C.lane); }
        conv_dense(C, 1, 2, C.WB + WB_W13, C.WB + WB_W2);
        SEAM(P1_RA);
    }
    if (IN(P1_RB)) { router_b(C, SSQ(3), C.moe, C.moe + 2 * 256 * NE, XS); SEAM(P1_RB); }
    if (IN(P1_M13)) { pg8::EpiSwiglu<true> E{rstds, MHID}; run_moe(C, C.moe + 2 * 256 * NE, XS, C.WA + WA_MOE13, (size_t)5632 * D * 2, D, 5632, E); SEAM(P1_M13); }
    if (IN(P1_M2)) { pg8::EpiMoeW2 E{gates, XS}; run_moe(C, C.moe + 2 * 256 * NE, MHID, C.WA + WA_MOE2, (size_t)D * FF * 2, FF, 1024, E); SEAM(P1_M2); }
    if (IN(P1_CMB)) {
        moe_combine(C, XS, SSQ(4));
        conv_ret(C, 1, 3, C.WA + WA_MIX, C.WA + WA_MIX_WO_RET);
        conv_moe(C, 1, 3, C.WA + WA_MOE13, C.WA + WA_MOE2);
        SEAM(P1_CMB);
    }
    if (IN(P2_PREP)) { pool_prep(C, SSQ(4), C.in[2] + 2 * D, PQ); SEAM(P2_PREP); }
    if (IN(P2_POOL)) { pg8::EpiResid E{C.H, SSQ(5), C.in[13]}; run_dense(C, PQ, D, 512, C.WB + WB_MIX, 256, 1024, E); SEAM(P2_POOL); }
    if (IN(P2_W13)) { pg8::EpiSwiglu<false> E{SSQ(5), HID}; run_dense(C, C.H, D, 0, C.WB + WB_W13, D, 5632, E); SEAM(P2_W13); }
    if (IN(P2_W2)) { pg8::EpiResid E{C.H, SSQ(6), nullptr}; run_dense(C, HID, FF, 0, C.WB + WB_W2, FF, 1024, E); SEAM(P2_W2); }
    if (IN(P3_QKVG)) { pg8::EpiProj<0> E{SSQ(6), C.tab, PQ, PK, PV, PG}; run_dense(C, C.H, D, 0, C.WA + WA_MIX, D, 6144, E); SEAM(P3_QKVG); }
    if (IN(P3_RET)) { if (NAIVE_RET) ret_naive(C, PQ, PK, PV, YM, C.gst); else ret_mfma(C, PQ, PK, PV, YM, C.gst); SEAM(P3_RET); }
    if (IN(P3_FIN)) { ret_finalize(C, 1, PV, YM, PG, C.gst); SEAM(P3_FIN); }
    if (IN(P3_WO)) { pg8::EpiResid E{C.H, SSQ(7), nullptr}; run_dense(C, PG, 2048, 0, C.WA + WA_MIX_WO_RET, 2048, 1024, E); SEAM(P3_WO); }
    if (IN(P3_RA)) { router_a(C, 1, 3, SSQ(7), C.moe + 256 * NE); SEAM(P3_RA); }
    if (IN(P3_RB)) { router_b(C, SSQ(7), C.moe + 256 * NE, C.moe + 2 * 256 * NE + 16, XS); SEAM(P3_RB); }
    if (IN(P3_M13)) { pg8::EpiSwiglu<true> E{rstds, MHID}; run_moe(C, C.moe + 2 * 256 * NE + 16, XS, C.WA + WA_MOE13, (size_t)5632 * D * 2, D, 5632, E); SEAM(P3_M13); }
    if (IN(P3_M2)) { pg8::EpiMoeW2 E{gates, XS}; run_moe(C, C.moe + 2 * 256 * NE + 16, MHID, C.WA + WA_MOE2, (size_t)D * FF * 2, FF, 1024, E); SEAM(P3_M2); }
    if (IN(P3_CMB)) { moe_combine(C, XS, SSQ(8)); SEAM(P3_CMB); }
    if (IN(P_FINAL)) {
        const float* g = C.in[21];
        for (int row = C.gw; row < MREAL; row += C.NGW) {
            const float rs = pg8::rstd_of(SSQ(8), row);
#pragma unroll
            for (int q = 0; q < 2; ++q) { const int col = q * 512 + C.lane * 8; const u32x4 t = *(const u32x4*)(C.H + (size_t)row * D + col);
                const f32x4 g0 = *(const f32x4*)(g + col), g1 = *(const f32x4*)(g + col + 4);
                f32x4 o0 = {bflo(t.x) * rs * g0[0], bfhi(t.x) * rs * g0[1], bflo(t.y) * rs * g0[2], bfhi(t.y) * rs * g0[3]};
                f32x4 o1 = {bflo(t.z) * rs * g1[0], bfhi(t.z) * rs * g1[1], bflo(t.w) * rs * g1[2], bfhi(t.w) * rs * g1[3]};
                *(f32x4*)(C.out + (size_t)row * D + col) = o0; *(f32x4*)(C.out + (size_t)row * D + col + 4) = o1; }
        }
    }
#undef IN
#undef SEAM
#undef SSQ
}

extern "C" void kernel_launch(void* const* d_in, const int* in_sizes, int n_in, void* d_out, int out_size, void* d_ws, size_t ws_size, hipStream_t stream) {
    static int grid = 0;
    if (grid == 0) {
        if (n_in != 22 || out_size != MREAL * D || ws_size < WS_END) { fprintf(stderr, "kernel_launch: unexpected shapes (n_in %d out %d ws %zu)\n", n_in, out_size, ws_size); grid = -1; return; }
        int dev = 0, cus = 0;
        if (hipGetDevice(&dev) != hipSuccess || hipDeviceGetAttribute(&cus, hipDeviceAttributeMultiprocessorCount, dev) != hipSuccess) { grid = -1; return; }
        if (hipFuncSetAttribute((const void*)fwd_kernel, hipFuncAttributeMaxDynamicSharedMemorySize, LDS_BYTES) != hipSuccess) { grid = -1; return; }
        int per_cu = 0;
        if (hipOccupancyMaxActiveBlocksPerMultiprocessor(&per_cu, (const void*)fwd_kernel, 512, LDS_BYTES) != hipSuccess || per_cu < 1) { fprintf(stderr, "kernel_launch: occupancy query says %d\n", per_cu); }
        (void)hipGetLastError();
        grid = cus;
    }
    if (grid < 0) return;
    (void)hipMemsetAsync((char*)d_ws + WS_CTL, 0, CTL_BYTES, stream);
    Args a{};
    for (int i = 0; i < 22; ++i) a.in[i] = (const float*)d_in[i];
    a.out = (float*)d_out; a.ws = (unsigned char*)d_ws;
#if MK_PER_PHASE
    for (int k = 0; k < P_COUNT; ++k) { a.ph_lo = k; a.ph_hi = k + 1; hipLaunchKernelGGL(fwd_kernel, dim3(grid), dim3(512), LDS_BYTES, stream, a); }
#else
    a.ph_lo = 0; a.ph_hi = P_COUNT;
    hipLaunchKernelGGL(fwd_kernel, dim3(grid), dim3(512), LDS_BYTES, stream, a);
#endif
}
```

```cpp
#include <hip/hip_runtime.h>
#include <cstdio>
#include <cstdint>

#ifndef MK_PER_PHASE
#define MK_PER_PHASE 0
#endif
#ifndef PROBE_GAIN
#define PROBE_GAIN 92.0f
#endif
#ifndef PROBE_GROUP
#define PROBE_GROUP 0
#endif
#ifndef NAIVE_RET
#define NAIVE_RET 0
#endif
#ifndef NAIVE_SB
#define NAIVE_SB 0
#endif

#define GAS __attribute__((address_space(1)))
#define LAS __attribute__((address_space(3)))
typedef unsigned short bf16_t;
typedef short bf16x8 __attribute__((ext_vector_type(8)));
typedef float f32x4 __attribute__((ext_vector_type(4)));
typedef float f32x2 __attribute__((ext_vector_type(2)));
typedef unsigned u32x4 __attribute__((ext_vector_type(4)));
typedef unsigned u32x2 __attribute__((ext_vector_type(2)));

constexpr int D = 1024, NBATCH = 16, SEQ = 2048, NMETA = 16;
constexpr int MREAL = NBATCH * SEQ;
constexpr int MVALID = MREAL + NMETA;
constexpr int MROWS = 33024;
constexpr int FF = 2816, NE = 8;
constexpr int LPOS = SEQ + NMETA;
constexpr float EPS = 1e-6f;
constexpr int MOE_ROWS = 67840;

constexpr size_t MiB = 1u << 20;
constexpr size_t WS_CTL = 0, CTL_BYTES = 1 * MiB;
constexpr int CW_BAR = 4096;
constexpr size_t CTL_SROW = 64 * 1024;
constexpr size_t CTL_MOE = 512 * 1024;
constexpr size_t WS_SSQ = 1 * MiB;
constexpr size_t WS_GST = 20 * MiB;
constexpr size_t WS_WA = 29 * MiB, WS_WB = 185 * MiB, WS_H = 221 * MiB, WS_TAB = 289 * MiB, WS_MISC = 291 * MiB, WS_POOL = 297 * MiB, WS_END = 795 * MiB;
static_assert(WS_SSQ + (size_t)9 * MROWS * 64 <= WS_GST && WS_GST + (size_t)MROWS * 8 * 8 * 4 <= WS_WA, "ssq/gst");
constexpr size_t WA_MOE13 = 0, WA_MOE2 = (size_t)NE * 5632 * 1024, WA_MIX = WA_MOE2 + (size_t)NE * 1024 * 2816;
constexpr size_t WA_MIX_WO_SB = WA_MIX + (size_t)3072 * 1024, WA_MIX_WO_RET = WA_MIX + (size_t)6144 * 1024;
constexpr size_t WB_MIX = 0, WB_WO = (size_t)6144 * 1024, WB_W13 = WB_WO + (size_t)1024 * 2048, WB_W2 = WB_W13 + (size_t)5632 * 1024;
static_assert((WA_MIX + 8388608) * 2 <= 156 * MiB && (WB_W2 + (size_t)1024 * 2816) * 2 <= 36 * MiB, "weight regions");
constexpr size_t MISC_TOKE = 0, MISC_TOKG = 512 * 1024, MISC_TOKR = 1024 * 1024, MISC_TOKP = 1536 * 1024, MISC_RSTDS = 2 * MiB, MISC_GATES = 2 * MiB + 512 * 1024, MISC_YM = 3 * MiB;
constexpr size_t ACT1 = (size_t)MROWS * 1024 * 2;
constexpr size_t PO_Q = 0, PO_K = ACT1, PO_V = 2 * ACT1, PO_G = 4 * ACT1;
constexpr size_t PO_HID = 0, PO_D = 0;
constexpr size_t PO_XS = 0, PO_MHID = 133 * MiB;
static_assert(PO_G + 2 * ACT1 <= 498 * MiB && PO_MHID + (size_t)MOE_ROWS * FF * 2 <= 498 * MiB && (size_t)MOE_ROWS * 2048 <= 133 * MiB, "pool");

constexpr int RING_BYTES = 147456;
constexpr int LDSCTL_OFF = RING_BYTES;
constexpr int LDS_PEXP = LDSCTL_OFF + 256;
constexpr int LDS_BYTES = 163840;

__device__ __forceinline__ unsigned f2bf(float f) { unsigned u = __builtin_bit_cast(unsigned, f); return (u + 0x7fffu + ((u >> 16) & 1u)) >> 16; }
typedef __bf16 bf16x2_t __attribute__((ext_vector_type(2)));
__device__ __forceinline__ unsigned pk2(float lo, float hi) { const f32x2 v = {lo, hi}; const bf16x2_t b = __builtin_convertvector(v, bf16x2_t); return __builtin_bit_cast(unsigned, b); }
__device__ __forceinline__ float bflo(unsigned u) { return __builtin_bit_cast(float, u << 16); }
__device__ __forceinline__ float bfhi(unsigned u) { return __builtin_bit_cast(float, u & 0xffff0000u); }
__device__ __forceinline__ float bf1(bf16_t u) { return __builtin_bit_cast(float, ((unsigned)u) << 16); }
__device__ __forceinline__ float fast_rcp(float x) { return __builtin_amdgcn_rcpf(x); }
__device__ __forceinline__ float fast_exp2(float x) { return __builtin_amdgcn_exp2f(x); }
__device__ __forceinline__ float silu_f(float v) { return v * fast_rcp(1.0f + fast_exp2(-1.4426950408889634f * v)); }
__device__ __forceinline__ float wave_sum(float v) {
#pragma unroll
    for (int o = 1; o < 64; o <<= 1) v += __shfl_xor(v, o);
    return v;
}
__device__ __forceinline__ int row_pos(int row) { return row < MREAL ? NMETA + (row & (SEQ - 1)) : (row - MREAL < NMETA ? row - MREAL : NMETA - 1); }
__device__ __forceinline__ int pos_row(int b, int p) { return p < NMETA ? MREAL + p : b * SEQ + p - NMETA; }
#define LDS_WAIT() asm volatile("s_waitcnt lgkmcnt(0)" ::: "memory")

namespace pg8 {
constexpr int BM = 256, BK = 64, HALF = 128, HTB = HALF * BK * 2, NXCD = 8, WGM = 8;
__host__ __device__ __forceinline__ int lds_byte(int r, int c) { const int st = (r >> 4) * 2 + (c >> 5), rr = r & 15, cc = c & 31, ob = rr * 64 + cc * 2; return st * 1024 + (ob ^ (((ob >> 9) & 1) << 5)); }
__host__ __device__ __forceinline__ void stage_rc(int b, int& R, int& C) { const int st = b / 1024, sb = b % 1024, swz = sb ^ (((sb >> 9) & 1) << 5); R = (st >> 1) * 16 + swz / 64; C = (st & 1) * 32 + (swz % 64) / 2; }
__host__ __device__ __forceinline__ int perm32(int rho) { const int n = rho >> 4, i = rho & 15; return 8 * (i >> 2) + 4 * n + (i & 3); }
struct Unit { int pm, pn; };

template <bool MOE> struct Sched {
    int nM, nN, nwg, G, c; const char* A; const char* Bt; size_t a_pm, a_pn, b_pn, b_e; const LAS int* pexp;
    __device__ __forceinline__ bool next(int i, Unit& u) const {
        const long L = (long)i * G + c; if (L >= nwg) return false;
        int wgid = (int)L; { const int q = nwg / NXCD, r = nwg % NXCD, xcd = wgid % NXCD, off = wgid / NXCD; wgid = (xcd < r ? xcd * (q + 1) : r * (q + 1) + (xcd - r) * q) + off; }
        const int nig = WGM * nN, gid = wgid / nig, fm = gid * WGM, gsz = (nM - fm) < WGM ? (nM - fm) : WGM;
        u.pm = fm + ((wgid % nig) % gsz); u.pn = (wgid % nig) / gsz; return true;
    }
    __device__ __forceinline__ const char* aptr(const Unit& u) const { return A + (size_t)u.pm * a_pm + (size_t)u.pn * a_pn; }
    __device__ __forceinline__ const char* bptr(const Unit& u) const { const char* b = Bt + (size_t)u.pn * b_pn; if constexpr (MOE) b += (size_t)pexp[u.pm] * b_e; return b; }
};

template <class Epi, class SchedT>
__device__ __forceinline__ void gemm_phase(LAS unsigned char* lds, const int K, const int lda, const SchedT& S, const Epi& E) {
    const int tid = threadIdx.x, wid = __builtin_amdgcn_readfirstlane(tid >> 6), lane = tid & 63, wr = wid >> 2, wc = wid & 3, fr = lane & 15, fq = lane >> 4;
    const int nt = K / BK;
    unsigned voffA[2], voffB[2];
#pragma unroll
    for (int i = 0; i < 2; ++i) { int R, C; stage_rc(tid * 16 + i * 8192, R, C); const int Rb = (R & ~31) + perm32(R & 31);
        voffA[i] = (unsigned)(R * lda + C) * 2u; voffB[i] = (unsigned)(Rb * K + C) * 2u; }
    const size_t kstep = (size_t)(BK * 2);
    const size_t hstepA = (size_t)HALF * lda * 2, hstepB = (size_t)HALF * K * 2;
    const unsigned ldsw = (unsigned)wid * 1024u;
    const int aoff = lds_byte(wr * 64 + fr, fq * 8), boff = lds_byte(wc * 32 + fr, fq * 8);
#define PG8_SA(b, h) (((b) * 2 + (h)) * HTB)
#define PG8_SB(b, h) ((4 + (b) * 2 + (h)) * HTB)
#define PG8_STAGE(bufoff, gbase, voff) do { _Pragma("unroll") for (int _i = 0; _i < 2; ++_i) \
        __builtin_amdgcn_global_load_lds((const unsigned*)((const char*)(gbase) + (voff)[_i]), (LAS unsigned*)(lds + (bufoff) + ldsw + _i * 8192), 16, 0, 0); } while (0)
#define PG8_LDA(dst, b, h) do { _Pragma("unroll") for (int m = 0; m < 4; ++m) _Pragma("unroll") for (int k = 0; k < 2; ++k) dst[m][k] = *(const LAS bf16x8*)(lds + PG8_SA(b, h) + aoff + m * 2048 + k * 1024); } while (0)
#define PG8_LDB(dst, b, h) do { _Pragma("unroll") for (int n = 0; n < 2; ++n) _Pragma("unroll") for (int k = 0; k < 2; ++k) dst[n][k] = *(const LAS bf16x8*)(lds + PG8_SB(b, h) + boff + n * 2048 + k * 1024); } while (0)
#define PG8_MMA(ai, bj, At, Bt) do { __builtin_amdgcn_s_setprio(1); _Pragma("unroll") for (int m = 0; m < 4; ++m) _Pragma("unroll") for (int n = 0; n < 2; ++n) _Pragma("unroll") for (int k = 0; k < 2; ++k) \
        acc[ai][bj][m][n] = __builtin_amdgcn_mfma_f32_16x16x32_bf16(Bt[n][k], At[m][k], acc[ai][bj][m][n], 0, 0, 0); __builtin_amdgcn_s_setprio(0); } while (0)
#define PG8_WAIT_V(n) asm volatile("s_waitcnt vmcnt(" #n ")" ::: "memory")
#define PG8_WAIT_L(n) asm volatile("s_waitcnt lgkmcnt(" #n ")" ::: "memory")
#define PG8_BAR __builtin_amdgcn_s_barrier()
#define PG8_SCHED __builtin_amdgcn_sched_barrier(0)
    Unit cur, nxt; int ui = 0;
    if (!S.next(0, cur)) return;
    f32x4 acc[2][2][4][2];
#pragma unroll
    for (int a = 0; a < 2; ++a)
#pragma unroll
        for (int b = 0; b < 2; ++b)
#pragma unroll
            for (int m = 0; m < 4; ++m)
#pragma unroll
                for (int n = 0; n < 2; ++n) acc[a][b][m][n] = (f32x4){0.f, 0.f, 0.f, 0.f};
    bf16x8 At[4][2], B0[2][2], B1[2][2];
    const char* cA = S.aptr(cur); const char* cB = S.bptr(cur);
    PG8_STAGE(PG8_SB(0, 0), cB, voffB); PG8_STAGE(PG8_SB(0, 1), cB + hstepB, voffB); PG8_STAGE(PG8_SA(0, 0), cA, voffA); PG8_STAGE(PG8_SA(0, 1), cA + hstepA, voffA);
    if (wr == 1) PG8_BAR;
    PG8_WAIT_V(2); PG8_BAR;
    PG8_STAGE(PG8_SB(1, 0), cB + kstep, voffB); PG8_STAGE(PG8_SA(1, 0), cA + kstep, voffA); PG8_STAGE(PG8_SB(1, 1), cB + hstepB + kstep, voffB);
    PG8_WAIT_V(6); PG8_BAR;
    for (;;) {
        const bool has_next = S.next(ui + 1, nxt);
        const char* nA = has_next ? S.aptr(nxt) : cA; const char* nB = has_next ? S.bptr(nxt) : cB;
        for (int t = 0; t < nt; t += 2) {
            const bool last = (t == nt - 2);
            const char* a1 = cA + (size_t)(t + 1) * kstep;
            const char* a2 = last ? nA : cA + (size_t)(t + 2) * kstep; const char* b2 = last ? nB : cB + (size_t)(t + 2) * kstep;
            const char* a3 = a2 + kstep; const char* b3 = b2 + kstep;
            PG8_LDB(B0, 0, 0); PG8_LDB(B1, 0, 1); PG8_SCHED; PG8_LDA(At, 0, 0); PG8_STAGE(PG8_SA(1, 1), a1 + hstepA, voffA);
            PG8_WAIT_V(8); PG8_WAIT_L(0); PG8_BAR; PG8_MMA(0, 0, At, B0); PG8_MMA(0, 1, At, B1); PG8_BAR; PG8_SCHED;
            PG8_LDA(At, 0, 1); PG8_STAGE(PG8_SB(0, 0), b2, voffB); PG8_STAGE(PG8_SB(0, 1), b2 + hstepB, voffB); PG8_STAGE(PG8_SA(0, 0), a2, voffA);
            PG8_WAIT_V(8); PG8_WAIT_L(0); PG8_BAR; PG8_MMA(1, 0, At, B0); PG8_MMA(1, 1, At, B1); PG8_BAR; PG8_SCHED;
            PG8_LDB(B0, 1, 0); PG8_LDB(B1, 1, 1); PG8_SCHED; PG8_LDA(At, 1, 0); PG8_STAGE(PG8_SA(0, 1), a2 + hstepA, voffA);
            PG8_WAIT_V(8); PG8_WAIT_L(0); PG8_BAR; PG8_MMA(0, 0, At, B0); PG8_MMA(0, 1, At, B1); PG8_BAR; PG8_SCHED;
            PG8_LDA(At, 1, 1); PG8_STAGE(PG8_SB(1, 0), b3, voffB); PG8_STAGE(PG8_SB(1, 1), b3 + hstepB, voffB); PG8_STAGE(PG8_SA(1, 0), a3, voffA);
            PG8_WAIT_V(8); PG8_WAIT_L(0); PG8_BAR; PG8_MMA(1, 0, At, B0); PG8_MMA(1, 1, At, B1); PG8_BAR; PG8_SCHED;
        }
#if PROBE_GROUP == 9 || PROBE_GROUP == 61
        const unsigned long long _pt0 = __builtin_amdgcn_s_memrealtime();
#endif
        if (wr == 0) PG8_BAR;
        epi_tile(E, acc, cur, wr, wc, fr, fq);
#if PROBE_GROUP == 9
        asm volatile("" ::: "memory"); if (blockIdx.x == 0 && tid == 0) *(LAS unsigned long long*)(lds + LDSCTL_OFF + 8192) += __builtin_amdgcn_s_memrealtime() - _pt0;
#endif
#if PROBE_GROUP == 61
        asm volatile("" ::: "memory"); if (!Epi::BATCH && !Epi::HASPRE && blockIdx.x == 0 && tid == 0) *(LAS unsigned long long*)(lds + LDSCTL_OFF + 8192) += __builtin_amdgcn_s_memrealtime() - _pt0;
#endif
        if (!has_next) break;
#pragma unroll
        for (int a = 0; a < 2; ++a)
#pragma unroll
            for (int b = 0; b < 2; ++b)
#pragma unroll
                for (int m = 0; m < 4; ++m)
#pragma unroll
                    for (int n = 0; n < 2; ++n) acc[a][b][m][n] = (f32x4){0.f, 0.f, 0.f, 0.f};
        cur = nxt; cA = nA; cB = nB; ++ui;
        if (wr == 1) PG8_BAR;
    }
    PG8_WAIT_V(0);
    PG8_BAR;
#undef PG8_SA
#undef PG8_SB
#undef PG8_STAGE
#undef PG8_LDA
#undef PG8_LDB
#undef PG8_MMA
#undef PG8_WAIT_V
#undef PG8_WAIT_L
#undef PG8_BAR
#undef PG8_SCHED
}

__device__ __forceinline__ float clamp8(float x) { return __builtin_amdgcn_fmed3f(x, -448.0f, 448.0f); }
__device__ __forceinline__ u32x2 pack_fp8x8(float a0, float a1, float a2, float a3, float a4, float a5, float a6, float a7) {
    int lo = __builtin_amdgcn_cvt_pk_fp8_f32(clamp8(a0), clamp8(a1), 0, false); lo = __builtin_amdgcn_cvt_pk_fp8_f32(clamp8(a2), clamp8(a3), lo, true);
    int hi = __builtin_amdgcn_cvt_pk_fp8_f32(clamp8(a4), clamp8(a5), 0, false); hi = __builtin_amdgcn_cvt_pk_fp8_f32(clamp8(a6), clamp8(a7), hi, true);
    return (u32x2){(unsigned)lo, (unsigned)hi}; }
typedef f32x4 Acc[2][2][4][2];
__device__ __forceinline__ float gload1_asm(const float* p) { float v; asm volatile("global_load_dword %0, %1, off" : "=v"(v) : "v"(p) : "memory"); return v; }
__device__ __forceinline__ f32x4 gload4f_asm(const float* p) { f32x4 v; asm volatile("global_load_dwordx4 %0, %1, off" : "=v"(v) : "v"(p) : "memory"); return v; }
__device__ __forceinline__ void gload4f_tied(f32x4& v, const float* p) { asm volatile("global_load_dwordx4 %0, %1, off" : "+v"(v) : "v"(p) : "memory"); }
#define PG8_WAIT_PIN8(r) asm volatile("s_waitcnt vmcnt(0)" : "+v"(r[0][0]), "+v"(r[0][1]), "+v"(r[0][2]), "+v"(r[0][3]), "+v"(r[1][0]), "+v"(r[1][1]), "+v"(r[1][2]), "+v"(r[1][3]) : : "memory")
template <bool ROW> struct PreRaw { typedef f32x4 T; };
template <> struct PreRaw<true> { typedef float T; };
__device__ __forceinline__ float rstd_fin(const f32x4 a) { float s = (a[0] + a[1]) + (a[2] + a[3]); s += __shfl_xor(s, 16); s += __shfl_xor(s, 32); return __builtin_amdgcn_rsqf(s * (1.0f / D) + EPS); }
__device__ __forceinline__ float rstd_of(const float* ssqp, int row) {
    const f32x4* p = (const f32x4*)(ssqp + (size_t)row * 16); const f32x4 a = p[0], b = p[1], c = p[2], d = p[3];
    const float s = ((a[0] + a[1]) + (a[2] + a[3])) + ((b[0] + b[1]) + (b[2] + b[3])) + ((c[0] + c[1]) + (c[2] + c[3])) + ((d[0] + d[1]) + (d[2] + d[3]));
    return __builtin_amdgcn_rsqf(s * (1.0f / D) + EPS); }
__device__ __forceinline__ float rstd_coop(const float* ssqp, int row, int fq) {
    const f32x4 a = *(const f32x4*)(ssqp + (size_t)row * 16 + 4 * fq);
    float s = (a[0] + a[1]) + (a[2] + a[3]);
    s += __shfl_xor(s, 16); s += __shfl_xor(s, 32);
    return __builtin_amdgcn_rsqf(s * (1.0f / D) + EPS); }
__device__ __forceinline__ void ssq_store_single(float* ssqp, int row, float ss, int lane) { if (lane < 16) ssqp[(size_t)row * 16 + lane] = (lane == 0) ? ss : 0.f; }
template <class Epi> __device__ __forceinline__ void epi_tile(const Epi& E, const Acc& acc, const Unit& u, int wr, int wc, int fr, int fq) {
    if constexpr (Epi::BATCH) { E.tile(acc, u, wr, wc, fr, fq); return; }
    else if constexpr (Epi::HASPRE) {
        typename Epi::Raw raw[2][4]; float pre[2][4];
#pragma unroll
        for (int ai = 0; ai < 2; ++ai)
#pragma unroll
            for (int m = 0; m < 4; ++m) raw[ai][m] = E.pre_load(u.pm * BM + ai * HALF + wr * 64 + m * 16 + fr, fq);
        PG8_WAIT_PIN8(raw);
#pragma unroll
        for (int ai = 0; ai < 2; ++ai)
#pragma unroll
            for (int m = 0; m < 4; ++m) pre[ai][m] = E.pre_fin(raw[ai][m], fq);
#pragma unroll
        for (int ai = 0; ai < 2; ++ai)
#pragma unroll
            for (int m = 0; m < 4; ++m) E.frag(u.pm * BM + ai * HALF + wr * 64 + m * 16 + fr, u.pn, wc, fq, pre[ai][m], acc[ai][0][m][0], acc[ai][0][m][1], acc[ai][1][m][0], acc[ai][1][m][1]);
    } else {
#pragma unroll
        for (int ai = 0; ai < 2; ++ai)
#pragma unroll
            for (int m = 0; m < 4; ++m) E.frag(u.pm * BM + ai * HALF + wr * 64 + m * 16 + fr, u.pn, wc, fq, acc[ai][0][m][0], acc[ai][0][m][1], acc[ai][1][m][0], acc[ai][1][m][1]);
    }
}
template <class Epi> __device__ __forceinline__ void epi_frag(const Epi& E, int row, int pn, int wc, int fq, const f32x4 a00, const f32x4 a01, const f32x4 a10, const f32x4 a11) {
    if constexpr (Epi::HASPRE) { typename Epi::Raw r = E.pre_load(row, fq); asm volatile("s_waitcnt vmcnt(0)" : "+v"(r) : : "memory"); E.frag(row, pn, wc, fq, E.pre_fin(r, fq), a00, a01, a10, a11); }
    else E.frag(row, pn, wc, fq, a00, a01, a10, a11);
}

template <int MODE> struct EpiProj {
    static constexpr bool BATCH = true, HASPRE = false;
    const float* ssq; const f32x2* tab; bf16_t* Q; bf16_t* Kk; bf16_t* V; bf16_t* Gt; float ascale;
    __device__ __forceinline__ void tile(const Acc& acc, const Unit& u, int wr, int wc, int fr, int fq) const {
        const int pn = u.pn; int seg, colt, ld; size_t boff;
        if (MODE == 0) { if (pn < 4) { seg = 0; colt = pn * 256; ld = 1024; boff = PO_Q; } else if (pn < 8) { seg = 1; colt = (pn - 4) * 256; ld = 1024; boff = PO_K; }
                         else if (pn < 16) { seg = 2; colt = (pn - 8) * 256; ld = 2048; boff = PO_V; } else { seg = 3; colt = (pn - 16) * 256; ld = 2048; boff = PO_G; } }
        else { ld = 1024; if (pn < 4) { seg = 4; colt = pn * 256; boff = PO_Q; } else if (pn < 8) { seg = 2; colt = (pn - 4) * 256; boff = PO_K; } else { seg = 2; colt = (pn - 8) * 256; boff = PO_V; } }
        bf16_t* base = (bf16_t*)((unsigned char*)Q + boff);
        const int col0 = colt + wc * 32 + 8 * fq, row0 = u.pm * BM + wr * 64 + fr;
        f32x4 raw[2][4]; float rsv[2][4];
#pragma unroll
        for (int ai = 0; ai < 2; ++ai)
#pragma unroll
            for (int m = 0; m < 4; ++m) raw[ai][m] = gload4f_asm(ssq + (size_t)(row0 + ai * HALF + m * 16) * 16 + 4 * fq);
        PG8_WAIT_PIN8(raw);
#pragma unroll
        for (int ai = 0; ai < 2; ++ai)
#pragma unroll
            for (int m = 0; m < 4; ++m) rsv[ai][m] = rstd_fin(raw[ai][m]);
        if (MODE == 0 && seg < 2) {
            asm volatile("" ::: "memory");
            float invr[2][4], l2g[2];
#pragma unroll
            for (int bj = 0; bj < 2; ++bj) { const int i0 = ((col0 + bj * HALF) & 127) >> 1;
#pragma unroll
                for (int jj = 0; jj < 4; ++jj) invr[bj][jj] = fast_exp2(-(float)(i0 + jj) * (13.287712379549449f / 64.0f)) * 0.15915494309189535f;
                const int hh = ((pn & 3) << 1) + bj; l2g[bj] = __builtin_amdgcn_logf(1.0f - fast_exp2(-5.0f - (float)hh)) * (seg == 0 ? 1.0f : -1.0f); }
            const float kscale = (seg == 1) ? 0.08838834764831845f : 1.0f;
#pragma unroll
            for (int ai = 0; ai < 2; ++ai)
#pragma unroll
                for (int m = 0; m < 4; ++m) {
                    const int row = row0 + ai * HALF + m * 16; const float rs = rsv[ai][m] * (kscale * ascale);
                    const float pf = (float)row_pos(row); const float cl = (float)(row & 127);
#pragma unroll
                    for (int bj = 0; bj < 2; ++bj) {
                        const float ks = NAIVE_RET ? rs : rs * fast_exp2(cl * l2g[bj]);
                        const f32x4 v0 = acc[ai][bj][m][0] * ks, v1 = acc[ai][bj][m][1] * ks;
                        float c[4], sn[4];
#pragma unroll
                        for (int jj = 0; jj < 4; ++jj) { const float rev = __builtin_amdgcn_fractf(pf * invr[bj][jj]); c[jj] = __builtin_amdgcn_cosf(rev); sn[jj] = __builtin_amdgcn_sinf(rev); }
                        u32x4 w;
                        w.x = pk2(v0[0] * c[0] - v0[1] * sn[0], v0[0] * sn[0] + v0[1] * c[0]); w.y = pk2(v0[2] * c[1] - v0[3] * sn[1], v0[2] * sn[1] + v0[3] * c[1]);
                        w.z = pk2(v1[0] * c[2] - v1[1] * sn[2], v1[0] * sn[2] + v1[1] * c[2]); w.w = pk2(v1[2] * c[3] - v1[3] * sn[3], v1[2] * sn[3] + v1[3] * c[3]);
                        *(u32x4*)(base + (size_t)row * ld + col0 + bj * HALF) = w;
                    }
                }
        } else if (MODE == 0 && seg == 3) {
            asm volatile("" ::: "memory");
#pragma unroll
            for (int ai = 0; ai < 2; ++ai)
#pragma unroll
                for (int m = 0; m < 4; ++m) {
                    const int row = row0 + ai * HALF + m * 16; const float rs = rsv[ai][m] * ascale; const float nrs = -1.4426950408889634f * rs;
#pragma unroll
                    for (int bj = 0; bj < 2; ++bj) {
                        const f32x4 a0 = acc[ai][bj][m][0], a1 = acc[ai][bj][m][1];
                        f32x4 e0 = a0 * nrs, e1 = a1 * nrs;
#pragma unroll
                        for (int j = 0; j < 4; ++j) { e0[j] = fast_exp2(e0[j]); e1[j] = fast_exp2(e1[j]); }
                        e0 = e0 + 1.0f; e1 = e1 + 1.0f;
#pragma unroll
                        for (int j = 0; j < 4; ++j) { e0[j] = fast_rcp(e0[j]); e1[j] = fast_rcp(e1[j]); }
                        const f32x4 o0 = a0 * (e0 * rs), o1 = a1 * (e1 * rs);
                        u32x4 w; w.x = pk2(o0[0], o0[1]); w.y = pk2(o0[2], o0[3]); w.z = pk2(o1[0], o1[1]); w.w = pk2(o1[2], o1[3]);
                        *(u32x4*)(base + (size_t)row * ld + col0 + bj * HALF) = w;
                    }
                }
        } else {
            asm volatile("" ::: "memory");
            const float sc = (MODE == 1 && seg == 4) ? 0.18033688011112042f : 1.0f;
#pragma unroll
            for (int ai = 0; ai < 2; ++ai)
#pragma unroll
                for (int m = 0; m < 4; ++m) {
                    const int row = row0 + ai * HALF + m * 16; const float rs = rsv[ai][m] * (sc * ascale);
#pragma unroll
                    for (int bj = 0; bj < 2; ++bj) {
                        const f32x4 v0 = acc[ai][bj][m][0] * rs, v1 = acc[ai][bj][m][1] * rs;
                        u32x4 w; w.x = pk2(v0[0], v0[1]); w.y = pk2(v0[2], v0[3]); w.z = pk2(v1[0], v1[1]); w.w = pk2(v1[2], v1[3]);
                        *(u32x4*)(base + (size_t)row * ld + col0 + bj * HALF) = w;
                    }
                }
        }
    }
    __device__ __forceinline__ void frag(int row, int pn, int wc, int fq, const f32x4 a00, const f32x4 a01, const f32x4 a10, const f32x4 a11) const {
        int seg, colt, ld; size_t boff;
        if (MODE == 0) { if (pn < 4) { seg = 0; colt = pn * 256; ld = 1024; boff = PO_Q; } else if (pn < 8) { seg = 1; colt = (pn - 4) * 256; ld = 1024; boff = PO_K; }
                         else if (pn < 16) { seg = 2; colt = (pn - 8) * 256; ld = 2048; boff = PO_V; } else { seg = 3; colt = (pn - 16) * 256; ld = 2048; boff = PO_G; } }
        else { ld = 1024; if (pn < 4) { seg = 4; colt = pn * 256; boff = PO_Q; } else if (pn < 8) { seg = 2; colt = (pn - 4) * 256; boff = PO_K; } else { seg = 2; colt = (pn - 8) * 256; boff = PO_V; } }
        bf16_t* base = (bf16_t*)((unsigned char*)Q + boff);
        const int col0 = colt + wc * 32 + 8 * fq;
        const float rs = rstd_coop(ssq, row, fq) * ((MODE == 1 && seg == 4) ? 0.18033688011112042f : 1.0f) * ascale;
        const int p = row_pos(row);
#pragma unroll
        for (int bj = 0; bj < 2; ++bj) {
            f32x4 v0 = (bj ? a10 : a00) * rs, v1 = (bj ? a11 : a01) * rs;
            const int col = col0 + bj * HALF;
            if (MODE == 0 && seg < 2) {
                const int i0 = (col & 127) >> 1; const float pf = (float)p;
                f32x4 t0, t1;
#pragma unroll
                for (int jj = 0; jj < 4; ++jj) {
                    const float invr = fast_exp2(-(float)(i0 + jj) * (13.287712379549449f / 64.0f)) * 0.15915494309189535f;
                    const float rev = __builtin_amdgcn_fractf(pf * invr);
                    const float c = __builtin_amdgcn_cosf(rev), sn = __builtin_amdgcn_sinf(rev);
                    if (jj < 2) { t0[2 * jj] = c; t0[2 * jj + 1] = sn; } else { t1[2 * (jj - 2)] = c; t1[2 * (jj - 2) + 1] = sn; }
                }
                f32x4 o0, o1;
                o0[0] = v0[0] * t0[0] - v0[1] * t0[1]; o0[1] = v0[0] * t0[1] + v0[1] * t0[0];
                o0[2] = v0[2] * t0[2] - v0[3] * t0[3]; o0[3] = v0[2] * t0[3] + v0[3] * t0[2];
                o1[0] = v1[0] * t1[0] - v1[1] * t1[1]; o1[1] = v1[0] * t1[1] + v1[1] * t1[0];
                o1[2] = v1[2] * t1[2] - v1[3] * t1[3]; o1[3] = v1[2] * t1[3] + v1[3] * t1[2];
                float ks = (seg == 1) ? 0.08838834764831845f : 1.0f;
                if (!NAIVE_RET) {
                    const int hh = ((pn & 3) << 1) + bj; const float l2g = __builtin_amdgcn_logf(1.0f - fast_exp2(-5.0f - (float)hh));
                    const int cl = row < MREAL ? (row & 127) : 112 + ((row - MREAL) & 15);
                    ks *= fast_exp2((seg == 0 ? (float)cl : -(float)cl) * l2g);
                }
                v0 = o0 * ks; v1 = o1 * ks;
            }
            if (MODE == 0 && seg == 3) {
#pragma unroll
                for (int j = 0; j < 4; ++j) { v0[j] = silu_f(v0[j]); v1[j] = silu_f(v1[j]); }
            }
            u32x4 w; w.x = pk2(v0[0], v0[1]); w.y = pk2(v0[2], v0[3]); w.z = pk2(v1[0], v1[1]); w.w = pk2(v1[2], v1[3]);
            *(u32x4*)(base + (size_t)row * ld + col) = w;
        }
    }
};
struct EpiResid {
    static constexpr bool BATCH = true, HASPRE = false;
    bf16_t* H; float* ssq_out; const float* colscale; unsigned char* H8; float ascale;
    __device__ __forceinline__ void frag_r(int row, int pn, int wc, int fq, const u32x4 hv0, const u32x4 hv1, const f32x4 c00, const f32x4 c01, const f32x4 c10, const f32x4 c11,
                                           const f32x4 a00, const f32x4 a01, const f32x4 a10, const f32x4 a11) const {
        const int col0 = pn * BM + wc * 32 + 8 * fq; float ss = 0.f;
#pragma unroll
        for (int bj = 0; bj < 2; ++bj) {
            f32x4 a0 = (bj ? a10 : a00) * ascale, a1 = (bj ? a11 : a01) * ascale;
            if (colscale) { a0 = a0 * (bj ? c10 : c00); a1 = a1 * (bj ? c11 : c01); }
            bf16_t* hp = H + (size_t)row * D + col0 + bj * HALF;
            const u32x4 hv = bj ? hv1 : hv0;
            u32x4 w;
            w.x = pk2(bflo(hv.x) + a0[0], bfhi(hv.x) + a0[1]); w.y = pk2(bflo(hv.y) + a0[2], bfhi(hv.y) + a0[3]);
            w.z = pk2(bflo(hv.z) + a1[0], bfhi(hv.z) + a1[1]); w.w = pk2(bflo(hv.w) + a1[2], bfhi(hv.w) + a1[3]);
            *(u32x4*)hp = w;
            if (H8) *(u32x2*)(H8 + (size_t)row * D + col0 + bj * HALF) = pack_fp8x8(bflo(w.x), bfhi(w.x), bflo(w.y), bfhi(w.y), bflo(w.z), bfhi(w.z), bflo(w.w), bfhi(w.w));
            ss += bflo(w.x) * bflo(w.x) + bfhi(w.x) * bfhi(w.x) + bflo(w.y) * bflo(w.y) + bfhi(w.y) * bfhi(w.y)
                + bflo(w.z) * bflo(w.z) + bfhi(w.z) * bfhi(w.z) + bflo(w.w) * bflo(w.w) + bfhi(w.w) * bfhi(w.w);
        }
        ss += __shfl_xor(ss, 16); ss += __shfl_xor(ss, 32);
        if (fq == 0) ssq_out[(size_t)row * 16 + pn * 4 + wc] = ss;
    }
    __device__ __forceinline__ void frag(int row, int pn, int wc, int fq, const f32x4 a00, const f32x4 a01, const f32x4 a10, const f32x4 a11) const {
        const int col0 = pn * BM + wc * 32 + 8 * fq;
        const u32x4 hv0 = *(const u32x4*)(H + (size_t)row * D + col0), hv1 = *(const u32x4*)(H + (size_t)row * D + col0 + HALF);
        f32x4 c00 = {1.f, 1.f, 1.f, 1.f}, c01 = c00, c10 = c00, c11 = c00;
        if (colscale) { c00 = *(const f32x4*)(colscale + col0); c01 = *(const f32x4*)(colscale + col0 + 4); c10 = *(const f32x4*)(colscale + col0 + HALF); c11 = *(const f32x4*)(colscale + col0 + HALF + 4); }
        frag_r(row, pn, wc, fq, hv0, hv1, c00, c01, c10, c11, a00, a01, a10, a11);
    }
    __device__ __forceinline__ void tile(const Acc& acc, const Unit& u, int wr, int wc, int fr, int fq) const {
        const int col0 = u.pn * BM + wc * 32 + 8 * fq, row0 = u.pm * BM + wr * 64 + fr;
        f32x4 c00 = {1.f, 1.f, 1.f, 1.f}, c01 = c00, c10 = c00, c11 = c00;
        if (colscale) { c00 = *(const f32x4*)(colscale + col0); c01 = *(const f32x4*)(colscale + col0 + 4); c10 = *(const f32x4*)(colscale + col0 + HALF); c11 = *(const f32x4*)(colscale + col0 + HALF + 4); }
#pragma unroll
        for (int ai = 0; ai < 2; ++ai) {
            f32x4 r[2][4];
#pragma unroll
            for (int m = 0; m < 4; ++m) { const bf16_t* hp = H + (size_t)(row0 + ai * HALF + m * 16) * D + col0; r[0][m] = gload4f_asm((const float*)hp); r[1][m] = gload4f_asm((const float*)(hp + HALF)); }
            PG8_WAIT_PIN8(r);
#pragma unroll
            for (int m = 0; m < 4; ++m) frag_r(row0 + ai * HALF + m * 16, u.pn, wc, fq, __builtin_bit_cast(u32x4, r[0][m]), __builtin_bit_cast(u32x4, r[1][m]), c00, c01, c10, c11,
                                               acc[ai][0][m][0], acc[ai][0][m][1], acc[ai][1][m][0], acc[ai][1][m][1]);
        }
    }
};
template <bool ROWRSTD> struct EpiSwiglu {
    static constexpr bool BATCH = false, HASPRE = true;
    const float* rsrc; bf16_t* HID;
    typedef typename PreRaw<ROWRSTD>::T Raw;
    __device__ __forceinline__ Raw pre_load(int row, int fq) const { if constexpr (ROWRSTD) return gload1_asm(rsrc + row); else return gload4f_asm(rsrc + (size_t)row * 16 + 4 * fq); }
    __device__ __forceinline__ float pre_fin(const Raw r, int fq) const { if constexpr (ROWRSTD) return r; else return rstd_fin(r); }
    __device__ __forceinline__ void frag(int row, int pn, int wc, int fq, const float rs, const f32x4 a00, const f32x4 a01, const f32x4 a10, const f32x4 a11) const {
        const int col0 = pn * HALF + wc * 32 + 8 * fq;
        const float nrs = -1.4426950408889634f * rs, rs2 = rs * rs;
        f32x4 e0 = a00 * nrs, e1 = a01 * nrs;
#pragma unroll
        for (int j = 0; j < 4; ++j) { e0[j] = fast_exp2(e0[j]); e1[j] = fast_exp2(e1[j]); }
        e0 = e0 + 1.0f; e1 = e1 + 1.0f;
#pragma unroll
        for (int j = 0; j < 4; ++j) { e0[j] = fast_rcp(e0[j]); e1[j] = fast_rcp(e1[j]); }
        const f32x4 o0 = (a00 * a10) * (e0 * rs2), o1 = (a01 * a11) * (e1 * rs2);
        u32x4 w; w.x = pk2(o0[0], o0[1]); w.y = pk2(o0[2], o0[3]); w.z = pk2(o1[0], o1[1]); w.w = pk2(o1[2], o1[3]);
        *(u32x4*)(HID + (size_t)row * FF + col0) = w;
    }
};
struct EpiMoeW2 {
    static constexpr bool BATCH = false, HASPRE = true;
    const float* gate; bf16_t* YS;
    typedef float Raw;
    __device__ __forceinline__ Raw pre_load(int row, int fq) const { return gload1_asm(gate + row); }
    __device__ __forceinline__ float pre_fin(const Raw r, int fq) const { return r; }
    __device__ __forceinline__ void frag(int row, int pn, int wc, int fq, const float g, const f32x4 a00, const f32x4 a01, const f32x4 a10, const f32x4 a11) const {
        const int col0 = pn * BM + wc * 32 + 8 * fq;
#pragma unroll
        for (int bj = 0; bj < 2; ++bj) {
            const f32x4 v0 = (bj ? a10 : a00) * g, v1 = (bj ? a11 : a01) * g;
            u32x4 w; w.x = pk2(v0[0], v0[1]); w.y = pk2(v0[2], v0[3]); w.z = pk2(v1[0], v1[1]); w.w = pk2(v1[2], v1[3]);
            *(u32x4*)(YS + (size_t)row * D + col0 + bj * HALF) = w;
        }
    }
};

typedef int v8i __attribute__((ext_vector_type(8)));
typedef int v4i __attribute__((ext_vector_type(4)));
__host__ __device__ __forceinline__ int lds_byte8(int r, int cb) { const int st = (r >> 4) * 2 + (cb >> 6), rr = r & 15, cc = cb & 63, ob = rr * 64 + cc; return st * 1024 + (ob ^ (((ob >> 9) & 1) << 4)); }
__host__ __device__ __forceinline__ void stage_rc8(int b, int& R, int& Cb) { const int st = b / 1024, sb = b % 1024, swz = sb ^ (((sb >> 9) & 1) << 4); R = (st >> 1) * 16 + swz / 64; Cb = (st & 1) * 64 + (swz % 64); }
template <class Epi, class SchedT>
__device__ __forceinline__ void gemm_phase8(LAS unsigned char* lds, const int K  , const int lda  , const SchedT& S, const Epi& E) {
    const int tid = threadIdx.x, wid = __builtin_amdgcn_readfirstlane(tid >> 6), lane = tid & 63, wr = wid >> 2, wc = wid & 3, fr = lane & 15, fq = lane >> 4;
    const int nt = K / 128;
    unsigned voffA[2], voffB[2];
#pragma unroll
    for (int i = 0; i < 2; ++i) { int R, Cb; stage_rc8(tid * 16 + i * 8192, R, Cb); const int Rb = (R & ~31) + perm32(R & 31);
        voffA[i] = (unsigned)(R * lda + Cb); voffB[i] = (unsigned)(Rb * K + Cb); }
    const size_t kstep = 128;
    const size_t hstepA = (size_t)HALF * lda, hstepB = (size_t)HALF * K;
    const unsigned ldsw = (unsigned)wid * 1024u;
    const int a0 = lds_byte8(wr * 64 + fr, 32 * fq), a1 = lds_byte8(wr * 64 + fr, 32 * fq + 16), b0 = lds_byte8(wc * 32 + fr, 32 * fq), b1 = lds_byte8(wc * 32 + fr, 32 * fq + 16);
#define PG8_SA(b, h) (((b) * 2 + (h)) * HTB)
#define PG8_SB(b, h) ((4 + (b) * 2 + (h)) * HTB)
#define PG8_STAGE(bufoff, gbase, voff) do { _Pragma("unroll") for (int _i = 0; _i < 2; ++_i) \
        __builtin_amdgcn_global_load_lds((const unsigned*)((const char*)(gbase) + (voff)[_i]), (LAS unsigned*)(lds + (bufoff) + ldsw + _i * 8192), 16, 0, 0); } while (0)
#define PG8_RD32(o0, o1) __builtin_shufflevector(*(const LAS v4i*)(lds + (o0)), *(const LAS v4i*)(lds + (o1)), 0, 1, 2, 3, 4, 5, 6, 7)
#define PG8_LDA(dst, b, h) do { _Pragma("unroll") for (int m = 0; m < 4; ++m) dst[m] = PG8_RD32(PG8_SA(b, h) + a0 + m * 2048, PG8_SA(b, h) + a1 + m * 2048); } while (0)
#define PG8_LDB(dst, b, h) do { _Pragma("unroll") for (int n = 0; n < 2; ++n) dst[n] = PG8_RD32(PG8_SB(b, h) + b0 + n * 2048, PG8_SB(b, h) + b1 + n * 2048); } while (0)
#define PG8_MMA(ai, bj, At, Bt) do { __builtin_amdgcn_s_setprio(1); _Pragma("unroll") for (int m = 0; m < 4; ++m) _Pragma("unroll") for (int n = 0; n < 2; ++n) \
        asm volatile("v_mfma_scale_f32_16x16x128_f8f6f4 %0, %1, %2, %0, %3, %3 op_sel_hi:[0,0,0]" : "+v"(acc[ai][bj][m][n]) : "v"(Bt[n]), "v"(At[m]), "v"(one8)); __builtin_amdgcn_s_setprio(0); } while (0)
#define PG8_MMA0(ai, bj, At, Bt) do { __builtin_amdgcn_s_setprio(1); _Pragma("unroll") for (int m = 0; m < 4; ++m) _Pragma("unroll") for (int n = 0; n < 2; ++n) \
        asm volatile("v_mfma_scale_f32_16x16x128_f8f6f4 %0, %1, %2, 0, %3, %3 op_sel_hi:[0,0,0]" : "=&v"(acc[ai][bj][m][n]) : "v"(Bt[n]), "v"(At[m]), "v"(one8)); __builtin_amdgcn_s_setprio(0); } while (0)
#define PG8_WAIT_V(n) asm volatile("s_waitcnt vmcnt(" #n ")" ::: "memory")
#define PG8_WAIT_L(n) asm volatile("s_waitcnt lgkmcnt(" #n ")" ::: "memory")
#define PG8_BAR __builtin_amdgcn_s_barrier()
#define PG8_SCHED __builtin_amdgcn_sched_barrier(0)
    int one8 = 0x7f7f7f7f; asm volatile("" : "+v"(one8));
    Unit cur, nxt; int ui = 0;
    if (!S.next(0, cur)) return;
    f32x4 acc[2][2][4][2];
#pragma unroll
    for (int a = 0; a < 2; ++a)
#pragma unroll
        for (int b = 0; b < 2; ++b)
#pragma unroll
            for (int m = 0; m < 4; ++m)
#pragma unroll
                for (int n = 0; n < 2; ++n) acc[a][b][m][n] = (f32x4){0.f, 0.f, 0.f, 0.f};
    v8i At[4], B0[2], B1[2];
    const char* cA = S.aptr(cur); const char* cB = S.bptr(cur);
    PG8_STAGE(PG8_SB(0, 0), cB, voffB); PG8_STAGE(PG8_SB(0, 1), cB + hstepB, voffB); PG8_STAGE(PG8_SA(0, 0), cA, voffA); PG8_STAGE(PG8_SA(0, 1), cA + hstepA, voffA);
    if (wr == 1) PG8_BAR;
    PG8_WAIT_V(2); PG8_BAR;
    PG8_STAGE(PG8_SB(1, 0), cB + kstep, voffB); PG8_STAGE(PG8_SA(1, 0), cA + kstep, voffA); PG8_STAGE(PG8_SB(1, 1), cB + hstepB + kstep, voffB);
    PG8_WAIT_V(6); PG8_BAR;
    for (;;) {
        const bool has_next = S.next(ui + 1, nxt);
        const char* nA = has_next ? S.aptr(nxt) : cA; const char* nB = has_next ? S.bptr(nxt) : cB;
        for (int t = 0; t < nt; t += 2) {
            const bool last = (t == nt - 2);
            const char* a1p = cA + (size_t)(t + 1) * kstep;
            const char* a2 = last ? nA : cA + (size_t)(t + 2) * kstep; const char* b2 = last ? nB : cB + (size_t)(t + 2) * kstep;
            const char* a3 = a2 + kstep; const char* b3 = b2 + kstep;
            PG8_LDB(B0, 0, 0); PG8_LDB(B1, 0, 1); PG8_SCHED; PG8_LDA(At, 0, 0); PG8_STAGE(PG8_SA(1, 1), a1p + hstepA, voffA);
            PG8_WAIT_V(8); PG8_WAIT_L(0); PG8_BAR; if (t == 0) { PG8_MMA0(0, 0, At, B0); PG8_MMA0(0, 1, At, B1); } else { PG8_MMA(0, 0, At, B0); PG8_MMA(0, 1, At, B1); } PG8_BAR; PG8_SCHED;
            PG8_LDA(At, 0, 1); PG8_STAGE(PG8_SB(0, 0), b2, voffB); PG8_STAGE(PG8_SB(0, 1), b2 + hstepB, voffB); PG8_STAGE(PG8_SA(0, 0), a2, voffA);
            PG8_WAIT_V(8); PG8_WAIT_L(0); PG8_BAR; if (t == 0) { PG8_MMA0(1, 0, At, B0); PG8_MMA0(1, 1, At, B1); } else { PG8_MMA(1, 0, At, B0); PG8_MMA(1, 1, At, B1); } PG8_BAR; PG8_SCHED;
            PG8_LDB(B0, 1, 0); PG8_LDB(B1, 1, 1); PG8_SCHED; PG8_LDA(At, 1, 0); PG8_STAGE(PG8_SA(0, 1), a2 + hstepA, voffA);
            PG8_WAIT_V(8); PG8_WAIT_L(0); PG8_BAR; PG8_MMA(0, 0, At, B0); PG8_MMA(0, 1, At, B1); PG8_BAR; PG8_SCHED;
            PG8_LDA(At, 1, 1); PG8_STAGE(PG8_SB(1, 0), b3, voffB); PG8_STAGE(PG8_SB(1, 1), b3 + hstepB, voffB); PG8_STAGE(PG8_SA(1, 0), a3, voffA);
            PG8_WAIT_V(8); PG8_WAIT_L(0); PG8_BAR; PG8_MMA(1, 0, At, B0); PG8_MMA(1, 1, At, B1); PG8_BAR; PG8_SCHED;
        }
        if (wr == 0) PG8_BAR;
        asm volatile("s_nop 15\n\ts_nop 7" ::: "memory");
        epi_tile(E, acc, cur, wr, wc, fr, fq);
        if (!has_next) break;
        cur = nxt; cA = nA; cB = nB; ++ui;
        if (wr == 1) PG8_BAR;
    }
    PG8_WAIT_V(0);
    PG8_BAR;
#undef PG8_SA
#undef PG8_SB
#undef PG8_STAGE
#undef PG8_RD32
#undef PG8_LDA
#undef PG8_LDB
#undef PG8_MMA
#undef PG8_MMA0
#undef PG8_WAIT_V
#undef PG8_WAIT_L
#undef PG8_BAR
#undef PG8_SCHED
}
template <class Epi, class SchedT>
__device__ __forceinline__ void gemm_phase8g(LAS unsigned char* lds, const int K  , const unsigned char* Ag  , const int* srow, const SchedT& S, const Epi& E) {
    const int tid = threadIdx.x, wid = __builtin_amdgcn_readfirstlane(tid >> 6), lane = tid & 63, wr = wid >> 2, wc = wid & 3, fr = lane & 15, fq = lane >> 4;
    const int nt = K / 128;
    unsigned voffB[2];
#pragma unroll
    for (int i = 0; i < 2; ++i) { int R, Cb; stage_rc8(tid * 16 + i * 8192, R, Cb); const int Rb = (R & ~31) + perm32(R & 31); voffB[i] = (unsigned)(Rb * K + Cb); }
    const size_t kstep = 128;
    const size_t hstepB = (size_t)HALF * K;
    LAS int* itab = (LAS int*)(lds + LDSCTL_OFF + 4096);
#define PG8_GFILL(slot0, par) do { if (wid < 4) __builtin_amdgcn_global_load_lds((const unsigned*)(srow + (slot0) + wid * 64 + lane), (LAS unsigned*)(itab + (par) * 256 + wid * 64), 4, 0, 0); } while (0)
#define PG8_GOFFS(dst, par) do { int _t = tid; asm volatile("" : "+v"(_t)); int _R0, _Cb0; stage_rc8(_t * 16, _R0, _Cb0); \
        _Pragma("unroll") for (int _h = 0; _h < 2; ++_h) _Pragma("unroll") for (int _i = 0; _i < 2; ++_i) dst[_h][_i] = (unsigned)itab[(par) * 256 + _h * 128 + _i * 64 + _R0] * (unsigned)K + (unsigned)_Cb0; } while (0)
    const unsigned ldsw = (unsigned)wid * 1024u;
    const int a0 = lds_byte8(wr * 64 + fr, 32 * fq), a1 = lds_byte8(wr * 64 + fr, 32 * fq + 16), b0 = lds_byte8(wc * 32 + fr, 32 * fq), b1 = lds_byte8(wc * 32 + fr, 32 * fq + 16);
#define PG8_SA(b, h) (((b) * 2 + (h)) * HTB)
#define PG8_SB(b, h) ((4 + (b) * 2 + (h)) * HTB)
#define PG8_STAGE(bufoff, gbase, voff) do { _Pragma("unroll") for (int _i = 0; _i < 2; ++_i) \
        __builtin_amdgcn_global_load_lds((const unsigned*)((const char*)(gbase) + (voff)[_i]), (LAS unsigned*)(lds + (bufoff) + ldsw + _i * 8192), 16, 0, 0); } while (0)
#define PG8_RD32(o0, o1) __builtin_shufflevector(*(const LAS v4i*)(lds + (o0)), *(const LAS v4i*)(lds + (o1)), 0, 1, 2, 3, 4, 5, 6, 7)
#define PG8_LDA(dst, b, h) do { _Pragma("unroll") for (int m = 0; m < 4; ++m) dst[m] = PG8_RD32(PG8_SA(b, h) + a0 + m * 2048, PG8_SA(b, h) + a1 + m * 2048); } while (0)
#define PG8_LDB(dst, b, h) do { _Pragma("unroll") for (int n = 0; n < 2; ++n) dst[n] = PG8_RD32(PG8_SB(b, h) + b0 + n * 2048, PG8_SB(b, h) + b1 + n * 2048); } while (0)
#define PG8_MMA(ai, bj, At, Bt) do { __builtin_amdgcn_s_setprio(1); _Pragma("unroll") for (int m = 0; m < 4; ++m) _Pragma("unroll") for (int n = 0; n < 2; ++n) \
        asm volatile("v_mfma_scale_f32_16x16x128_f8f6f4 %0, %1, %2, %0, %3, %3 op_sel_hi:[0,0,0]" : "+v"(acc[ai][bj][m][n]) : "v"(Bt[n]), "v"(At[m]), "v"(one8)); __builtin_amdgcn_s_setprio(0); } while (0)
#define PG8_MMA0(ai, bj, At, Bt) do { __builtin_amdgcn_s_setprio(1); _Pragma("unroll") for (int m = 0; m < 4; ++m) _Pragma("unroll") for (int n = 0; n < 2; ++n) \
        asm volatile("v_mfma_scale_f32_16x16x128_f8f6f4 %0, %1, %2, 0, %3, %3 op_sel_hi:[0,0,0]" : "=&v"(acc[ai][bj][m][n]) : "v"(Bt[n]), "v"(At[m]), "v"(one8)); __builtin_amdgcn_s_setprio(0); } while (0)
#define PG8_WAIT_V(n) asm volatile("s_waitcnt vmcnt(" #n ")" ::: "memory")
#define PG8_WAIT_L(n) asm volatile("s_waitcnt lgkmcnt(" #n ")" ::: "memory")
#define PG8_BAR __builtin_amdgcn_s_barrier()
#define PG8_SCHED __builtin_amdgcn_sched_barrier(0)
    int one8 = 0x7f7f7f7f; asm volatile("" : "+v"(one8));
    Unit cur, nxt; int ui = 0;
    if (!S.next(0, cur)) return;
    f32x4 acc[2][2][4][2];
#pragma unroll
    for (int a = 0; a < 2; ++a)
#pragma unroll
        for (int b = 0; b < 2; ++b)
#pragma unroll
            for (int m = 0; m < 4; ++m)
#pragma unroll
                for (int n = 0; n < 2; ++n) acc[a][b][m][n] = (f32x4){0.f, 0.f, 0.f, 0.f};
    v8i At[4], B0[2], B1[2];
    const char* const A0 = (const char*)Ag; const char* cB = S.bptr(cur);
    unsigned coff[2][2];
    PG8_GFILL(cur.pm * 256, 0); PG8_WAIT_V(0); PG8_BAR;
    PG8_GOFFS(coff, 0);
    PG8_STAGE(PG8_SB(0, 0), cB, voffB); PG8_STAGE(PG8_SB(0, 1), cB + hstepB, voffB); PG8_STAGE(PG8_SA(0, 0), A0, coff[0]); PG8_STAGE(PG8_SA(0, 1), A0, coff[1]);
    if (wr == 1) PG8_BAR;
    PG8_WAIT_V(2); PG8_BAR;
    PG8_STAGE(PG8_SB(1, 0), cB + kstep, voffB); PG8_STAGE(PG8_SA(1, 0), A0 + kstep, coff[0]); PG8_STAGE(PG8_SB(1, 1), cB + hstepB + kstep, voffB);
    PG8_WAIT_V(6); PG8_BAR;
    for (;;) {
        const bool has_next = S.next(ui + 1, nxt);
        const char* nB = has_next ? S.bptr(nxt) : cB;
        if (has_next) PG8_GFILL(nxt.pm * 256, (ui + 1) & 1);
        for (int t = 0; t < nt; t += 2) {
            const bool last = (t == nt - 2);
            const char* a1p = A0 + (size_t)(t + 1) * kstep;
            const bool usen = last && has_next;
            const char* a2 = last ? A0 : A0 + (size_t)(t + 2) * kstep; const char* b2 = last ? nB : cB + (size_t)(t + 2) * kstep;
            const char* a3 = a2 + kstep; const char* b3 = b2 + kstep;
            PG8_LDB(B0, 0, 0); PG8_LDB(B1, 0, 1); PG8_SCHED; PG8_LDA(At, 0, 0); PG8_STAGE(PG8_SA(1, 1), a1p, coff[1]);
            if (usen) PG8_GOFFS(coff, (ui + 1) & 1);
            PG8_WAIT_V(8); PG8_WAIT_L(0); PG8_BAR; if (t == 0) { PG8_MMA0(0, 0, At, B0); PG8_MMA0(0, 1, At, B1); } else { PG8_MMA(0, 0, At, B0); PG8_MMA(0, 1, At, B1); } PG8_BAR; PG8_SCHED;
            PG8_LDA(At, 0, 1); PG8_STAGE(PG8_SB(0, 0), b2, voffB); PG8_STAGE(PG8_SB(0, 1), b2 + hstepB, voffB); PG8_STAGE(PG8_SA(0, 0), a2, coff[0]);
            PG8_WAIT_V(8); PG8_WAIT_L(0); PG8_BAR; if (t == 0) { PG8_MMA0(1, 0, At, B0); PG8_MMA0(1, 1, At, B1); } else { PG8_MMA(1, 0, At, B0); PG8_MMA(1, 1, At, B1); } PG8_BAR; PG8_SCHED;
            PG8_LDB(B0, 1, 0); PG8_LDB(B1, 1, 1); PG8_SCHED; PG8_LDA(At, 1, 0); PG8_STAGE(PG8_SA(0, 1), a2, coff[1]);
            PG8_WAIT_V(8); PG8_WAIT_L(0); PG8_BAR; PG8_MMA(0, 0, At, B0); PG8_MMA(0, 1, At, B1); PG8_BAR; PG8_SCHED;
            PG8_LDA(At, 1, 1); PG8_STAGE(PG8_SB(1, 0), b3, voffB); PG8_STAGE(PG8_SB(1, 1), b3 + hstepB, voffB); PG8_STAGE(PG8_SA(1, 0), a3, coff[0]);
            PG8_WAIT_V(8); PG8_WAIT_L(0); PG8_BAR; PG8_MMA(1, 0, At, B0); PG8_MMA(1, 1, At, B1); PG8_BAR; PG8_SCHED;
        }
        if (wr == 0) PG8_BAR;
        asm volatile("s_nop 15\n\ts_nop 7" ::: "memory");
        epi_tile(E, acc, cur, wr, wc, fr, fq);
        if (!has_next) break;
        cur = nxt; cB = nB; ++ui;
        if (wr == 1) PG8_BAR;
    }
    PG8_WAIT_V(0);
    PG8_BAR;
#undef PG8_GFILL
#undef PG8_GOFFS
#undef PG8_SA
#undef PG8_SB
#undef PG8_STAGE
#undef PG8_RD32
#undef PG8_LDA
#undef PG8_LDB
#undef PG8_MMA
#undef PG8_MMA0
#undef PG8_WAIT_V
#undef PG8_WAIT_L
#undef PG8_BAR
#undef PG8_SCHED
}
constexpr float F8_W13 = 32.0f, F8_W2 = 64.0f, F8_HID = 4.0f;
template <bool ROWRSTD> struct EpiSwigluF8 {
    static constexpr bool BATCH = false, HASPRE = true;
    const float* rstd; unsigned char* HID8;
    typedef typename PreRaw<ROWRSTD>::T Raw;
    __device__ __forceinline__ Raw pre_load(int row, int fq) const { if constexpr (ROWRSTD) return gload1_asm(rstd + row); else return gload4f_asm(rstd + (size_t)row * 16 + 4 * fq); }
    __device__ __forceinline__ float pre_fin(const Raw r, int fq) const { if constexpr (ROWRSTD) return r * (1.0f / F8_W13); else return rstd_fin(r) * (1.0f / F8_W13); }
    __device__ __forceinline__ void frag(int row, int pn, int wc, int fq, const float rs, const f32x4 a00, const f32x4 a01, const f32x4 a10, const f32x4 a11) const {
        const int col0 = pn * HALF + wc * 32 + 8 * fq;
        const float nrs = -1.4426950408889634f * rs, rs2 = rs * rs * F8_HID;
        f32x4 e0 = a00 * nrs, e1 = a01 * nrs;
#pragma unroll
        for (int j = 0; j < 4; ++j) { e0[j] = fast_exp2(e0[j]); e1[j] = fast_exp2(e1[j]); }
        e0 = e0 + 1.0f; e1 = e1 + 1.0f;
#pragma unroll
        for (int j = 0; j < 4; ++j) { e0[j] = fast_rcp(e0[j]); e1[j] = fast_rcp(e1[j]); }
        const f32x4 o0 = (a00 * a10) * (e0 * rs2), o1 = (a01 * a11) * (e1 * rs2);
        *(u32x2*)(HID8 + (size_t)row * FF + col0) = pack_fp8x8(o0[0], o0[1], o0[2], o0[3], o1[0], o1[1], o1[2], o1[3]);
    }
};
template <class Epi> __device__ __forceinline__ void meta_gemm(LAS unsigned char* red, const bf16_t* A, int lda, size_t a_pn_el, const bf16_t* Bt, int K, int N, const Epi& E, int G) {
    const int tid = threadIdx.x, wid = __builtin_amdgcn_readfirstlane(tid >> 6), lane = tid & 63, fr = lane & 15, fq = lane >> 4;
    for (int task = blockIdx.x; task < N / 64; task += G) {
        const int pn = task >> 2, wc = task & 3;
        const bf16_t* ap = A + (size_t)(MREAL + fr) * lda + a_pn_el * pn + 8 * fq;
        const bf16_t* bp = Bt + (size_t)(256 * pn + 32 * wc + 8 * (fr >> 2) + (fr & 3)) * K + 8 * fq;
        f32x4 acc[2][2];
#pragma unroll
        for (int bj = 0; bj < 2; ++bj)
#pragma unroll
            for (int n = 0; n < 2; ++n) acc[bj][n] = (f32x4){0.f, 0.f, 0.f, 0.f};
        const int nst = K / 256;
        for (int s0 = 0; s0 < nst; s0 += 4) {
            bf16x8 af[4], bfr[4][4];
#pragma unroll
            for (int t = 0; t < 4; ++t) if (s0 + t < nst) { const int kk = wid * nst + s0 + t;
                af[t] = *(const bf16x8*)(ap + 32 * kk);
#pragma unroll
                for (int bj = 0; bj < 2; ++bj)
#pragma unroll
                    for (int n = 0; n < 2; ++n) bfr[t][bj * 2 + n] = *(const bf16x8*)(bp + (size_t)(128 * bj + 4 * n) * K + 32 * kk); }
#pragma unroll
            for (int t = 0; t < 4; ++t) if (s0 + t < nst) {
#pragma unroll
                for (int bj = 0; bj < 2; ++bj)
#pragma unroll
                    for (int n = 0; n < 2; ++n) acc[bj][n] = __builtin_amdgcn_mfma_f32_16x16x32_bf16(bfr[t][bj * 2 + n], af[t], acc[bj][n], 0, 0, 0); }
        }
        LAS f32x4* r4 = (LAS f32x4*)red;
#pragma unroll
        for (int bj = 0; bj < 2; ++bj)
#pragma unroll
            for (int n = 0; n < 2; ++n) r4[(wid * 4 + bj * 2 + n) * 64 + lane] = acc[bj][n];
        __syncthreads();
        if (wid == 0) {
            f32x4 s0 = r4[lane], s1 = r4[64 + lane], s2 = r4[128 + lane], s3 = r4[192 + lane];
#pragma unroll
            for (int w = 1; w < 8; ++w) { s0 = s0 + r4[(w * 4) * 64 + lane]; s1 = s1 + r4[(w * 4 + 1) * 64 + lane]; s2 = s2 + r4[(w * 4 + 2) * 64 + lane]; s3 = s3 + r4[(w * 4 + 3) * 64 + lane]; }
            epi_frag(E, MREAL + fr, pn, wc, fq, s0, s1, s2, s3);
        }
        __syncthreads();
    }
}

template <class Epi> __device__ __forceinline__ void meta_gemm8(LAS unsigned char* red, const unsigned char* A, int lda, const unsigned char* Bt, int K, int N, const Epi& E, int G) {
    const int tid = threadIdx.x, wid = __builtin_amdgcn_readfirstlane(tid >> 6), lane = tid & 63, fr = lane & 15, fq = lane >> 4;
    int one8 = 0x7f7f7f7f; asm volatile("" : "+v"(one8));
    for (int task = blockIdx.x; task < N / 64; task += G) {
        const int pn = task >> 2, wc = task & 3;
        const unsigned char* ap = A + (size_t)(MREAL + fr) * lda + 32 * fq;
        const unsigned char* bp = Bt + (size_t)(256 * pn + 32 * wc + 8 * (fr >> 2) + (fr & 3)) * K + 32 * fq;
        f32x4 acc[2][2];
#pragma unroll
        for (int bj = 0; bj < 2; ++bj)
#pragma unroll
            for (int n = 0; n < 2; ++n) acc[bj][n] = (f32x4){0.f, 0.f, 0.f, 0.f};
        asm volatile("s_nop 7" ::: "memory");
        for (int kk = wid; kk < K / 128; kk += 8) {
            const v8i af = __builtin_shufflevector(*(const v4i*)(ap + 128 * kk), *(const v4i*)(ap + 128 * kk + 16), 0, 1, 2, 3, 4, 5, 6, 7);
            v8i bf[2][2];
#pragma unroll
            for (int bj = 0; bj < 2; ++bj)
#pragma unroll
                for (int n = 0; n < 2; ++n) { const unsigned char* q = bp + (size_t)(128 * bj + 4 * n) * K + 128 * kk; bf[bj][n] = __builtin_shufflevector(*(const v4i*)q, *(const v4i*)(q + 16), 0, 1, 2, 3, 4, 5, 6, 7); }
#pragma unroll
            for (int bj = 0; bj < 2; ++bj)
#pragma unroll
                for (int n = 0; n < 2; ++n) asm volatile("v_mfma_scale_f32_16x16x128_f8f6f4 %0, %1, %2, %0, %3, %3 op_sel_hi:[0,0,0]" : "+v"(acc[bj][n]) : "v"(bf[bj][n]), "v"(af), "v"(one8));
        }
        asm volatile("s_nop 15\n\ts_nop 7" ::: "memory");
        LAS f32x4* r4 = (LAS f32x4*)red;
#pragma unroll
        for (int bj = 0; bj < 2; ++bj)
#pragma unroll
            for (int n = 0; n < 2; ++n) r4[(wid * 4 + bj * 2 + n) * 64 + lane] = acc[bj][n];
        __syncthreads();
        if (wid == 0) {
            f32x4 s0 = r4[lane], s1 = r4[64 + lane], s2 = r4[128 + lane], s3 = r4[192 + lane];
#pragma unroll
            for (int w = 1; w < 8; ++w) { s0 = s0 + r4[(w * 4) * 64 + lane]; s1 = s1 + r4[(w * 4 + 1) * 64 + lane]; s2 = s2 + r4[(w * 4 + 2) * 64 + lane]; s3 = s3 + r4[(w * 4 + 3) * 64 + lane]; }
            epi_frag(E, MREAL + fr, pn, wc, fq, s0, s1, s2, s3);
        }
        __syncthreads();
    }
}
}

#define XB_TMO      128
#define XB_XCNT(j)  (256  + 64 * (j))
#define XB_XSUB(j)  (1280 + 64 * (j))
#define XB_XGEN(j)  (2304 + 64 * (j))
#define XB_TOP      3328
#define XB_TOPGEN   3392
#define XCD_BAR_WORDS 3456
#define XB_SPIN_CAP (1u << 18)
__device__ __forceinline__ unsigned xb_ld(unsigned* p)              { return __hip_atomic_load(p, __ATOMIC_RELAXED, __HIP_MEMORY_SCOPE_AGENT); }
__device__ __forceinline__ unsigned xb_add(unsigned* p, unsigned v) { return __hip_atomic_fetch_add(p, v, __ATOMIC_RELAXED, __HIP_MEMORY_SCOPE_AGENT); }
__device__ __forceinline__ unsigned xb_xcc_id() { return (unsigned)__builtin_amdgcn_s_getreg((3 << 11) | 20) & 0xFu; }
#define XB_SPIN(cond, bar) do { unsigned _sp = 0; while (cond) { __builtin_amdgcn_s_sleep(1); \
    if ((++_sp & 255u) == 0u) { if (xb_ld(&(bar)[XB_TMO])) break; if (_sp > XB_SPIN_CAP) { atomicAdd(&(bar)[XB_TMO], 1u); break; } } } } while (0)
struct XcdBarrier { unsigned* bar; unsigned x; volatile LAS unsigned* st; };
__device__ __forceinline__ XcdBarrier xcd_barrier_post(unsigned* bar, volatile LAS unsigned* st) {
    XcdBarrier b; b.bar = bar; b.x = xb_xcc_id(); b.st = st;
    if (threadIdx.x == 0) (void)xb_add(&bar[XB_XCNT(b.x)], 1u);
    return b;
}
__device__ __forceinline__ void xcd_barrier_complete(unsigned* bar, unsigned x, unsigned& nloc, unsigned& nx) {
    const unsigned G = gridDim.x * gridDim.y * gridDim.z;
    unsigned sum, cnt, mine, sp = 0u;
    for (;;) {
        sum = 0u; cnt = 0u; mine = 0u;
#pragma unroll
        for (unsigned j = 0; j < 16; ++j) { const unsigned c = xb_ld(&bar[XB_XCNT(j)]); sum += c; cnt += (c > 0u) ? 1u : 0u; mine = (j == x) ? c : mine; }
        if (sum == G) break;
        __builtin_amdgcn_s_sleep(1);
        if ((++sp & 255u) == 0u) { if (xb_ld(&bar[XB_TMO])) break; if (sp > XB_SPIN_CAP) { atomicAdd(&bar[XB_TMO], 1u); break; } }
    }
    nloc = mine > 0u ? mine : 1u; nx = cnt > 0u ? cnt : 1u;
}
__device__ __forceinline__ void xcd_barrier(const XcdBarrier& b) {
    asm volatile("s_waitcnt vmcnt(0)" ::: "memory");
    __syncthreads();
    if (threadIdx.x == 0) {
        unsigned* bar = b.bar;
        __builtin_amdgcn_s_waitcnt(0);
        unsigned nloc = b.st[0], nx = b.st[1];
        if (nloc == 0u) { xcd_barrier_complete(bar, b.x, nloc, nx); b.st[0] = nloc; b.st[1] = nx; }
        const unsigned old = xb_add(&bar[XB_XSUB(b.x)], 1u);
        const unsigned gen = old / nloc;
        if (old + 1u == (gen + 1u) * nloc) {
            __builtin_amdgcn_fence(__ATOMIC_RELEASE, "agent");
            asm volatile("s_waitcnt vmcnt(0)" ::: "memory");
            const unsigned og = xb_add(&bar[XB_TOP], 1u);
            const unsigned tg = og / nx;
            if (og + 1u == (tg + 1u) * nx) xb_add(&bar[XB_TOPGEN], 1u);
            else XB_SPIN(xb_ld(&bar[XB_TOPGEN]) == tg, bar);
            __builtin_amdgcn_fence(__ATOMIC_ACQUIRE, "agent");
            xb_add(&bar[XB_XGEN(b.x)], 1u);
            asm volatile("s_waitcnt vmcnt(0)" ::: "memory");
        } else {
            XB_SPIN(xb_ld(&bar[XB_XGEN(b.x)]) == gen, bar);
            __builtin_amdgcn_fence(__ATOMIC_ACQUIRE, "agent");
            asm volatile("s_waitcnt vmcnt(0)" ::: "memory");
        }
    }
    __syncthreads();
}

struct Args { const float* in[22]; float* out; unsigned char* ws; int ph_lo, ph_hi; };

template <int MAP> __device__ __forceinline__ int map_row(int n) {
    if (MAP == 1) { const int i = n & 127; return (n & ~127) + 2 * (i & 63) + (i >> 6); }
    if (MAP == 2) return (n >> 7) * 256 + (n & 127);
    if (MAP == 3) return (n >> 7) * 256 + 128 + (n & 127);
    return n;
}
template <int MAP> __device__ __forceinline__ void wt_item(const float* W, int K, int ldw, int N, bf16_t* WT, const float* gain, LAS float* scr, int item, int lane) {
    const int nblk = N / 32, kb = item / nblk, nb = item % nblk, k0 = 64 * kb, n0 = 32 * nb;
    { f32x4 v[8]; float gv[8];
#pragma unroll
      for (int i = 0; i < 8; ++i) { const int kk = 8 * i + (lane >> 3); v[i] = *(const f32x4*)(W + (size_t)(k0 + kk) * ldw + n0 + 4 * (lane & 7)); gv[i] = gain ? gain[k0 + kk] : 1.0f; }
#pragma unroll
      for (int i = 0; i < 8; ++i) { const int kk = 8 * i + (lane >> 3); LAS float* d = scr + kk * 33 + 4 * (lane & 7); d[0] = v[i][0] * gv[i]; d[1] = v[i][1] * gv[i]; d[2] = v[i][2] * gv[i]; d[3] = v[i][3] * gv[i]; } }
    LDS_WAIT(); asm volatile("" ::: "memory");
    const int c = lane & 7;
#pragma unroll
    for (int j = 0; j < 4; ++j) { const int n = (lane >> 3) + 8 * j; const LAS float* s = scr + (8 * c) * 33 + n;
        u32x4 o; o.x = pk2(s[0 * 33], s[1 * 33]); o.y = pk2(s[2 * 33], s[3 * 33]); o.z = pk2(s[4 * 33], s[5 * 33]); o.w = pk2(s[6 * 33], s[7 * 33]);
        *(u32x4*)(WT + (size_t)map_row<MAP>(n0 + n) * K + k0 + 8 * c) = o; }
    LDS_WAIT(); asm volatile("" ::: "memory");
}
template <int MAP> __device__ __forceinline__ void wt_item8(const float* W, int K, int ldw, int N, unsigned char* WT, const float* gain, float scale, LAS float* scr, int item, int lane) {
    const int nblk = N / 32, kb = item / nblk, nb = item % nblk, k0 = 64 * kb, n0 = 32 * nb;
    { f32x4 v[8]; float gv[8];
#pragma unroll
      for (int i = 0; i < 8; ++i) { const int kk = 8 * i + (lane >> 3); v[i] = *(const f32x4*)(W + (size_t)(k0 + kk) * ldw + n0 + 4 * (lane & 7)); gv[i] = (gain ? gain[k0 + kk] : 1.0f) * scale; }
#pragma unroll
      for (int i = 0; i < 8; ++i) { const int kk = 8 * i + (lane >> 3); LAS float* d = scr + kk * 33 + 4 * (lane & 7); d[0] = v[i][0] * gv[i]; d[1] = v[i][1] * gv[i]; d[2] = v[i][2] * gv[i]; d[3] = v[i][3] * gv[i]; } }
    LDS_WAIT(); asm volatile("" ::: "memory");
    const int c = lane & 7;
#pragma unroll
    for (int j = 0; j < 4; ++j) { const int n = (lane >> 3) + 8 * j; const LAS float* sp = scr + (8 * c) * 33 + n;
        *(u32x2*)(WT + (size_t)map_row<MAP>(n0 + n) * K + k0 + 8 * c) = pg8::pack_fp8x8(sp[0 * 33], sp[1 * 33], sp[2 * 33], sp[3 * 33], sp[4 * 33], sp[5 * 33], sp[6 * 33], sp[7 * 33]); }
    LDS_WAIT(); asm volatile("" ::: "memory");
}
template <int MAP> __device__ __forceinline__ void wt_matrix8(const float* W, int K, int ldw, int N, unsigned char* WT, const float* gain, float scale, LAS float* scr, int gw, int NGW, int lane) {
    const int nitems = (K / 64) * (N / 32);
    for (int it = gw; it < nitems; it += NGW) wt_item8<MAP>(W, K, ldw, N, WT, gain, scale, scr, it, lane);
}
template <int MAP> __device__ __forceinline__ void wt_matrix(const float* W, int K, int ldw, int N, bf16_t* WT, const float* gain, LAS float* scr, int gw, int NGW, int lane) {
    const int nitems = (K / 64) * (N / 32);
    for (int it = gw; it < nitems; it += NGW) wt_item<MAP>(W, K, ldw, N, WT, gain, scr, it, lane);
}

enum Phase { P_PRO = 0,
    P0_QKVG, P0_RET, P0_FIN, P0_WO, P0_W13, P0_W2,
    P1_QKV, P1_SB, P1_WO, P1_RA, P1_RB, P1_M13, P1_M2, P1_CMB,
    P2_PREP, P2_POOL, P2_W13, P2_W2,
    P3_QKVG, P3_RET, P3_FIN, P3_WO, P3_RA, P3_RB, P3_M13, P3_M2, P3_CMB,
    P_FINAL, P_COUNT };

struct Ctx {
    LAS unsigned char* lds; int tid, lane, wave, G, gw, NGW;
    const float* const* in; float* out; unsigned char* ws;
    bf16_t* H; float* ssq; float* gst; bf16_t* WA; bf16_t* WB; unsigned char* pool; unsigned char* misc; f32x2* tab; int* moe;
};

__device__ __forceinline__ void conv_ret(const Ctx& C, int j, int layer, bf16_t* mix, bf16_t* wo) {
    LAS float* scr = (LAS float*)(C.lds + C.wave * 16384);
    const float* g = C.in[2] + (size_t)layer * D;
    wt_matrix<1>(C.in[4] + (size_t)j * D * D, D, D, D, mix, g, scr, C.gw, C.NGW, C.lane);
    wt_matrix<1>(C.in[5] + (size_t)j * D * D, D, D, D, mix + (size_t)1024 * D, g, scr, C.gw, C.NGW, C.lane);
    wt_matrix<0>(C.in[6] + (size_t)j * D * 2 * D, D, 2 * D, 2 * D, mix + (size_t)2048 * D, g, scr, C.gw, C.NGW, C.lane);
    wt_matrix<0>(C.in[7] + (size_t)j * D * 2 * D, D, 2 * D, 2 * D, mix + (size_t)4096 * D, g, scr, C.gw, C.NGW, C.lane);
    wt_matrix<0>(C.in[8] + (size_t)j * 2 * D * D, 2 * D, D, D, wo, nullptr, scr, C.gw, C.NGW, C.lane);
}
constexpr float F8_WP = 32.0f, F8_WO = 32.0f, F8_A2 = 8.0f;
__device__ __forceinline__ void conv_ret8(const Ctx& C, int j, int layer, bf16_t* mix_, bf16_t* wo_) {
    LAS float* scr = (LAS float*)(C.lds + C.wave * 16384);
    const float* g = C.in[2] + (size_t)layer * D;
    unsigned char* mix = (unsigned char*)mix_; unsigned char* wo = (unsigned char*)wo_;
    wt_matrix8<1>(C.in[4] + (size_t)j * D * D, D, D, D, mix, g, F8_WP, scr, C.gw, C.NGW, C.lane);
    wt_matrix8<1>(C.in[5] + (size_t)j * D * D, D, D, D, mix + (size_t)1024 * D, g, F8_WP, scr, C.gw, C.NGW, C.lane);
    wt_matrix8<0>(C.in[6] + (size_t)j * D * 2 * D, D, 2 * D, 2 * D, mix + (size_t)2048 * D, g, F8_WP, scr, C.gw, C.NGW, C.lane);
    wt_matrix8<0>(C.in[7] + (size_t)j * D * 2 * D, D, 2 * D, 2 * D, mix + (size_t)4096 * D, g, F8_WP, scr, C.gw, C.NGW, C.lane);
    wt_matrix8<0>(C.in[8] + (size_t)j * 2 * D * D, 2 * D, D, D, wo, nullptr, F8_WO, scr, C.gw, C.NGW, C.lane);
}
__device__ __forceinline__ void conv_dense(const Ctx& C, int c, int layer, bf16_t* w13_, bf16_t* w2_) {
    LAS float* scr = (LAS float*)(C.lds + C.wave * 16384);
    const float* g = C.in[3] + (size_t)layer * D;
    unsigned char* w13 = (unsigned char*)w13_; unsigned char* w2 = (unsigned char*)w2_;
    wt_matrix8<2>(C.in[14] + (size_t)c * D * FF, D, FF, FF, w13, g, pg8::F8_W13, scr, C.gw, C.NGW, C.lane);
    wt_matrix8<3>(C.in[15] + (size_t)c * D * FF, D, FF, FF, w13, g, pg8::F8_W13, scr, C.gw, C.NGW, C.lane);
    wt_matrix8<0>(C.in[16] + (size_t)c * FF * D, FF, D, D, w2, nullptr, pg8::F8_W2, scr, C.gw, C.NGW, C.lane);
}
__device__ __forceinline__ void conv_dense_bf16(const Ctx& C, int c, int layer, bf16_t* w13, bf16_t* w2) {
    LAS float* scr = (LAS float*)(C.lds + C.wave * 16384);
    const float* g = C.in[3] + (size_t)layer * D;
    wt_matrix<2>(C.in[14] + (size_t)c * D * FF, D, FF, FF, w13, g, scr, C.gw, C.NGW, C.lane);
    wt_matrix<3>(C.in[15] + (size_t)c * D * FF, D, FF, FF, w13, g, scr, C.gw, C.NGW, C.lane);
    wt_matrix<0>(C.in[16] + (size_t)c * FF * D, FF, D, D, w2, nullptr, scr, C.gw, C.NGW, C.lane);
}
__device__ __forceinline__ void conv_moe(const Ctx& C, int c, int layer, bf16_t* w13_, bf16_t* w2_) {
    LAS float* scr = (LAS float*)(C.lds + C.wave * 16384);
    const float* g = C.in[3] + (size_t)layer * D;
    unsigned char* w13 = (unsigned char*)w13_; unsigned char* w2 = (unsigned char*)w2_;
    for (int e = 0; e < NE; ++e) {
        wt_matrix8<2>(C.in[18] + ((size_t)c * NE + e) * D * FF, D, FF, FF, w13 + (size_t)e * 5632 * D, g, pg8::F8_W13, scr, C.gw, C.NGW, C.lane);
        wt_matrix8<3>(C.in[19] + ((size_t)c * NE + e) * D * FF, D, FF, FF, w13 + (size_t)e * 5632 * D, g, pg8::F8_W13, scr, C.gw, C.NGW, C.lane);
        wt_matrix8<0>(C.in[20] + ((size_t)c * NE + e) * FF * D, FF, D, D, w2 + (size_t)e * D * FF, nullptr, pg8::F8_W2, scr, C.gw, C.NGW, C.lane);
    }
}

template <class Epi> __device__ __forceinline__ void run_dense(const Ctx& C, const bf16_t* A, int lda, size_t a_pn_bytes, const bf16_t* Bt, int K, int N, const Epi& E) {
#if PROBE_GROUP == 60
    const unsigned long long _pt0 = __builtin_amdgcn_s_memrealtime();
#endif
    pg8::meta_gemm(C.lds, A, lda, a_pn_bytes / 2, Bt, K, N, E, C.G);
#if PROBE_GROUP == 60
    asm volatile("s_waitcnt vmcnt(0)" ::: "memory"); if (blockIdx.x == 0 && C.tid == 0) *(LAS unsigned long long*)(C.lds + LDSCTL_OFF + 8192) += __builtin_amdgcn_s_memrealtime() - _pt0;
#endif
    pg8::Sched<false> S; S.nM = MREAL / 256; S.nN = N / 256; S.nwg = S.nM * S.nN; S.G = C.G; S.c = (int)blockIdx.x;
    S.A = (const char*)A; S.Bt = (const char*)Bt; S.a_pm = (size_t)256 * lda * 2; S.a_pn = a_pn_bytes; S.b_pn = (size_t)256 * K * 2; S.b_e = 0; S.pexp = nullptr;
    pg8::gemm_phase(C.lds, K, lda, S, E);
}
template <class Epi> __device__ __forceinline__ void run_dense8(const Ctx& C, const unsigned char* A, int lda, const unsigned char* Bt, int K, int N, const Epi& E) {
#if PROBE_GROUP == 60
    const unsigned long long _pt0 = __builtin_amdgcn_s_memrealtime();
#endif
    pg8::meta_gemm8(C.lds, A, lda, Bt, K, N, E, C.G);
#if PROBE_GROUP == 60
    asm volatile("s_waitcnt vmcnt(0)" ::: "memory"); if (blockIdx.x == 0 && C.tid == 0) *(LAS unsigned long long*)(C.lds + LDSCTL_OFF + 8192) += __builtin_amdgcn_s_memrealtime() - _pt0;
#endif
    pg8::Sched<false> S; S.nM = MREAL / 256; S.nN = N / 256; S.nwg = S.nM * S.nN; S.G = C.G; S.c = (int)blockIdx.x;
    S.A = (const char*)A; S.Bt = (const char*)Bt; S.a_pm = (size_t)256 * lda; S.a_pn = 0; S.b_pn = (size_t)256 * K; S.b_e = 0; S.pexp = nullptr;
    pg8::gemm_phase8(C.lds, K, lda, S, E);
}
template <class Epi> __device__ __forceinline__ void run_moe(const Ctx& C, const int* seg, const bf16_t* A, const bf16_t* Bt, size_t b_e_bytes, int K, int N, const Epi& E) {
    LAS int* pexp = (LAS int*)(C.lds + LDS_PEXP);
    const int total = seg[8] / 256;
    for (int p = C.tid; p < total; p += 512) { int e = 0;
#pragma unroll
        for (int j = 1; j < 8; ++j) e += (p * 256 >= seg[j]) ? 1 : 0;
        pexp[p] = e; }
    __syncthreads();
    pg8::Sched<true> S; S.nM = total; S.nN = N / 256; S.nwg = S.nM * S.nN; S.G = C.G; S.c = (int)blockIdx.x;
    S.A = (const char*)A; S.Bt = (const char*)Bt; S.a_pm = (size_t)256 * K * 2; S.a_pn = 0; S.b_pn = (size_t)256 * K * 2; S.b_e = b_e_bytes; S.pexp = pexp;
    pg8::gemm_phase(C.lds, K, K, S, E);
    __syncthreads();
}

template <class Epi> __device__ __forceinline__ void run_moe8(const Ctx& C, const int* seg, const unsigned char* A, const unsigned char* Bt, size_t b_e_bytes, int K, int N, const Epi& E, const int* srow = nullptr) {
    LAS int* pexp = (LAS int*)(C.lds + LDS_PEXP);
    const int total = seg[8] / 256;
    for (int p = C.tid; p < total; p += 512) { int e = 0;
#pragma unroll
        for (int j = 1; j < 8; ++j) e += (p * 256 >= seg[j]) ? 1 : 0;
        pexp[p] = e; }
    __syncthreads();
    pg8::Sched<true> S; S.nM = total; S.nN = N / 256; S.nwg = S.nM * S.nN; S.G = C.G; S.c = (int)blockIdx.x;
    S.A = (const char*)A; S.Bt = (const char*)Bt; S.a_pm = (size_t)256 * K; S.a_pn = 0; S.b_pn = (size_t)256 * K; S.b_e = b_e_bytes; S.pexp = pexp;
    if (srow) pg8::gemm_phase8g(C.lds, K, A, srow, S, E); else pg8::gemm_phase8(C.lds, K, K, S, E);
    __syncthreads();
}
__device__ __forceinline__ void ret_finalize(const Ctx& C, int j, const bf16_t* Y, const bf16_t* YM, bf16_t* Gt, const float* gst, unsigned char* A8 = nullptr) {
    const float* gn = C.in[9] + (size_t)j * 2 * D;
    for (int row = C.gw; row < MVALID; row += C.NGW) {
        const bf16_t* yrow = row < MREAL ? Y + (size_t)row * 2048 : YM + (size_t)(row - MREAL) * 2048;
        u32x4 yv[4], gv[4]; f32x4 ga[4], gb[4];
#pragma unroll
        for (int q = 0; q < 4; ++q) { const int col = q * 512 + C.lane * 8, h = col >> 8;
            yv[q] = *(const u32x4*)(yrow + col); gv[q] = *(const u32x4*)(Gt + (size_t)row * 2048 + col);
            ga[q] = *(const f32x4*)(gst + ((size_t)row * 8 + h) * 8); gb[q] = *(const f32x4*)(gst + ((size_t)row * 8 + h) * 8 + 4); }
#pragma unroll
        for (int q = 0; q < 4; ++q) {
            const int col = q * 512 + C.lane * 8;
            const float s1 = (ga[q][0] + ga[q][2]) + (gb[q][0] + gb[q][2]), s2 = (ga[q][1] + ga[q][3]) + (gb[q][1] + gb[q][3]);
            const float mu = s1 * (1.0f / 256.0f); const float var = fmaxf(s2 * (1.0f / 256.0f) - mu * mu, 0.f); const float rs = __builtin_amdgcn_rsqf(var + EPS);
            const f32x4 g0 = *(const f32x4*)(gn + col) * rs, g1 = *(const f32x4*)(gn + col + 4) * rs;
            if (A8) {
                *(u32x2*)(A8 + (size_t)row * 2048 + col) = pg8::pack_fp8x8(
                    F8_A2 * bflo(gv[q].x) * (bflo(yv[q].x) - mu) * g0[0], F8_A2 * bfhi(gv[q].x) * (bfhi(yv[q].x) - mu) * g0[1], F8_A2 * bflo(gv[q].y) * (bflo(yv[q].y) - mu) * g0[2], F8_A2 * bfhi(gv[q].y) * (bfhi(yv[q].y) - mu) * g0[3],
                    F8_A2 * bflo(gv[q].z) * (bflo(yv[q].z) - mu) * g1[0], F8_A2 * bfhi(gv[q].z) * (bfhi(yv[q].z) - mu) * g1[1], F8_A2 * bflo(gv[q].w) * (bflo(yv[q].w) - mu) * g1[2], F8_A2 * bfhi(gv[q].w) * (bfhi(yv[q].w) - mu) * g1[3]);
                continue;
            }
            u32x4 w;
            w.x = pk2(bflo(gv[q].x) * (bflo(yv[q].x) - mu) * g0[0], bfhi(gv[q].x) * (bfhi(yv[q].x) - mu) * g0[1]);
            w.y = pk2(bflo(gv[q].y) * (bflo(yv[q].y) - mu) * g0[2], bfhi(gv[q].y) * (bfhi(yv[q].y) - mu) * g0[3]);
            w.z = pk2(bflo(gv[q].z) * (bflo(yv[q].z) - mu) * g1[0], bfhi(gv[q].z) * (bfhi(yv[q].z) - mu) * g1[1]);
            w.w = pk2(bflo(gv[q].w) * (bflo(yv[q].w) - mu) * g1[2], bfhi(gv[q].w) * (bfhi(yv[q].w) - mu) * g1[3]);
            *(u32x4*)(Gt + (size_t)row * 2048 + col) = w;
        }
    }
}

__device__ __forceinline__ void ret_naive(const Ctx& C, const bf16_t* Q, const bf16_t* Kk, bf16_t* V, bf16_t* YM, float* gst) {
    for (int item = blockIdx.x; item < NBATCH * 8 * 2; item += C.G) {
        const int half = item & 1, h = (item >> 1) & 7, b = item >> 4;
        if (C.tid < 128) {
            const int e = half * 128 + C.tid;
            const float gamma = 1.0f - exp2f(-5.0f - (float)h);
            float S[128];
#pragma unroll
            for (int d = 0; d < 128; ++d) S[d] = 0.f;
            for (int p = 0; p < LPOS; ++p) {
                const int row = pos_row(b, p);
                const u32x4* qp = (const u32x4*)(Q + (size_t)row * D + h * 128);
                const u32x4* kp = (const u32x4*)(Kk + (size_t)row * D + h * 128);
                bf16_t* vp = V + (size_t)row * 2048 + h * 256 + e;
                const float v = bf1(*vp);
                float y = 0.f;
#pragma unroll
                for (int jj = 0; jj < 16; ++jj) {
                    const u32x4 kq = kp[jj], qq = qp[jj];
                    const unsigned kw[4] = {kq.x, kq.y, kq.z, kq.w}, qw[4] = {qq.x, qq.y, qq.z, qq.w};
#pragma unroll
                    for (int i = 0; i < 4; ++i) {
                        S[8 * jj + 2 * i] = gamma * S[8 * jj + 2 * i] + bflo(kw[i]) * v; y += bflo(qw[i]) * S[8 * jj + 2 * i];
                        S[8 * jj + 2 * i + 1] = gamma * S[8 * jj + 2 * i + 1] + bfhi(kw[i]) * v; y += bfhi(qw[i]) * S[8 * jj + 2 * i + 1];
                    }
                }
                if (p >= NMETA || b == 0) {
                    if (p >= NMETA) *vp = (bf16_t)f2bf(y); else YM[(size_t)p * 2048 + h * 256 + e] = (bf16_t)f2bf(y);
                    const float s1 = wave_sum(y), s2 = wave_sum(y * y);
                    if (C.lane == 0) { *(f32x2*)(gst + ((size_t)row * 8 + h) * 8 + (half * 2 + C.wave) * 2) = (f32x2){s1, s2}; }
                }
            }
        }
    }
}


__device__ __forceinline__ void glds16(const void* gsrc, unsigned lds_dst) { unsigned keep;
    asm volatile("s_mov_b32 %0, m0\n\ts_mov_b32 m0, %2\n\ts_nop 0\n\tglobal_load_lds_dwordx4 %1, off\n\ts_mov_b32 m0, %0" : "=&s"(keep) : "v"(gsrc), "s"(lds_dst) : "memory"); }
__device__ __forceinline__ void gstore8_asm(void* p, u32x2 v) { asm volatile("global_store_dwordx2 %0, %1, off" :: "v"(p), "v"(v) : "memory"); }
__device__ __forceinline__ void gstore16_asm(void* p, f32x4 v) { asm volatile("global_store_dwordx4 %0, %1, off\n\ts_nop 1" :: "v"(p), "v"(v) : "memory"); }
namespace retm {
typedef float f32x16 __attribute__((ext_vector_type(16)));
typedef short s16x4 __attribute__((ext_vector_type(4)));
typedef short v4i16_t __attribute__((ext_vector_type(4)));
constexpr int L_KROW = 0, L_KTR = 32768, L_V = 65536, L_ST = 98304;
__device__ __forceinline__ int crow(int r, int hi) { return (r & 3) + 8 * (r >> 2) + 4 * hi; }
__device__ __forceinline__ s16x4 vtr(const LAS unsigned char* p) { return __builtin_bit_cast(s16x4, __builtin_amdgcn_ds_read_tr16_b64_v4i16((LAS v4i16_t*)p)); }
__device__ __forceinline__ float partner32(float x, int hi) { auto rr = __builtin_amdgcn_permlane32_swap(__float_as_uint(x), __float_as_uint(x), false, false); return __uint_as_float(hi ? rr[0] : rr[1]); }
__device__ __forceinline__ int grow(int b, int i, int j) { return i == 0 ? (j >= 112 ? MREAL + (j - 112) : MVALID) : b * SEQ + (i - 1) * 128 + j; }
__device__ __forceinline__ bf16x8 pack8(const f32x16& v, int o) { u32x4 a; a.x = pk2(v[o], v[o + 1]); a.y = pk2(v[o + 2], v[o + 3]); a.z = pk2(v[o + 4], v[o + 5]); a.w = pk2(v[o + 6], v[o + 7]); return __builtin_bit_cast(bf16x8, a); }
__device__ __forceinline__ bf16x8 trfrag(const LAS unsigned char* p) { const s16x4 a = vtr(p), c = vtr(p + 512); return (bf16x8){a[0], a[1], a[2], a[3], c[0], c[1], c[2], c[3]}; }

__device__ __forceinline__ void stats_flush(const LAS float* st, int b, int h, int half, int i, float* gst, int tid) {
    if (tid < 128) {
        const int j = tid; const bool ok = (i > 0) || (j >= 112 && b == 0);
        if (ok) { const int row = grow(b, i, j);
            const LAS f32x2* p = (const LAS f32x2*)(st + j * 8);
            const f32x2 a = p[0], c = p[1], d = p[2], e = p[3];
            *(f32x4*)(gst + ((size_t)row * 8 + h) * 8 + half * 4) = (f32x4){a[0] + c[0], a[1] + c[1], d[0] + e[0], d[1] + e[1]}; }
    }
}

constexpr int STAGE = 49152, S_K = 0, S_Q = 16384, S_V = 32768;
constexpr int L_ST2 = LDSCTL_OFF + 2048;

__device__ __forceinline__ void stats_flush64(const LAS float* st, int b, int h, int half, int j, float* gst, int tid) {
    if (tid < 64) {
        const int i = j >> 1, jr = 64 * (j & 1) + tid; const bool ok = (i > 0) || (jr >= 112 && b == 0);
        if (ok) { const int row = grow(b, i, jr);
            const LAS f32x2* p = (const LAS f32x2*)(st + tid * 8);
            const f32x2 a = p[0], c = p[1], d = p[2], e = p[3];
            gstore16_asm(gst + ((size_t)row * 8 + h) * 8 + half * 4, (f32x4){a[0] + c[0], a[1] + c[1], d[0] + e[0], d[1] + e[1]}); }
    }
}

__device__ __forceinline__ void ret_item(LAS unsigned char* lds, int b, int h, int half, const bf16_t* Q, const bf16_t* K, bf16_t* V, bf16_t* YM, float* gst, int wid, int lane, int tid) {
    const int r32 = lane & 31, hi = lane >> 5, et = wid & 3, cbl = wid >> 2;
    const float gamma = 1.0f - exp2f(-5.0f - (float)h); const float g128 = exp2f(128.0f * log2f(gamma));
    f32x16 T[4];
#pragma unroll
    for (int d = 0; d < 4; ++d) T[d] = (f32x16){};
    LAS float* st = (LAS float*)(lds + L_ST2);
    const unsigned lds0 = (unsigned)(size_t)lds;
    const int trq = (lane & 15) >> 2, trp = lane & 3, trb = (lane >> 4) & 1;
    const int troff = (4 * hi + trq) * 64 + trb * 32 + trp * 8;
    const int trp2 = ((trp & 1) << 1) | (trp >> 1);
    const int ktr_ch = 2 * trb + (trp2 >> 1);
    const int ktr_lane = ktr_ch * 1024 + (trp2 & 1) * 8;
    const int ktr_r0 = ((4 * hi + trq) ^ (4 * ktr_ch)) * 16, ktr_r1 = ((4 * hi + 8 + trq) ^ (4 * ktr_ch)) * 16;
    const int krA = hi * 1024 + (r32 ^ (4 * hi)) * 16, krB = hi * 1024 + (r32 ^ (8 + 4 * hi)) * 16;
    const int qro = hi * 1024 + (32 * cbl + r32) * 16;
    const int vrow = lane >> 2;
#define RET_DMA(jj, stg) do { const int _i = (jj) >> 1, _r0 = 64 * ((jj) & 1); const unsigned _base = lds0 + (stg) * STAGE; \
        _Pragma("unroll") for (int u = 0; u < 2; ++u) { const int pc = wid * 2 + u; \
            { const int rowk = grow(b, _i, _r0 + (lane ^ (4 * (pc & 3)))); glds16(K + (size_t)rowk * D + h * 128 + pc * 8, (unsigned)__builtin_amdgcn_readfirstlane(_base + S_K + pc * 1024)); } \
            { const int rowq = grow(b, _i, _r0 + lane); glds16(Q + (size_t)rowq * D + h * 128 + pc * 8, (unsigned)__builtin_amdgcn_readfirstlane(_base + S_Q + pc * 1024)); } \
            { const int rowv = grow(b, _i, _r0 + (pc & 3) * 16 + vrow); glds16(V + (size_t)rowv * 2048 + h * 256 + half * 128 + (pc >> 2) * 32 + (lane & 3) * 8, (unsigned)__builtin_amdgcn_readfirstlane(_base + S_V + pc * 1024)); } } } while (0)
    const bf16_t* kpt[2]; const bf16_t* qpt[2]; const bf16_t* vpt[2];
#pragma unroll
    for (int u = 0; u < 2; ++u) { const int pc = wid * 2 + u;
        kpt[u] = K + (size_t)(b * SEQ + (lane ^ (4 * (pc & 3)))) * D + h * 128 + pc * 8;
        qpt[u] = Q + (size_t)(b * SEQ + lane) * D + h * 128 + pc * 8;
        vpt[u] = V + (size_t)(b * SEQ + (pc & 3) * 16 + vrow) * 2048 + h * 256 + half * 128 + (pc >> 2) * 32 + (lane & 3) * 8; }
#define RET_DMA_FAST(stg) do { const unsigned _base = lds0 + (stg) * STAGE; \
        _Pragma("unroll") for (int u = 0; u < 2; ++u) { const int pc = wid * 2 + u; \
            glds16(kpt[u], (unsigned)__builtin_amdgcn_readfirstlane(_base + S_K + pc * 1024)); glds16(qpt[u], (unsigned)__builtin_amdgcn_readfirstlane(_base + S_Q + pc * 1024)); \
            glds16(vpt[u], (unsigned)__builtin_amdgcn_readfirstlane(_base + S_V + pc * 1024)); \
            kpt[u] += (size_t)64 * D; qpt[u] += (size_t)64 * D; vpt[u] += (size_t)64 * 2048; } } while (0)
    __builtin_amdgcn_s_waitcnt(0);
    RET_DMA(1, 1); RET_DMA_FAST(2);
    for (int j = 1; j < 34; ++j) {
#if PROBE_GROUP == 10 || PROBE_GROUP == 11
        const unsigned long long _pt0 = __builtin_amdgcn_s_memrealtime();
#endif
        if (j < 33) asm volatile("s_waitcnt vmcnt(6) lgkmcnt(0)" ::: "memory"); else asm volatile("s_waitcnt vmcnt(0) lgkmcnt(0)" ::: "memory");
        __builtin_amdgcn_s_barrier(); asm volatile("" ::: "memory");
#if PROBE_GROUP == 10
        if (blockIdx.x == 0 && tid == 0) *(LAS unsigned long long*)(lds + LDSCTL_OFF + 8192) += __builtin_amdgcn_s_memrealtime() - _pt0;
#endif
#if PROBE_GROUP == 11
        if (blockIdx.x == 0 && tid == 256) *(LAS unsigned long long*)(lds + LDSCTL_OFF + 8192) += __builtin_amdgcn_s_memrealtime() - _pt0;
#endif
        if (j > 1) stats_flush64(st, b, h, half, j - 1, gst, tid);
        const LAS unsigned char* sb_ = lds + (j % 3) * STAGE;
        const int i = j >> 1, hh = j & 1;
        if (hh == 0) {
#pragma unroll
            for (int d = 0; d < 4; ++d) T[d] *= g128;
        }
        bf16x8 qf[8];
#pragma unroll
        for (int ks = 0; ks < 8; ++ks) qf[ks] = *(const LAS bf16x8*)(sb_ + S_Q + (2 * ks) * 1024 + qro);
        __builtin_amdgcn_sched_barrier(0);
        f32x16 yT = {};
#pragma unroll
        for (int db = 0; db < 4; ++db) {
            yT = __builtin_amdgcn_mfma_f32_32x32x16_bf16(pack8(T[db], 0), qf[2 * db], yT, 0, 0, 0);
            yT = __builtin_amdgcn_mfma_f32_32x32x16_bf16(pack8(T[db], 8), qf[2 * db + 1], yT, 0, 0, 0);
        }
        for (int sb = 0; sb <= cbl; ++sb) {
            f32x16 sc = {};
            bf16x8 kfr[8];
#pragma unroll
            for (int ks = 0; ks < 8; ++ks) kfr[ks] = *(const LAS bf16x8*)(sb_ + S_K + sb * 512 + (2 * ks) * 1024 + ((ks & 1) ? krB : krA));
            const LAS unsigned char* vb = sb_ + S_V + et * 4096 + (32 * sb) * 64 + troff;
            const bf16x8 vf0 = trfrag(vb), vf1 = trfrag(vb + 1024);
            __builtin_amdgcn_sched_barrier(0);
#pragma unroll
            for (int ks = 0; ks < 8; ++ks) sc = __builtin_amdgcn_mfma_f32_32x32x16_bf16(kfr[ks], qf[ks], sc, 0, 0, 0);
            if (sb == cbl) {
#pragma unroll
                for (int r = 0; r < 16; ++r) if (crow(r, hi) > r32) sc[r] = 0.f;
            }
            yT = __builtin_amdgcn_mfma_f32_32x32x16_bf16(vf0, pack8(sc, 0), yT, 0, 0, 0);
            yT = __builtin_amdgcn_mfma_f32_32x32x16_bf16(vf1, pack8(sc, 8), yT, 0, 0, 0);
        }
        {
            const int jl = 32 * cbl + r32, jrow = 64 * hh + jl; const int row = grow(b, i, jrow);
            float s1 = 0.f, s2 = 0.f;
#pragma unroll
            for (int r = 0; r < 16; ++r) { s1 += yT[r]; s2 += yT[r] * yT[r]; }
            s1 += partner32(s1, hi); s2 += partner32(s2, hi);
            if (hi == 0) *(LAS f32x2*)(st + jl * 8 + et * 2) = (f32x2){s1, s2};
            const bool ok = (i > 0) || (jrow >= 112 && b == 0);
            if (ok) {
                bf16_t* yp = (i > 0 ? V + (size_t)row * 2048 : YM + (size_t)(row - MREAL) * 2048) + h * 256 + half * 128 + et * 32 + 4 * hi;
#pragma unroll
                for (int g = 0; g < 4; ++g) { u32x2 w; w.x = pk2(yT[4 * g], yT[4 * g + 1]); w.y = pk2(yT[4 * g + 2], yT[4 * g + 3]); gstore8_asm(yp + 8 * g, w); }
            }
        }
#pragma unroll
        for (int ks = 0; ks < 4; ++ks) {
            const bf16x8 vf = trfrag(sb_ + S_V + et * 4096 + (16 * ks) * 64 + troff);
            bf16x8 kf[4];
#pragma unroll
            for (int db = 0; db < 4; ++db) {
                const LAS unsigned char* kb = sb_ + S_K + db * 4096 + ks * 256 + ktr_lane;
                const s16x4 a = vtr(kb + ktr_r0), c = vtr(kb + ktr_r1);
                kf[db] = (bf16x8){a[0], a[1], a[2], a[3], c[0], c[1], c[2], c[3]};
            }
            __builtin_amdgcn_sched_barrier(0);
#pragma unroll
            for (int db = 0; db < 4; ++db) T[db] = __builtin_amdgcn_mfma_f32_32x32x16_bf16(kf[db], vf, T[db], 0, 0, 0);
        }
        if (j + 2 < 34) RET_DMA_FAST((j + 2) % 3);
    }
#undef RET_DMA
#undef RET_DMA_FAST
    asm volatile("s_waitcnt vmcnt(0) lgkmcnt(0)" ::: "memory"); __builtin_amdgcn_s_barrier(); asm volatile("" ::: "memory");
    stats_flush64(st, b, h, half, 33, gst, tid);
}

constexpr int STAGE5 = 57344, S5_K = 0, S5_Q = 16384, S5_V = 24576;
constexpr int L_ST5 = LDSCTL_OFF + 2048;
__device__ __forceinline__ u32x2 gload8_asm(const void* p) { u32x2 v; asm volatile("global_load_dwordx2 %0, %1, off" : "=v"(v) : "v"(p) : "memory"); return v; }
__device__ __forceinline__ void gstore4_asm(void* p, unsigned v) { asm volatile("global_store_dword %0, %1, off" :: "v"(p), "v"(v) : "memory"); }

template <bool F8OUT>
__device__ __forceinline__ void ret_item5(LAS unsigned char* lds, int b, int h, int rh, const bf16_t* Q, const bf16_t* K, const bf16_t* V, bf16_t* Gt, unsigned char* A8, const float* gn, int wid, int lane) {
    const int r32 = lane & 31, hi = lane >> 5, et = wid;
    const float gamma = 1.0f - exp2f(-5.0f - (float)h); const float g128 = exp2f(128.0f * log2f(gamma));
    f32x16 T[4];
#pragma unroll
    for (int d = 0; d < 4; ++d) T[d] = (f32x16){};
    LAS float* st = (LAS float*)(lds + L_ST5);
    const unsigned lds0 = (unsigned)(size_t)lds;
    const int trq = (lane & 15) >> 2, trp = lane & 3, trb = (lane >> 4) & 1;
    const int troff = (4 * hi + trq) * 64 + trb * 32 + trp * 8;
    const int trp2 = ((trp & 1) << 1) | (trp >> 1);
    const int ktr_ch = 2 * trb + (trp2 >> 1);
    const int ktr_lane = ktr_ch * 1024 + (trp2 & 1) * 8;
    const int ktr_r0 = ((4 * hi + trq) ^ (4 * ktr_ch)) * 16, ktr_r1 = ((4 * hi + 8 + trq) ^ (4 * ktr_ch)) * 16;
    const int krA = hi * 1024 + (r32 ^ (4 * hi)) * 16, krB = hi * 1024 + (r32 ^ (8 + 4 * hi)) * 16;
    const int qro = hi * 512 + r32 * 16;
    LAS float* gnl = (LAS float*)(lds + L_ST5 + 4096);
    if (threadIdx.x < 256) gnl[threadIdx.x] = gn[h * 256 + threadIdx.x];
    const bf16_t* kpt[2]; const bf16_t* qpt; const bf16_t* vpt[4];
#pragma unroll
    for (int u = 0; u < 2; ++u) { const int pc = wid * 2 + u; kpt[u] = K + (size_t)(b * SEQ + (lane ^ (4 * (pc & 3)))) * D + h * 128 + pc * 8; }
    qpt = Q + (size_t)(b * SEQ + 32 * rh + (lane & 31)) * D + h * 128 + (2 * wid + (lane >> 5)) * 8;
#pragma unroll
    for (int u = 0; u < 4; ++u) vpt[u] = V + (size_t)(b * SEQ + 16 * u + (lane >> 2)) * 2048 + h * 256 + 32 * wid + 8 * (lane & 3);
#define R5_DMA_FAST(stg) do { const unsigned _base = lds0 + (stg) * STAGE5; \
        _Pragma("unroll") for (int u = 0; u < 2; ++u) { glds16(kpt[u], (unsigned)__builtin_amdgcn_readfirstlane(_base + S5_K + (wid * 2 + u) * 1024)); kpt[u] += (size_t)64 * D; } \
        glds16(qpt, (unsigned)__builtin_amdgcn_readfirstlane(_base + S5_Q + wid * 1024)); qpt += (size_t)64 * D; \
        _Pragma("unroll") for (int u = 0; u < 4; ++u) { glds16(vpt[u], (unsigned)__builtin_amdgcn_readfirstlane(_base + S5_V + (wid * 4 + u) * 1024)); vpt[u] += (size_t)64 * 2048; } } while (0)
#define R5_DMA_META(stg) do { const unsigned _base = lds0 + (stg) * STAGE5; \
        _Pragma("unroll") for (int u = 0; u < 2; ++u) { const int pc = wid * 2 + u; const int rowk = grow(b, 0, 64 + (lane ^ (4 * (pc & 3)))); \
            glds16(K + (size_t)rowk * D + h * 128 + pc * 8, (unsigned)__builtin_amdgcn_readfirstlane(_base + S5_K + pc * 1024)); } \
        { const int rowq = grow(b, 0, 64 + 32 * rh + (lane & 31)); glds16(Q + (size_t)rowq * D + h * 128 + (2 * wid + (lane >> 5)) * 8, (unsigned)__builtin_amdgcn_readfirstlane(_base + S5_Q + wid * 1024)); } \
        _Pragma("unroll") for (int u = 0; u < 4; ++u) { const int rowv = grow(b, 0, 64 + 16 * u + (lane >> 2)); \
            glds16(V + (size_t)rowv * 2048 + h * 256 + 32 * wid + 8 * (lane & 3), (unsigned)__builtin_amdgcn_readfirstlane(_base + S5_V + (wid * 4 + u) * 1024)); } } while (0)
#define R5_FINALIZE(jp) do { const int _ip = (jp) >> 1, _jr = 64 * ((jp) & 1) + 32 * rh + r32; const bool _ok = (_ip > 0) || (_jr >= 112 && b == 0); const int _row = grow(b, _ip, _jr); \
        asm volatile("" : "+v"(gq[0]), "+v"(gq[1]), "+v"(gq[2]), "+v"(gq[3]), "+v"(yp) :: "memory");     \
        const LAS f32x4* sp = (const LAS f32x4*)(st + (((jp) & 1) * 32 + r32) * 16); const f32x4 q0 = sp[0], q1 = sp[1], q2 = sp[2], q3 = sp[3]; \
        const float s1 = ((q0[0] + q0[2]) + (q1[0] + q1[2])) + ((q2[0] + q2[2]) + (q3[0] + q3[2])), s2 = ((q0[1] + q0[3]) + (q1[1] + q1[3])) + ((q2[1] + q2[3]) + (q3[1] + q3[3])); \
        const float mu = s1 * (1.0f / 256.0f); const float rsd = __builtin_amdgcn_rsqf(fmaxf(s2 * (1.0f / 256.0f) - mu * mu, 0.f) + EPS); \
        _Pragma("unroll") for (int g = 0; g < 4; ++g) { const f32x4 gv = *(const LAS f32x4*)(gnl + 32 * et + 8 * g + 4 * hi) * rsd; \
            const float o0 = bflo(gq[g].x) * (yp[4 * g] - mu) * gv[0], o1 = bfhi(gq[g].x) * (yp[4 * g + 1] - mu) * gv[1]; \
            const float o2 = bflo(gq[g].y) * (yp[4 * g + 2] - mu) * gv[2], o3 = bfhi(gq[g].y) * (yp[4 * g + 3] - mu) * gv[3]; \
            if (_ok) { if (F8OUT) { int pk = __builtin_amdgcn_cvt_pk_fp8_f32(pg8::clamp8(F8_A2 * o0), pg8::clamp8(F8_A2 * o1), 0, false); pk = __builtin_amdgcn_cvt_pk_fp8_f32(pg8::clamp8(F8_A2 * o2), pg8::clamp8(F8_A2 * o3), pk, true); \
                                   gstore4_asm(A8 + (size_t)_row * 2048 + h * 256 + 32 * et + 8 * g + 4 * hi, (unsigned)pk); } \
                       else { u32x2 w; w.x = pk2(o0, o1); w.y = pk2(o2, o3); gstore8_asm(Gt + (size_t)_row * 2048 + h * 256 + 32 * et + 8 * g + 4 * hi, w); } } } } while (0)
#define R5_GLOAD(jp) do { const int _ip = (jp) >> 1, _jr = 64 * ((jp) & 1) + 32 * rh + r32; const int _row = grow(b, _ip, _jr); const bf16_t* gp = Gt + (size_t)_row * 2048 + h * 256 + 32 * et + 4 * hi; \
        _Pragma("unroll") for (int g = 0; g < 4; ++g) gq[g] = *(const u32x2*)(gp + 8 * g); } while (0)
    __builtin_amdgcn_s_waitcnt(0);
    R5_DMA_META(1);
    f32x16 yp = {}; u32x2 gq[4] = {};
    for (int j = 1; j < 34; ++j) {
        asm volatile("s_waitcnt vmcnt(0) lgkmcnt(0)" ::: "memory"); __builtin_amdgcn_s_barrier(); asm volatile("" ::: "memory");
        if (j > 1) R5_FINALIZE(j - 1);
        if (j + 1 < 34) R5_DMA_FAST((j + 1) & 1);
        const LAS unsigned char* sb_ = lds + (j & 1) * STAGE5;
        const int hh = j & 1;
        if (hh == 0) {
#pragma unroll
            for (int d = 0; d < 4; ++d) T[d] *= g128;
        }
        bf16x8 qf[8];
#pragma unroll
        for (int ks = 0; ks < 8; ++ks) qf[ks] = *(const LAS bf16x8*)(sb_ + S5_Q + (2 * ks) * 512 + qro);
        __builtin_amdgcn_sched_barrier(0);
        f32x16 yT = {};
#pragma unroll
        for (int db = 0; db < 4; ++db) {
            yT = __builtin_amdgcn_mfma_f32_32x32x16_bf16(pack8(T[db], 0), qf[2 * db], yT, 0, 0, 0);
            yT = __builtin_amdgcn_mfma_f32_32x32x16_bf16(pack8(T[db], 8), qf[2 * db + 1], yT, 0, 0, 0);
        }
        for (int sb = 0; sb <= rh; ++sb) {
            f32x16 sc = {};
            bf16x8 kfr[8];
#pragma unroll
            for (int ks = 0; ks < 8; ++ks) kfr[ks] = *(const LAS bf16x8*)(sb_ + S5_K + sb * 512 + (2 * ks) * 1024 + ((ks & 1) ? krB : krA));
            const LAS unsigned char* vb = sb_ + S5_V + et * 4096 + (32 * sb) * 64 + troff;
            const bf16x8 vf0 = trfrag(vb), vf1 = trfrag(vb + 1024);
            __builtin_amdgcn_sched_barrier(0);
#pragma unroll
            for (int ks = 0; ks < 8; ++ks) sc = __builtin_amdgcn_mfma_f32_32x32x16_bf16(kfr[ks], qf[ks], sc, 0, 0, 0);
            if (sb == rh) {
#pragma unroll
                for (int r = 0; r < 16; ++r) if (crow(r, hi) > r32) sc[r] = 0.f;
            }
            yT = __builtin_amdgcn_mfma_f32_32x32x16_bf16(vf0, pack8(sc, 0), yT, 0, 0, 0);
            yT = __builtin_amdgcn_mfma_f32_32x32x16_bf16(vf1, pack8(sc, 8), yT, 0, 0, 0);
        }
        {
            float s1 = 0.f, s2 = 0.f;
#pragma unroll
            for (int r = 0; r < 16; ++r) { s1 += yT[r]; s2 += yT[r] * yT[r]; }
            s1 += partner32(s1, hi); s2 += partner32(s2, hi);
            if (hi == 0) *(LAS f32x2*)(st + ((hh * 32 + r32) * 8 + et) * 2) = (f32x2){s1, s2};
        }
        yp = yT;
#pragma unroll
        for (int ks = 0; ks < 4; ++ks) {
            const bf16x8 vf = trfrag(sb_ + S5_V + et * 4096 + (16 * ks) * 64 + troff);
            bf16x8 kf[4];
#pragma unroll
            for (int db = 0; db < 4; ++db) {
                const LAS unsigned char* kb = sb_ + S5_K + db * 4096 + ks * 256 + ktr_lane;
                const s16x4 a = vtr(kb + ktr_r0), c = vtr(kb + ktr_r1);
                kf[db] = (bf16x8){a[0], a[1], a[2], a[3], c[0], c[1], c[2], c[3]};
            }
            __builtin_amdgcn_sched_barrier(0);
#pragma unroll
            for (int db = 0; db < 4; ++db) T[db] = __builtin_amdgcn_mfma_f32_32x32x16_bf16(kf[db], vf, T[db], 0, 0, 0);
        }
        R5_GLOAD(j);
    }
    asm volatile("s_waitcnt vmcnt(0) lgkmcnt(0)" ::: "memory"); __builtin_amdgcn_s_barrier(); asm volatile("" ::: "memory");
    R5_FINALIZE(33);
#undef R5_DMA_FAST
#undef R5_DMA_META
#undef R5_FINALIZE
#undef R5_GLOAD
}
}
__device__ __forceinline__ void ret_mfma(const Ctx& C, const bf16_t* Q, const bf16_t* Kk, bf16_t* V, bf16_t* YM, float* gst) {
    const int bx = (int)blockIdx.x, vcu = (C.G % 8 == 0) ? (bx % 8) * (C.G / 8) + bx / 8 : bx;
    for (int item = vcu; item < NBATCH * 8 * 2; item += C.G) {
        const int half = item & 1, h = (item >> 1) & 7, b = item >> 4;
        retm::ret_item(C.lds, b, h, half, Q, Kk, V, YM, gst, C.wave, C.lane, C.tid);
    }
    asm volatile("s_waitcnt vmcnt(0)" ::: "memory");
    __syncthreads();
}


template <bool F8OUT> __device__ __forceinline__ void ret_mfma5(const Ctx& C, const bf16_t* Q, const bf16_t* Kk, const bf16_t* V, bf16_t* Gt, unsigned char* A8, const float* gn) {
    const int bx = (int)blockIdx.x, vcu = (C.G % 8 == 0) ? (bx % 8) * (C.G / 8) + bx / 8 : bx;
    for (int item = vcu; item < NBATCH * 8 * 2; item += C.G) {
        const int rh = item & 1, h = (item >> 1) & 7, b = item >> 4;
        retm::ret_item5<F8OUT>(C.lds, b, h, rh, Q, Kk, V, Gt, A8, gn, C.wave, C.lane);
    }
    asm volatile("s_waitcnt vmcnt(0)" ::: "memory");
    __syncthreads();
}
__device__ __forceinline__ void sb_naive(const Ctx& C, bf16_t* Q, const bf16_t* Kk, const bf16_t* V) {
    const int NIT = NBATCH * 16 * 32 + 16;
    for (int it = (NAIVE_SB ? C.gw : NBATCH * 16 * 32 + C.gw); it < NIT; it += C.NGW) {
        int b, h, p0, nq;
        if (it < NBATCH * 16 * 32) { const int bh = it & 255, qb = it >> 8; b = bh >> 4; h = bh & 15; p0 = NMETA + qb * 64; nq = 64; }
        else { b = 0; h = it - NBATCH * 16 * 32; p0 = 0; nq = 16; }
        const int p = p0 + C.lane; const bool valid = C.lane < nq;
        const int row = pos_row(b, valid ? p : p0);
        float q[64], o[64];
        { const u32x4* qp = (const u32x4*)(Q + (size_t)row * D + h * 64);
#pragma unroll
          for (int jj = 0; jj < 8; ++jj) { const u32x4 t = qp[jj]; q[8 * jj] = bflo(t.x); q[8 * jj + 1] = bfhi(t.x); q[8 * jj + 2] = bflo(t.y); q[8 * jj + 3] = bfhi(t.y); q[8 * jj + 4] = bflo(t.z); q[8 * jj + 5] = bfhi(t.z); q[8 * jj + 6] = bflo(t.w); q[8 * jj + 7] = bfhi(t.w); } }
#pragma unroll
        for (int d = 0; d < 64; ++d) o[d] = 0.f;
        float P = 1.0f;
        for (int s = p0 + nq - 2; s >= 0; --s) {
            const int krow = pos_row(b, s);
            const u32x4* kp = (const u32x4*)(Kk + (size_t)krow * D + h * 64);
            const u32x4* vp = (const u32x4*)(V + (size_t)krow * D + h * 64);
            float z = 0.f;
#pragma unroll
            for (int jj = 0; jj < 8; ++jj) { const u32x4 t = kp[jj];
                z += q[8 * jj] * bflo(t.x) + q[8 * jj + 1] * bfhi(t.x) + q[8 * jj + 2] * bflo(t.y) + q[8 * jj + 3] * bfhi(t.y) + q[8 * jj + 4] * bflo(t.z) + q[8 * jj + 5] * bfhi(t.z) + q[8 * jj + 6] * bflo(t.w) + q[8 * jj + 7] * bfhi(t.w); }
            z = fminf(z, 100.f);
            const float E = fast_exp2(z), r = fast_rcp(1.0f + E);
            const bool act = valid && (s < p);
            const float w = act ? E * r * P : 0.f;
            P = act ? P * r : P;
#pragma unroll
            for (int jj = 0; jj < 8; ++jj) { const u32x4 t = vp[jj];
                o[8 * jj] += w * bflo(t.x); o[8 * jj + 1] += w * bfhi(t.x); o[8 * jj + 2] += w * bflo(t.y); o[8 * jj + 3] += w * bfhi(t.y); o[8 * jj + 4] += w * bflo(t.z); o[8 * jj + 5] += w * bfhi(t.z); o[8 * jj + 6] += w * bflo(t.w); o[8 * jj + 7] += w * bfhi(t.w); }
        }
        if (valid) { u32x4* op = (u32x4*)(Q + (size_t)row * D + h * 64);
#pragma unroll
            for (int jj = 0; jj < 8; ++jj) { u32x4 t; t.x = pk2(o[8 * jj], o[8 * jj + 1]); t.y = pk2(o[8 * jj + 2], o[8 * jj + 3]); t.z = pk2(o[8 * jj + 4], o[8 * jj + 5]); t.w = pk2(o[8 * jj + 6], o[8 * jj + 7]); op[jj] = t; } }
    }
}


namespace sbm {
typedef float f32x16 __attribute__((ext_vector_type(16)));
typedef short s16x4 __attribute__((ext_vector_type(4)));
typedef short v4i16_t __attribute__((ext_vector_type(4)));
constexpr int SLOTB = 8192, LDS_K = 0, LDS_V = 3 * SLOTB;
__device__ __forceinline__ int crow(int r, int hi) { return (r & 3) + 8 * (r >> 2) + 4 * hi; }
__device__ __forceinline__ s16x4 vtr(const LAS unsigned char* p) { return __builtin_bit_cast(s16x4, __builtin_amdgcn_ds_read_tr16_b64_v4i16((LAS v4i16_t*)p)); }
__device__ __forceinline__ float partner32(float x, int hi) { auto rr = __builtin_amdgcn_permlane32_swap(__float_as_uint(x), __float_as_uint(x), false, false); return __uint_as_float(hi ? rr[0] : rr[1]); }

__device__ __forceinline__ void sb_block(const f32x16& p, float& Pin, int hi, bf16x8& f0, bf16x8& f1) {
    float rr[16];
#pragma unroll
    for (int r = 0; r < 16; ++r) { const float E = fast_exp2(p[r]); rr[r] = fast_rcp(1.0f + E); }
    float G[4], PG[4];
#pragma unroll
    for (int g = 0; g < 4; ++g) { G[g] = (rr[4 * g] * rr[4 * g + 1]) * (rr[4 * g + 2] * rr[4 * g + 3]); PG[g] = partner32(G[g], hi); }
    float R[4]; R[3] = 1.0f; R[2] = G[3] * PG[3]; R[1] = R[2] * (G[2] * PG[2]); R[0] = R[1] * (G[1] * PG[1]);
    const float tot = R[0] * (G[0] * PG[0]);
    float w[16];
#pragma unroll
    for (int g = 0; g < 4; ++g) {
        float sfx = Pin * R[g] * (hi ? 1.0f : PG[g]), nx;
        nx = sfx * rr[4 * g + 3]; w[4 * g + 3] = sfx - nx; sfx = nx;
        nx = sfx * rr[4 * g + 2]; w[4 * g + 2] = sfx - nx; sfx = nx;
        nx = sfx * rr[4 * g + 1]; w[4 * g + 1] = sfx - nx; sfx = nx;
        nx = sfx * rr[4 * g];     w[4 * g] = sfx - nx;
    }
    Pin *= tot;
    u32x4 a, b;
    a.x = pk2(w[0], w[1]); a.y = pk2(w[2], w[3]); a.z = pk2(w[4], w[5]); a.w = pk2(w[6], w[7]);
    b.x = pk2(w[8], w[9]); b.y = pk2(w[10], w[11]); b.z = pk2(w[12], w[13]); b.w = pk2(w[14], w[15]);
    f0 = __builtin_bit_cast(bf16x8, a); f1 = __builtin_bit_cast(bf16x8, b);
}

__device__ __forceinline__ void sb_tile(const LAS unsigned char* kbase, const LAS unsigned char* vbase, const bf16x8 q0f, const bf16x8 q1f, const bf16x8 q2f, const bf16x8 q3f, f32x16& o0, f32x16& o1, float& Pin, int mode, int jb, int qrel, int r32, int hi, int lane) {
    const LAS unsigned char* kb = kbase + hi * 1024 + r32 * 16;
    const LAS unsigned char* vb = vbase + ((lane >> 4) & 1) * 32 + (lane & 3) * 8 + (4 * hi + ((lane & 15) >> 2)) * 64;
    f32x16 p0 = {}, p1 = {};
#pragma unroll
    for (int d0 = 0; d0 < 4; ++d0) {
        const bf16x8 k0 = *(const LAS bf16x8*)(kb + d0 * 2048), k1 = *(const LAS bf16x8*)(kb + d0 * 2048 + 512);
        const bf16x8 qd = d0 == 0 ? q0f : d0 == 1 ? q1f : d0 == 2 ? q2f : q3f;
        p0 = __builtin_amdgcn_mfma_f32_32x32x16_bf16(k0, qd, p0, 0, 0, 0);
        p1 = __builtin_amdgcn_mfma_f32_32x32x16_bf16(k1, qd, p1, 0, 0, 0);
    }
    if (mode != 0) {
        asm volatile("" : "+v"(p0), "+v"(p1));
        const int kofs = (mode == 1) ? 64 * jb : 0, qlim = (mode == 1) ? qrel : NMETA, lim1 = (mode == 1) ? qrel : -1000000;
#pragma unroll
        for (int r = 0; r < 16; ++r) { const int kv = kofs + crow(r, hi); if (kv >= qlim) p0[r] = -1.0e30f; if (kv + 32 >= lim1) p1[r] = -1.0e30f; }
    }
    bf16x8 pf[4];
    sb_block(p1, Pin, hi, pf[2], pf[3]);
    sb_block(p0, Pin, hi, pf[0], pf[1]);
#pragma unroll
    for (int ks = 0; ks < 4; ++ks) {
        const s16x4 a0 = vtr(vb + ks * 1024), a1 = vtr(vb + ks * 1024 + 512), c0 = vtr(vb + 4096 + ks * 1024), c1 = vtr(vb + 4096 + ks * 1024 + 512);
        const bf16x8 va = {a0[0], a0[1], a0[2], a0[3], a1[0], a1[1], a1[2], a1[3]}, vc = {c0[0], c0[1], c0[2], c0[3], c1[0], c1[1], c1[2], c1[3]};
        o0 = __builtin_amdgcn_mfma_f32_32x32x16_bf16(va, pf[ks], o0, 0, 0, 0);
        o1 = __builtin_amdgcn_mfma_f32_32x32x16_bf16(vc, pf[ks], o1, 0, 0, 0);
    }
}
constexpr int SLOT2 = 32768;
__device__ __forceinline__ void sb_unit(LAS unsigned char* lds, int b, int h, int qi, bf16_t* Q, const bf16_t* K, const bf16_t* V, int wid, int lane) {
    const int r32 = lane & 31, hi = lane >> 5;
    const size_t rowbase = (size_t)b * SEQ;
    const unsigned lds0 = (unsigned)(size_t)lds;
    const int q0 = qi * 256, NS = 2 * (qi + 1);
    bf16_t* qrow = Q + (rowbase + q0 + wid * 32 + r32) * D + h * 64;
    bf16x8 qf[4];
#pragma unroll
    for (int d0 = 0; d0 < 4; ++d0) qf[d0] = *(const bf16x8*)(qrow + d0 * 16 + hi * 8);
    const int vkey = 16 * (wid & 3) + (lane >> 2);
    const bf16_t* ksrc = K + (rowbase + lane) * D + h * 64 + wid * 8;
    const bf16_t* vsrc = V + (rowbase + vkey) * D + h * 64 + (wid >> 2) * 32 + (lane & 3) * 8;
    const bf16_t* ksrc_m = K + (size_t)(MREAL + (lane < 16 ? lane : 15)) * D + h * 64 + wid * 8;
    const bf16_t* vsrc_m = V + (size_t)(MREAL + (vkey < 16 ? vkey : 15)) * D + h * 64 + (wid >> 2) * 32 + (lane & 3) * 8;
#define SB_ISSUE(step) do { const int _st = (step); const unsigned _sl = lds0 + (_st % 3) * SLOT2 + wid * 1024; \
        if (_st < NS) { const int _t1 = 2 * (NS - 1 - _st) + 1; \
            glds16(ksrc + (size_t)_t1 * 64 * D, (unsigned)__builtin_amdgcn_readfirstlane(_sl)); glds16(ksrc + (size_t)(_t1 - 1) * 64 * D, (unsigned)__builtin_amdgcn_readfirstlane(_sl + 8192)); \
            glds16(vsrc + (size_t)_t1 * 64 * D, (unsigned)__builtin_amdgcn_readfirstlane(_sl + 16384)); glds16(vsrc + (size_t)(_t1 - 1) * 64 * D, (unsigned)__builtin_amdgcn_readfirstlane(_sl + 24576)); } \
        else { glds16(ksrc_m, (unsigned)__builtin_amdgcn_readfirstlane(_sl)); glds16(vsrc_m, (unsigned)__builtin_amdgcn_readfirstlane(_sl + 16384)); } } while (0)
    SB_ISSUE(0); SB_ISSUE(1);
    f32x16 o0 = {}, o1 = {};
    float Pin = 1.0f;
    const int qrel = wid * 32 + r32;
    LAS int* dflag = (LAS int*)(lds + LDSCTL_OFF + 12288);
    bool wdone = false;
    for (int st = 0; st <= NS; ++st) {
        if (st + 1 < NS) asm volatile("s_waitcnt vmcnt(4) lgkmcnt(0)" ::: "memory"); else if (st + 1 == NS) asm volatile("s_waitcnt vmcnt(2) lgkmcnt(0)" ::: "memory"); else asm volatile("s_waitcnt vmcnt(0) lgkmcnt(0)" ::: "memory");
        __builtin_amdgcn_s_barrier(); asm volatile("" ::: "memory");
        if (st > 0) {
            const LAS int* df = dflag + ((st - 1) & 1) * 8;
            if ((df[0] & df[1] & df[2] & df[3] & df[4] & df[5] & df[6] & df[7]) != 0) break;
        }
        if (st + 2 <= NS) SB_ISSUE(st + 2);
        const LAS unsigned char* sl = lds + (st % 3) * SLOT2;
        const int nsub = (st == NS) ? 1 : 2;
#pragma unroll 1
        for (int sub = 0; sub < nsub; ++sub) {
            const int mode = (st == NS) ? 2 : (st < 2 ? 1 : 0);
            const int jb = 3 - 2 * st - sub;
            if (mode == 1 && 64 * jb > wid * 32 + 31) continue;
            if (wdone) continue;
            sb_tile(sl + sub * 8192, sl + 16384 + sub * 8192, qf[0], qf[1], qf[2], qf[3], o0, o1, Pin, mode, jb, qrel, r32, hi, lane);
        }
        { const int dn = __all(Pin < 9.0e-13f) ? 1 : 0; wdone = dn != 0; if (lane == 0) dflag[(st & 1) * 8 + wid] = dn; }
    }
    asm volatile("s_waitcnt vmcnt(0)" ::: "memory");
#undef SB_ISSUE
#pragma unroll
    for (int g = 0; g < 4; ++g) {
        u32x2 w0, w1; w0.x = pk2(o0[4 * g], o0[4 * g + 1]); w0.y = pk2(o0[4 * g + 2], o0[4 * g + 3]); w1.x = pk2(o1[4 * g], o1[4 * g + 1]); w1.y = pk2(o1[4 * g + 2], o1[4 * g + 3]);
        *(u32x2*)(qrow + 8 * g + 4 * hi) = w0; *(u32x2*)(qrow + 32 + 8 * g + 4 * hi) = w1;
    }
    asm volatile("s_waitcnt lgkmcnt(0)" ::: "memory");
    __builtin_amdgcn_s_barrier(); asm volatile("" ::: "memory");
}
}
__device__ __forceinline__ void sb_mfma(const Ctx& C, bf16_t* Q, const bf16_t* Kk, const bf16_t* V) {
    const int bx = (int)blockIdx.x, vcu = (C.G % 8 == 0) ? (bx % 8) * (C.G / 8) + bx / 8 : bx;
    for (int pi = vcu; pi < NBATCH * 16 * 4; pi += C.G) {
        const int bh = pi >> 2, s4 = pi & 3;
        sbm::sb_unit(C.lds, bh >> 4, bh & 15, 7 - s4, Q, Kk, V, C.wave, C.lane);
        sbm::sb_unit(C.lds, bh >> 4, bh & 15, s4, Q, Kk, V, C.wave, C.lane);
    }
    asm volatile("s_waitcnt vmcnt(0)" ::: "memory");
    __syncthreads();
}

constexpr int ROWS_PER_WG = 129;
__device__ __forceinline__ void router_a(const Ctx& C, int c, int layer, const float* ssq, int* cnt_wg) {
    LAS unsigned char* bimg = C.lds;
    LAS int* lcnt = (LAS int*)(C.lds + 32768);
    LAS float* tile = (LAS float*)(C.lds + 33792 + C.wave * 1024);
    const float* Wr = C.in[17] + (size_t)c * D * NE; const float* g = C.in[3] + (size_t)layer * D;
    int tid_ = C.tid; asm volatile("" : "+v"(tid_));
    const int lane_ = tid_ & 63;
    for (int k = tid_; k < D; k += 512) {
        const f32x4 w0 = *(const f32x4*)(Wr + (size_t)k * NE), w1 = *(const f32x4*)(Wr + (size_t)k * NE + 4); const float gk = g[k];
        const int s_ = k >> 5, fq_ = (k >> 3) & 3, j_ = k & 7;
#pragma unroll
        for (int e = 0; e < NE; ++e) {
            const float w = (e < 4 ? w0[e & 3] : w1[e & 3]) * gk;
            const unsigned hi = pk2(w, 0.f) & 0xffffu; const float lo = w - bflo(hi);
            *(LAS unsigned short*)(bimg + ((s_ * 64 + fq_ * 16 + e) * 16) + 2 * j_) = (unsigned short)hi;
            *(LAS unsigned short*)(bimg + ((s_ * 64 + fq_ * 16 + e + 8) * 16) + 2 * j_) = (unsigned short)(pk2(lo, 0.f) & 0xffffu);
        }
    }
    if (tid_ < NE) lcnt[tid_] = 0;
    __syncthreads();
    int2* toke = (int2*)(C.misc + MISC_TOKE); f32x2* tokg = (f32x2*)(C.misc + MISC_TOKG); int2* tokr = (int2*)(C.misc + MISC_TOKR);
    const int r0 = (int)blockIdx.x * ROWS_PER_WG, rend = (r0 + ROWS_PER_WG < MVALID) ? r0 + ROWS_PER_WG : MVALID;
    const int fr = lane_ & 15, fq = lane_ >> 4;
    for (int grp = C.wave; grp < 9; grp += 8) {
        const int rbase = r0 + grp * 16; if (rbase >= rend) break;
        const int row = rbase + fr; const bool valid = row < rend; const int lrow = valid ? row : rbase;
        const float rs = pg8::rstd_of(ssq, lrow);
        const bf16_t* ap = C.H + (size_t)lrow * D + 8 * fq;
        f32x4 acc = {0.f, 0.f, 0.f, 0.f};
#pragma unroll
        for (int s0 = 0; s0 < 32; s0 += 8) {
            bf16x8 af[8], bfr[8];
#pragma unroll
            for (int t = 0; t < 8; ++t) af[t] = *(const bf16x8*)(ap + 32 * (s0 + t));
#pragma unroll
            for (int t = 0; t < 8; ++t) bfr[t] = *(const LAS bf16x8*)(bimg + ((s0 + t) * 64 + lane_) * 16);
#pragma unroll
            for (int t = 0; t < 8; ++t) acc = __builtin_amdgcn_mfma_f32_16x16x32_bf16(af[t], bfr[t], acc, 0, 0, 0);
        }
#pragma unroll
        for (int i = 0; i < 4; ++i) tile[(4 * fq + i) * 16 + fr] = acc[i];
        LDS_WAIT();
        if (lane_ < 16 && valid) {
            const f32x4 t0 = *(const LAS f32x4*)(tile + lane_ * 16), t1 = *(const LAS f32x4*)(tile + lane_ * 16 + 4), t2 = *(const LAS f32x4*)(tile + lane_ * 16 + 8), t3 = *(const LAS f32x4*)(tile + lane_ * 16 + 12);
            const float lg[NE] = {t0[0] + t2[0], t0[1] + t2[1], t0[2] + t2[2], t0[3] + t2[3], t1[0] + t3[0], t1[1] + t3[1], t1[2] + t3[2], t1[3] + t3[3]};
            int e0 = 0; float v0 = lg[0];
#pragma unroll
            for (int e = 1; e < NE; ++e) if (lg[e] > v0) { v0 = lg[e]; e0 = e; }
            int e1 = -1; float v1 = -3.0e38f;
#pragma unroll
            for (int e = 0; e < NE; ++e) if (e != e0 && lg[e] > v1) { v1 = lg[e]; e1 = e; }
            const float g1 = fast_rcp(1.0f + __expf((v0 - v1) * rs)), g0 = 1.0f - g1;
            const int k0 = atomicAdd((int*)&lcnt[e0], 1), k1 = atomicAdd((int*)&lcnt[e1], 1);
            toke[row] = make_int2(e0, e1); tokg[row] = (f32x2){g0, g1}; tokr[row] = make_int2(k0, k1);
        }
        LDS_WAIT();
    }
    __syncthreads();
    if (tid_ < NE) cnt_wg[(int)blockIdx.x * NE + tid_] = lcnt[tid_];
    __syncthreads();
}
__device__ __forceinline__ void router_b(const Ctx& C, const float* ssq, const int* cnt_wg, int* seg_out, int* srow) {
    LAS int* tot = (LAS int*)C.lds;
    LAS int* part = (LAS int*)(C.lds + 1024);
    { const int e = C.tid & 7, sl = C.tid >> 3; int all = 0, before = 0;
#pragma unroll
      for (int j = 0; j < 4; ++j) { const int w = sl * 4 + j; const int v = cnt_wg[w * NE + e]; all += v; before += (w < (int)blockIdx.x) ? v : 0; }
      all += __shfl_xor(all, 8); all += __shfl_xor(all, 16); all += __shfl_xor(all, 32);
      before += __shfl_xor(before, 8); before += __shfl_xor(before, 16); before += __shfl_xor(before, 32);
      if (C.lane < 8) { part[C.wave * 16 + C.lane] = all; part[C.wave * 16 + 8 + C.lane] = before; } }
    __syncthreads();
    if (C.tid < NE) { int all = 0, before = 0;
#pragma unroll
        for (int w = 0; w < 8; ++w) { all += part[w * 16 + C.tid]; before += part[w * 16 + 8 + C.tid]; }
        tot[C.tid] = all; tot[8 + C.tid] = before; }
    __syncthreads();
    if (C.tid == 0) { int s = 0;
        for (int e = 0; e < NE; ++e) { tot[16 + e] = s; s += (tot[e] + 255) & ~255; }
        tot[24] = s;
        if (blockIdx.x == 0) for (int e = 0; e <= NE; ++e) seg_out[e] = tot[16 + e]; }
    __syncthreads();
    const int2* toke = (const int2*)(C.misc + MISC_TOKE); const f32x2* tokg = (const f32x2*)(C.misc + MISC_TOKG); const int2* tokr = (const int2*)(C.misc + MISC_TOKR);
    int2* tokp = (int2*)(C.misc + MISC_TOKP); float* rstds = (float*)(C.misc + MISC_RSTDS); float* gates = (float*)(C.misc + MISC_GATES);
    const int r0 = (int)blockIdx.x * ROWS_PER_WG;
    int tid_ = C.tid; asm volatile("" : "+v"(tid_));
    if (tid_ < ROWS_PER_WG) {
        const int row = r0 + tid_;
        if (row < MVALID) {
            const int2 e = toke[row], k = tokr[row]; const f32x2 g = tokg[row];
            const int p0 = tot[16 + e.x] + tot[8 + e.x] + k.x, p1 = tot[16 + e.y] + tot[8 + e.y] + k.y;
            const float rs = pg8::rstd_of(ssq, row);
            tokp[row] = make_int2(p0, p1); rstds[p0] = rs; rstds[p1] = rs; srow[p0] = row; srow[p1] = row;
            gates[p0] = g.x * (1.0f / (pg8::F8_W2 * pg8::F8_HID)); gates[p1] = g.y * (1.0f / (pg8::F8_W2 * pg8::F8_HID));
        }
    }
    __syncthreads();
}
__device__ __forceinline__ void moe_combine(const Ctx& C, const bf16_t* YS, float* ssq_out) {
    const int2* tokp = (const int2*)(C.misc + MISC_TOKP);
    for (int row = C.gw; row < MVALID; row += C.NGW) {
        const int2 p = tokp[row]; float ss = 0.f;
        u32x4 hvv[2], y0v[2], y1v[2];
#pragma unroll
        for (int q = 0; q < 2; ++q) { const int col = q * 512 + C.lane * 8; hvv[q] = *(const u32x4*)(C.H + (size_t)row * D + col); y0v[q] = *(const u32x4*)(YS + (size_t)p.x * D + col); y1v[q] = *(const u32x4*)(YS + (size_t)p.y * D + col); }
#pragma unroll
        for (int q = 0; q < 2; ++q) {
            const int col = q * 512 + C.lane * 8;
            const u32x4 hv = hvv[q], y0 = y0v[q], y1 = y1v[q];
            u32x4 w;
            w.x = pk2(bflo(hv.x) + bflo(y0.x) + bflo(y1.x), bfhi(hv.x) + bfhi(y0.x) + bfhi(y1.x));
            w.y = pk2(bflo(hv.y) + bflo(y0.y) + bflo(y1.y), bfhi(hv.y) + bfhi(y0.y) + bfhi(y1.y));
            w.z = pk2(bflo(hv.z) + bflo(y0.z) + bflo(y1.z), bfhi(hv.z) + bfhi(y0.z) + bfhi(y1.z));
            w.w = pk2(bflo(hv.w) + bflo(y0.w) + bflo(y1.w), bfhi(hv.w) + bfhi(y0.w) + bfhi(y1.w));
            *(u32x4*)(C.H + (size_t)row * D + col) = w;
            ss += bflo(w.x) * bflo(w.x) + bfhi(w.x) * bfhi(w.x) + bflo(w.y) * bflo(w.y) + bfhi(w.y) * bfhi(w.y) + bflo(w.z) * bflo(w.z) + bfhi(w.z) * bfhi(w.z) + bflo(w.w) * bflo(w.w) + bfhi(w.w) * bfhi(w.w);
        }
        ss = wave_sum(ss);
        pg8::ssq_store_single(ssq_out, row, ss, C.lane);
    }
}
__device__ __forceinline__ void moe_combine_final(const Ctx& C, const bf16_t* YS, const float* g, float* out) {
    const int2* tokp = (const int2*)(C.misc + MISC_TOKP);
    for (int row = C.gw; row < MREAL; row += C.NGW) {
        const int2 p = tokp[row]; float ss = 0.f; float v[16];
#pragma unroll
        for (int q = 0; q < 2; ++q) {
            const int col = q * 512 + C.lane * 8;
            const u32x4 hv = *(const u32x4*)(C.H + (size_t)row * D + col), y0 = *(const u32x4*)(YS + (size_t)p.x * D + col), y1 = *(const u32x4*)(YS + (size_t)p.y * D + col);
            v[8 * q + 0] = bflo(hv.x) + bflo(y0.x) + bflo(y1.x); v[8 * q + 1] = bfhi(hv.x) + bfhi(y0.x) + bfhi(y1.x);
            v[8 * q + 2] = bflo(hv.y) + bflo(y0.y) + bflo(y1.y); v[8 * q + 3] = bfhi(hv.y) + bfhi(y0.y) + bfhi(y1.y);
            v[8 * q + 4] = bflo(hv.z) + bflo(y0.z) + bflo(y1.z); v[8 * q + 5] = bfhi(hv.z) + bfhi(y0.z) + bfhi(y1.z);
            v[8 * q + 6] = bflo(hv.w) + bflo(y0.w) + bflo(y1.w); v[8 * q + 7] = bfhi(hv.w) + bfhi(y0.w) + bfhi(y1.w);
#pragma unroll
            for (int j = 0; j < 8; ++j) ss += v[8 * q + j] * v[8 * q + j];
        }
        ss = wave_sum(ss);
        const float rs = __builtin_amdgcn_rsqf(ss * (1.0f / D) + EPS);
#pragma unroll
        for (int q = 0; q < 2; ++q) {
            const int col = q * 512 + C.lane * 8;
            const f32x4 g0 = *(const f32x4*)(g + col), g1 = *(const f32x4*)(g + col + 4);
            const f32x4 o0 = {v[8 * q] * rs * g0[0], v[8 * q + 1] * rs * g0[1], v[8 * q + 2] * rs * g0[2], v[8 * q + 3] * rs * g0[3]};
            const f32x4 o1 = {v[8 * q + 4] * rs * g1[0], v[8 * q + 5] * rs * g1[1], v[8 * q + 6] * rs * g1[2], v[8 * q + 7] * rs * g1[3]};
            *(f32x4*)(out + (size_t)row * D + col) = o0; *(f32x4*)(out + (size_t)row * D + col + 4) = o1;
        }
    }
}
__device__ __forceinline__ void pool_prep(const Ctx& C, const float* ssq, const float* gain, bf16_t* Dm) {
    for (int row = C.gw; row < MROWS; row += C.NGW) {
        if (row >= MVALID) { const u32x4 z = {0u, 0u, 0u, 0u}; *(u32x4*)(Dm + (size_t)row * D + C.lane * 8) = z; *(u32x4*)(Dm + (size_t)row * D + 512 + C.lane * 8) = z; continue; }
        const int b = row < MREAL ? row >> 11 : 0, p = row_pos(row);
        float rs_l = 0.f;
        { const int pd = p - (C.lane & 15); const int r2 = pos_row(b, pd > 0 ? pd : 0); rs_l = pg8::rstd_of(ssq, r2); }
#pragma unroll
        for (int q = 0; q < 2; ++q) {
            const int col = q * 512 + C.lane * 8, grp = col >> 8, w = 2 << grp;
            const int cnt = (p + 1 < w) ? p + 1 : w;
            const int dmax = q == 0 ? 4 : 16;
            u32x4 t[16];
#pragma unroll
            for (int d = 0; d < 16; ++d) if (d < dmax) { const int pd = p - d; const int r2 = pos_row(b, pd > 0 ? pd : 0); t[d] = *(const u32x4*)(C.H + (size_t)r2 * D + col); }
            float acc[8], self[8];
#pragma unroll
            for (int j = 0; j < 8; ++j) { acc[j] = 0.f; self[j] = 0.f; }
#pragma unroll
            for (int d = 0; d < 16; ++d) if (d < dmax) {
                const float rsd = __shfl(rs_l, d); const float wgt = (d < cnt) ? rsd : 0.f;
                const float v[8] = {bflo(t[d].x) * wgt, bfhi(t[d].x) * wgt, bflo(t[d].y) * wgt, bfhi(t[d].y) * wgt, bflo(t[d].z) * wgt, bfhi(t[d].z) * wgt, bflo(t[d].w) * wgt, bfhi(t[d].w) * wgt};
#pragma unroll
                for (int j = 0; j < 8; ++j) { acc[j] += v[j]; if (d == 0) self[j] = v[j]; }
            }
            const float ic = 1.0f / (float)cnt;
            const f32x4 g0 = *(const f32x4*)(gain + col), g1 = *(const f32x4*)(gain + col + 4);
            u32x4 o;
            o.x = pk2((acc[0] * ic - self[0]) * g0[0], (acc[1] * ic - self[1]) * g0[1]); o.y = pk2((acc[2] * ic - self[2]) * g0[2], (acc[3] * ic - self[3]) * g0[3]);
            o.z = pk2((acc[4] * ic - self[4]) * g1[0], (acc[5] * ic - self[5]) * g1[1]); o.w = pk2((acc[6] * ic - self[6]) * g1[2], (acc[7] * ic - self[7]) * g1[3]);
            *(u32x4*)(Dm + (size_t)row * D + col) = o;
        }
    }
}

__global__ void __launch_bounds__(512, 2) fwd_kernel(Args args) {
    extern __shared__ __attribute__((aligned(16))) unsigned char lds_raw[];
    Ctx C;
    C.lds = (LAS unsigned char*)lds_raw;
    C.tid = threadIdx.x; C.lane = C.tid & 63; C.wave = __builtin_amdgcn_readfirstlane(C.tid >> 6);
    C.G = gridDim.x; C.gw = (int)blockIdx.x * 8 + C.wave; C.NGW = C.G * 8;
    C.in = args.in; C.out = args.out; C.ws = args.ws;
    C.H = (bf16_t*)(args.ws + WS_H); C.ssq = (float*)(args.ws + WS_SSQ); C.gst = (float*)(args.ws + WS_GST);
    C.WA = (bf16_t*)(args.ws + WS_WA); C.WB = (bf16_t*)(args.ws + WS_WB); C.pool = args.ws + WS_POOL; C.misc = args.ws + WS_MISC; C.tab = (f32x2*)(args.ws + WS_TAB);
    C.moe = (int*)(args.ws + WS_CTL + CTL_MOE);
    for (int u = C.tid; u < (LDS_BYTES - LDSCTL_OFF) / 4; u += 512) ((LAS unsigned*)(C.lds + LDSCTL_OFF))[u] = 0u;
    __syncthreads();
    unsigned* barw = (unsigned*)(args.ws + WS_CTL) + CW_BAR;
    XcdBarrier bar; bar.bar = barw; bar.x = 0; bar.st = nullptr;
    if (!MK_PER_PHASE) bar = xcd_barrier_post(barw, (volatile LAS unsigned*)(C.lds + LDSCTL_OFF + 32));
    const int lo = args.ph_lo, hi = args.ph_hi;
#define IN(k) (lo <= (k) && (k) < hi)
#if PROBE_GROUP
    unsigned long long pr_last = __builtin_amdgcn_s_memrealtime(); const unsigned long long pr_t0 = pr_last; unsigned long long pr_acc = 0ull;
    constexpr unsigned long long PR_MASK =
        PROBE_GROUP == 1 ? (1ull << P_PRO) :
        PROBE_GROUP == 2 ? ((1ull << P0_QKVG) | (1ull << P0_WO) | (1ull << P0_W13) | (1ull << P0_W2) | (1ull << P1_QKV) | (1ull << P1_WO) | (1ull << P1_M13) | (1ull << P1_M2) | (1ull << P2_POOL) | (1ull << P2_W13) | (1ull << P2_W2) | (1ull << P3_QKVG) | (1ull << P3_WO) | (1ull << P3_M13) | (1ull << P3_M2)) :
        PROBE_GROUP == 3 ? (1ull << P1_SB) :
        PROBE_GROUP == 4 ? ((1ull << P0_RET) | (1ull << P3_RET)) :
        PROBE_GROUP == 5 ? ((1ull << P0_FIN) | (1ull << P3_FIN) | (1ull << P1_RA) | (1ull << P1_RB) | (1ull << P1_CMB) | (1ull << P3_RA) | (1ull << P3_RB) | (1ull << P3_CMB) | (1ull << P2_PREP)) :
        PROBE_GROUP == 6 ? ((1ull << P1_M13) | (1ull << P3_M13)) :
        PROBE_GROUP == 7 ? ((1ull << P1_M2) | (1ull << P3_M2)) :
        PROBE_GROUP == 8 ? ((1ull << P0_QKVG) | (1ull << P3_QKVG)) :
        PROBE_GROUP == 12 ? ((1ull << P0_FIN) | (1ull << P3_FIN)) :
        PROBE_GROUP == 13 ? ((1ull << P1_RA) | (1ull << P3_RA)) :
        PROBE_GROUP == 14 ? ((1ull << P1_RB) | (1ull << P3_RB)) :
        PROBE_GROUP == 15 ? ((1ull << P1_CMB) | (1ull << P3_CMB)) :
        PROBE_GROUP == 16 ? ((1ull << P2_PREP) | (1ull << P2_POOL)) :
        PROBE_GROUP == 30 ? (1ull << P1_RA) : PROBE_GROUP == 31 ? (1ull << P1_RB) : PROBE_GROUP == 32 ? (1ull << P1_CMB) : PROBE_GROUP == 33 ? (1ull << P3_RA) : PROBE_GROUP == 34 ? (1ull << P3_RB) : PROBE_GROUP == 35 ? (1ull << P3_CMB) :
        PROBE_GROUP == 36 ? (1ull << P2_PREP) : PROBE_GROUP == 37 ? (1ull << P2_POOL) : PROBE_GROUP == 38 ? (1ull << P1_M13) : PROBE_GROUP == 39 ? (1ull << P1_M2) : PROBE_GROUP == 40 ? (1ull << P0_QKVG) : PROBE_GROUP == 41 ? (1ull << P0_W13) :
        PROBE_GROUP == 42 ? (1ull << P0_WO) : PROBE_GROUP == 43 ? (1ull << P0_W2) : PROBE_GROUP == 44 ? (1ull << P3_QKVG) : PROBE_GROUP == 45 ? (1ull << P2_W13) : PROBE_GROUP == 46 ? (1ull << P0_RET) : PROBE_GROUP == 47 ? (1ull << P3_RET) :
        PROBE_GROUP == 48 ? (1ull << P1_QKV) : PROBE_GROUP == 49 ? (1ull << P1_WO) : PROBE_GROUP == 50 ? (1ull << P2_W2) : PROBE_GROUP == 51 ? (1ull << P3_WO) : PROBE_GROUP == 52 ? (1ull << P3_M13) : PROBE_GROUP == 53 ? (1ull << P3_M2) : 0ull;
#define PR_STAMP(k) do { const unsigned long long _t = __builtin_amdgcn_s_memrealtime(); if ((PR_MASK >> (k)) & 1ull) pr_acc += _t - pr_last; pr_last = _t; } while (0)
#else
#define PR_STAMP(k) do { } while (0)
#endif
#define SEAM(k) do { if (!MK_PER_PHASE && (k) + 1 < hi) xcd_barrier(bar); PR_STAMP(k); } while (0)

    bf16_t* const PQ = (bf16_t*)(C.pool + PO_Q); bf16_t* const PK = (bf16_t*)(C.pool + PO_K); bf16_t* const PV = (bf16_t*)(C.pool + PO_V); bf16_t* const PG = (bf16_t*)(C.pool + PO_G);
    bf16_t* const HID = (bf16_t*)(C.pool + PO_HID); bf16_t* const XS = (bf16_t*)(C.pool + PO_XS); bf16_t* const MHID = (bf16_t*)(C.pool + PO_MHID);
    bf16_t* const YM = (bf16_t*)(C.misc + MISC_YM);
    float* const rstds = (float*)(C.misc + MISC_RSTDS); float* const gates = (float*)(C.misc + MISC_GATES);
#define SSQ(i) (C.ssq + (size_t)(i) * MROWS * 16)
    unsigned char* const H8P = (unsigned char*)(C.pool + 100 * MiB);
    unsigned char* const H8L3 = (unsigned char*)(C.pool + 387 * MiB);
    unsigned char* const H8M = (unsigned char*)(C.pool + 320 * MiB);
    int* const srow = (int*)(args.ws + WS_CTL + CTL_SROW);
    unsigned char* const A28 = (unsigned char*)(C.pool + 420 * MiB);

    if (IN(P_PRO)) {
        conv_ret(C, 0, 0, C.WB + WB_MIX, C.WB + WB_WO);
        conv_dense_bf16(C, 0, 0, C.WB + WB_W13, C.WB + WB_W2);
        { LAS float* scr = (LAS float*)(C.lds + C.wave * 16384);
          wt_matrix<0>(C.in[10], D, 3 * D, 3 * D, C.WA + WA_MIX, C.in[2] + 1 * D, scr, C.gw, C.NGW, C.lane);
          wt_matrix<0>(C.in[11], D, D, D, C.WA + WA_MIX_WO_SB, nullptr, scr, C.gw, C.NGW, C.lane); }
        conv_moe(C, 0, 1, C.WA + WA_MOE13, C.WA + WA_MOE2);
        for (int row = C.gw; row < MROWS; row += C.NGW) {
            float ss = 0.f;
            if (row < MVALID) {
                const float* src = row < MREAL ? C.in[0] + (size_t)row * D : C.in[1] + (size_t)(row - MREAL) * D;
#pragma unroll
                for (int q = 0; q < 2; ++q) { const int col = q * 512 + C.lane * 8; const f32x4 a = *(const f32x4*)(src + col), b2 = *(const f32x4*)(src + col + 4);
                    u32x4 w; w.x = pk2(a[0], a[1]); w.y = pk2(a[2], a[3]); w.z = pk2(b2[0], b2[1]); w.w = pk2(b2[2], b2[3]);
                    *(u32x4*)(C.H + (size_t)row * D + col) = w;
                    ss += bflo(w.x) * bflo(w.x) + bfhi(w.x) * bfhi(w.x) + bflo(w.y) * bflo(w.y) + bfhi(w.y) * bfhi(w.y) + bflo(w.z) * bflo(w.z) + bfhi(w.z) * bfhi(w.z) + bflo(w.w) * bflo(w.w) + bfhi(w.w) * bfhi(w.w); }
                ss = wave_sum(ss);
            } else { const u32x4 z = {0u, 0u, 0u, 0u}; *(u32x4*)(C.H + (size_t)row * D + C.lane * 8) = z; *(u32x4*)(C.H + (size_t)row * D + 512 + C.lane * 8) = z; }
            pg8::ssq_store_single(SSQ(0), row, ss, C.lane);
        }
        SEAM(P_PRO);
    }
#define ZERO_ROWS() do { if (blockIdx.x == 0) { const u32x4 z = {0u, 0u, 0u, 0u}; if (C.tid < 128) { *(u32x4*)(PQ + (size_t)MVALID * D + C.tid * 8) = z; *(u32x4*)(PK + (size_t)MVALID * D + C.tid * 8) = z; } \
        if (C.tid < 256) *(u32x4*)(PV + (size_t)MVALID * 2048 + C.tid * 8) = z; } } while (0)
    if (IN(P0_QKVG)) { ZERO_ROWS(); pg8::EpiProj<0> E{SSQ(0), C.tab, PQ, PK, PV, PG, 1.0f}; run_dense(C, C.H, D, 0, C.WB + WB_MIX, D, 6144, E); SEAM(P0_QKVG); }
    if (IN(P0_RET)) { ret_mfma5<false>(C, PQ, PK, PV, PG, nullptr, C.in[9]); SEAM(P0_RET); }
    if (IN(P0_FIN)) { PR_STAMP(P0_FIN); }
    if (IN(P0_WO)) { pg8::EpiResid E{C.H, SSQ(1), nullptr, nullptr, 1.0f}; run_dense(C, PG, 2048, 0, C.WB + WB_WO, 2048, 1024, E); SEAM(P0_WO); }
    if (IN(P0_W13)) { pg8::EpiSwiglu<false> E{SSQ(1), HID}; run_dense(C, C.H, D, 0, C.WB + WB_W13, D, 5632, E); SEAM(P0_W13); }
    if (IN(P0_W2)) { pg8::EpiResid E{C.H, SSQ(2), nullptr, nullptr, 1.0f}; run_dense(C, HID, FF, 0, C.WB + WB_W2, FF, 1024, E); SEAM(P0_W2); }
    if (IN(P1_QKV)) { pg8::EpiProj<1> E{SSQ(2), C.tab, PQ, PK, PV, PG, 1.0f}; run_dense(C, C.H, D, 0, C.WA + WA_MIX, D, 3072, E); SEAM(P1_QKV); }
    if (IN(P1_SB)) { sb_naive(C, PQ, PK, PV); if (!NAIVE_SB) sb_mfma(C, PQ, PK, PV); SEAM(P1_SB); }
    if (IN(P1_WO)) { pg8::EpiResid E{C.H, SSQ(3), nullptr, H8M, 1.0f}; run_dense(C, PQ, D, 0, C.WA + WA_MIX_WO_SB, D, 1024, E); SEAM(P1_WO); }
    if (IN(P1_RA)) {
        router_a(C, 0, 1, SSQ(3), C.moe);
        { LAS float* scr = (LAS float*)(C.lds + C.wave * 16384);
          for (int g = 0; g < 4; ++g) wt_matrix<0>(C.in[12] + (size_t)g * 256 * 256, 256, 256, 256, C.WB + WB_MIX + (size_t)g * 256 * 256, nullptr, scr, C.gw, C.NGW, C.lane); }
        conv_dense(C, 1, 2, C.WB + WB_W13, C.WB + WB_W2);
        SEAM(P1_RA);
    }
    if (IN(P1_RB)) { router_b(C, SSQ(3), C.moe, C.moe + 2 * 256 * NE, srow); SEAM(P1_RB); }
    if (IN(P1_M13)) { pg8::EpiSwigluF8<true> E{rstds, (unsigned char*)MHID}; run_moe8(C, C.moe + 2 * 256 * NE, H8M, (const unsigned char*)(C.WA + WA_MOE13), (size_t)5632 * D, D, 5632, E, srow); SEAM(P1_M13); }
    if (IN(P1_M2)) { pg8::EpiMoeW2 E{gates, XS}; run_moe8(C, C.moe + 2 * 256 * NE, (const unsigned char*)MHID, (const unsigned char*)(C.WA + WA_MOE2), (size_t)D * FF, FF, 1024, E); SEAM(P1_M2); }
    if (IN(P1_CMB)) {
        moe_combine(C, XS, SSQ(4));
        conv_ret8(C, 1, 3, C.WA + WA_MIX, C.WA + WA_MIX_WO_RET);
        conv_moe(C, 1, 3, C.WA + WA_MOE13, C.WA + WA_MOE2);
        SEAM(P1_CMB);
    }
    if (IN(P2_PREP)) { pool_prep(C, SSQ(4), C.in[2] + 2 * D, PQ); SEAM(P2_PREP); }
    if (IN(P2_POOL)) { pg8::EpiResid E{C.H, SSQ(5), C.in[13], H8P, 1.0f}; run_dense(C, PQ, D, 512, C.WB + WB_MIX, 256, 1024, E); SEAM(P2_POOL); }
    if (IN(P2_W13)) { pg8::EpiSwigluF8<false> E{SSQ(5), (unsigned char*)HID}; run_dense8(C, H8P, D, (const unsigned char*)(C.WB + WB_W13), D, 5632, E); SEAM(P2_W13); }
    if (IN(P2_W2)) { pg8::EpiResid E{C.H, SSQ(6), nullptr, H8L3, 1.0f / (pg8::F8_W2 * pg8::F8_HID)}; run_dense8(C, (const unsigned char*)HID, FF, (const unsigned char*)(C.WB + WB_W2), FF, 1024, E); SEAM(P2_W2); }
    if (IN(P3_QKVG)) { ZERO_ROWS(); pg8::EpiProj<0> E{SSQ(6), C.tab, PQ, PK, PV, PG, 1.0f / F8_WP}; run_dense8(C, H8L3, D, (const unsigned char*)(C.WA + WA_MIX), D, 6144, E); SEAM(P3_QKVG); }
    if (IN(P3_RET)) { ret_mfma5<true>(C, PQ, PK, PV, PG, A28, C.in[9] + 2 * D); SEAM(P3_RET); }
    if (IN(P3_FIN)) { PR_STAMP(P3_FIN); }
    if (IN(P3_WO)) { pg8::EpiResid E{C.H, SSQ(7), nullptr, H8M, 1.0f / (F8_WO * F8_A2)}; run_dense8(C, A28, 2048, (const unsigned char*)(C.WA + WA_MIX_WO_RET), 2048, 1024, E); SEAM(P3_WO); }
    if (IN(P3_RA)) { router_a(C, 1, 3, SSQ(7), C.moe + 256 * NE); SEAM(P3_RA); }
    if (IN(P3_RB)) { router_b(C, SSQ(7), C.moe + 256 * NE, C.moe + 2 * 256 * NE + 16, srow); SEAM(P3_RB); }
    if (IN(P3_M13)) { pg8::EpiSwigluF8<true> E{rstds, (unsigned char*)MHID}; run_moe8(C, C.moe + 2 * 256 * NE + 16, H8M, (const unsigned char*)(C.WA + WA_MOE13), (size_t)5632 * D, D, 5632, E, srow); SEAM(P3_M13); }
    if (IN(P3_M2)) { pg8::EpiMoeW2 E{gates, XS}; run_moe8(C, C.moe + 2 * 256 * NE + 16, (const unsigned char*)MHID, (const unsigned char*)(C.WA + WA_MOE2), (size_t)D * FF, FF, 1024, E); SEAM(P3_M2); }
    if (IN(P3_CMB)) { moe_combine_final(C, XS, C.in[21], C.out); PR_STAMP(P3_CMB); }
    if (IN(P_FINAL)) {
#if PROBE_GROUP
        __syncthreads();
        if (blockIdx.x == 0 && C.tid == 0) { const unsigned long long tot = __builtin_amdgcn_s_memrealtime() - pr_t0; asm volatile("s_waitcnt vmcnt(0)" ::: "memory");
            if ((PROBE_GROUP >= 9 && PROBE_GROUP <= 11) || PROBE_GROUP == 60 || PROBE_GROUP == 61) pr_acc = *(LAS unsigned long long*)(C.lds + LDSCTL_OFF + 8192);
            C.out[0] = 4.0f + __builtin_rintf(PROBE_GAIN * (float)pr_acc / (float)tot); }
#endif
    }
#undef IN
#undef SEAM
#undef SSQ
}

extern "C" void kernel_launch(void* const* d_in, const int* in_sizes, int n_in, void* d_out, int out_size, void* d_ws, size_t ws_size, hipStream_t stream) {
    static int grid = 0;
    if (grid == 0) {
        if (n_in != 22 || out_size != MREAL * D || ws_size < WS_END) { fprintf(stderr, "kernel_launch: unexpected shapes (n_in %d out %d ws %zu)\n", n_in, out_size, ws_size); grid = -1; return; }
        int dev = 0, cus = 0;
        if (hipGetDevice(&dev) != hipSuccess || hipDeviceGetAttribute(&cus, hipDeviceAttributeMultiprocessorCount, dev) != hipSuccess) { grid = -1; return; }
        if (hipFuncSetAttribute((const void*)fwd_kernel, hipFuncAttributeMaxDynamicSharedMemorySize, LDS_BYTES) != hipSuccess) { grid = -1; return; }
        int per_cu = 0;
        if (hipOccupancyMaxActiveBlocksPerMultiprocessor(&per_cu, (const void*)fwd_kernel, 512, LDS_BYTES) != hipSuccess || per_cu < 1) { fprintf(stderr, "kernel_launch: occupancy query says %d\n", per_cu); }
        (void)hipGetLastError();
        grid = cus;
    }
    if (grid < 0) return;
    (void)hipMemsetAsync((char*)d_ws + WS_CTL, 0, CTL_BYTES, stream);
    Args a{};
    for (int i = 0; i < 22; ++i) a.in[i] = (const float*)d_in[i];
    a.out = (float*)d_out; a.ws = (unsigned char*)d_ws;
#if MK_PER_PHASE
    for (int k = 0; k < P_COUNT; ++k) { a.ph_lo = k; a.ph_hi = k + 1; hipLaunchKernelGGL(fwd_kernel, dim3(grid), dim3(512), LDS_BYTES, stream, a); }
#else
    a.ph_lo = 0; a.ph_hi = P_COUNT;
    hipLaunchKernelGGL(fwd_kernel, dim3(grid), dim3(512), LDS_BYTES, stream, a);
#endif
}
```

```cpp
#include <hip/hip_runtime.h>
#include <cstdio>
#include <cstdint>

#ifndef MK_PER_PHASE
#define MK_PER_PHASE 0
#endif
#ifndef PROBE_GAIN
#define PROBE_GAIN 92.0f
#endif
#ifndef PROBE_GROUP
#define PROBE_GROUP 0
#endif
#ifndef NAIVE_RET
#define NAIVE_RET 0
#endif
#ifndef NAIVE_SB
#define NAIVE_SB 0
#endif

#define GAS __attribute__((address_space(1)))
#define LAS __attribute__((address_space(3)))
typedef unsigned short bf16_t;
typedef short bf16x8 __attribute__((ext_vector_type(8)));
typedef float f32x4 __attribute__((ext_vector_type(4)));
typedef float f32x2 __attribute__((ext_vector_type(2)));
typedef unsigned u32x4 __attribute__((ext_vector_type(4)));
typedef unsigned u32x2 __attribute__((ext_vector_type(2)));

constexpr int D = 1024, NBATCH = 16, SEQ = 2048, NMETA = 16;
constexpr int MREAL = NBATCH * SEQ;
constexpr int MVALID = MREAL + NMETA;
constexpr int MROWS = 33024;
constexpr int FF = 2816, NE = 8;
constexpr int LPOS = SEQ + NMETA;
constexpr float EPS = 1e-6f;
constexpr int MOE_ROWS = 67840;

constexpr size_t MiB = 1u << 20;
constexpr size_t WS_CTL = 0, CTL_BYTES = 1 * MiB;
constexpr int CW_BAR = 4096;
constexpr size_t CTL_SROW = 64 * 1024;
constexpr size_t CTL_MOE = 512 * 1024;
constexpr size_t WS_SSQ = 1 * MiB;
constexpr size_t WS_GST = 20 * MiB;
constexpr size_t WS_WA = 29 * MiB, WS_WB = 185 * MiB, WS_H = 221 * MiB, WS_TAB = 289 * MiB, WS_MISC = 291 * MiB, WS_POOL = 297 * MiB, WS_END = 795 * MiB;
static_assert(WS_SSQ + (size_t)9 * MROWS * 64 <= WS_GST && WS_GST + (size_t)MROWS * 8 * 8 * 4 <= WS_WA, "ssq/gst");
constexpr size_t WA_MOE13 = 0, WA_MOE2 = (size_t)NE * 5632 * 1024, WA_MIX = WA_MOE2 + (size_t)NE * 1024 * 2816;
constexpr size_t WA_MIX_WO_SB = WA_MIX + (size_t)3072 * 1024, WA_MIX_WO_RET = WA_MIX + (size_t)6144 * 1024;
constexpr size_t WB_MIX = 0, WB_WO = (size_t)6144 * 1024, WB_W13 = WB_WO + (size_t)1024 * 2048, WB_W2 = WB_W13 + (size_t)5632 * 1024;
static_assert((WA_MIX + 8388608) * 2 <= 156 * MiB && (WB_W2 + (size_t)1024 * 2816) * 2 <= 36 * MiB, "weight regions");
constexpr size_t MISC_TOKE = 0, MISC_TOKG = 512 * 1024, MISC_TOKR = 1024 * 1024, MISC_TOKP = 1536 * 1024, MISC_RSTDS = 2 * MiB, MISC_GATES = 2 * MiB + 512 * 1024, MISC_YM = 3 * MiB;
constexpr size_t ACT1 = (size_t)MROWS * 1024 * 2;
constexpr size_t PO_Q = 0, PO_K = ACT1, PO_V = 2 * ACT1, PO_G = 4 * ACT1;
constexpr size_t PO_HID = 0, PO_D = 0;
constexpr size_t PO_XS = 0, PO_MHID = 133 * MiB;
static_assert(PO_G + 2 * ACT1 <= 498 * MiB && PO_MHID + (size_t)MOE_ROWS * FF * 2 <= 498 * MiB && (size_t)MOE_ROWS * 2048 <= 133 * MiB, "pool");

constexpr int RING_BYTES = 147456;
constexpr int LDSCTL_OFF = RING_BYTES;
constexpr int LDS_PEXP = LDSCTL_OFF + 256;
constexpr int LDS_BYTES = 163840;

__device__ __forceinline__ unsigned f2bf(float f) { unsigned u = __builtin_bit_cast(unsigned, f); return (u + 0x7fffu + ((u >> 16) & 1u)) >> 16; }
typedef __bf16 bf16x2_t __attribute__((ext_vector_type(2)));
__device__ __forceinline__ unsigned pk2(float lo, float hi) { const f32x2 v = {lo, hi}; const bf16x2_t b = __builtin_convertvector(v, bf16x2_t); return __builtin_bit_cast(unsigned, b); }
__device__ __forceinline__ float bflo(unsigned u) { return __builtin_bit_cast(float, u << 16); }
__device__ __forceinline__ float bfhi(unsigned u) { return __builtin_bit_cast(float, u & 0xffff0000u); }
__device__ __forceinline__ float bf1(bf16_t u) { return __builtin_bit_cast(float, ((unsigned)u) << 16); }
__device__ __forceinline__ float fast_rcp(float x) { return __builtin_amdgcn_rcpf(x); }
__device__ __forceinline__ float fast_exp2(float x) { return __builtin_amdgcn_exp2f(x); }
__device__ __forceinline__ float silu_f(float v) { return v * fast_rcp(1.0f + fast_exp2(-1.4426950408889634f * v)); }
__device__ __forceinline__ float wave_sum(float v) {
#pragma unroll
    for (int o = 1; o < 64; o <<= 1) v += __shfl_xor(v, o);
    return v;
}
__device__ __forceinline__ int row_pos(int row) { return row < MREAL ? NMETA + (row & (SEQ - 1)) : (row - MREAL < NMETA ? row - MREAL : NMETA - 1); }
__device__ __forceinline__ int pos_row(int b, int p) { return p < NMETA ? MREAL + p : b * SEQ + p - NMETA; }
#define LDS_WAIT() asm volatile("s_waitcnt lgkmcnt(0)" ::: "memory")

namespace pg8 {
constexpr int BM = 256, BK = 64, HALF = 128, HTB = HALF * BK * 2, NXCD = 8, WGM = 8;
__host__ __device__ __forceinline__ int lds_byte(int r, int c) { const int st = (r >> 4) * 2 + (c >> 5), rr = r & 15, cc = c & 31, ob = rr * 64 + cc * 2; return st * 1024 + (ob ^ (((ob >> 9) & 1) << 5)); }
__host__ __device__ __forceinline__ void stage_rc(int b, int& R, int& C) { const int st = b / 1024, sb = b % 1024, swz = sb ^ (((sb >> 9) & 1) << 5); R = (st >> 1) * 16 + swz / 64; C = (st & 1) * 32 + (swz % 64) / 2; }
__host__ __device__ __forceinline__ int perm32(int rho) { const int n = rho >> 4, i = rho & 15; return 8 * (i >> 2) + 4 * n + (i & 3); }
struct Unit { int pm, pn; };

template <bool MOE> struct Sched {
    int nM, nN, nwg, G, c; const char* A; const char* Bt; size_t a_pm, a_pn, b_pn, b_e; const LAS int* pexp;
    __device__ __forceinline__ bool next(int i, Unit& u) const {
        const long L = (long)i * G + c; if (L >= nwg) return false;
        int wgid = (int)L; { const int q = nwg / NXCD, r = nwg % NXCD, xcd = wgid % NXCD, off = wgid / NXCD; wgid = (xcd < r ? xcd * (q + 1) : r * (q + 1) + (xcd - r) * q) + off; }
        const int nig = WGM * nN, gid = wgid / nig, fm = gid * WGM, gsz = (nM - fm) < WGM ? (nM - fm) : WGM;
        u.pm = fm + ((wgid % nig) % gsz); u.pn = (wgid % nig) / gsz; return true;
    }
    __device__ __forceinline__ const char* aptr(const Unit& u) const { return A + (size_t)u.pm * a_pm + (size_t)u.pn * a_pn; }
    __device__ __forceinline__ const char* bptr(const Unit& u) const { const char* b = Bt + (size_t)u.pn * b_pn; if constexpr (MOE) b += (size_t)pexp[u.pm] * b_e; return b; }
};

template <class Epi, class SchedT>
__device__ __forceinline__ void gemm_phase(LAS unsigned char* lds, const int K, const int lda, const SchedT& S, const Epi& E) {
    const int tid = threadIdx.x, wid = __builtin_amdgcn_readfirstlane(tid >> 6), lane = tid & 63, wr = wid >> 2, wc = wid & 3, fr = lane & 15, fq = lane >> 4;
    const int nt = K / BK;
    unsigned voffA[2], voffB[2];
#pragma unroll
    for (int i = 0; i < 2; ++i) { int R, C; stage_rc(tid * 16 + i * 8192, R, C); const int Rb = (R & ~31) + perm32(R & 31);
        voffA[i] = (unsigned)(R * lda + C) * 2u; voffB[i] = (unsigned)(Rb * K + C) * 2u; }
    const size_t kstep = (size_t)(BK * 2);
    const size_t hstepA = (size_t)HALF * lda * 2, hstepB = (size_t)HALF * K * 2;
    const unsigned ldsw = (unsigned)wid * 1024u;
    const int aoff = lds_byte(wr * 64 + fr, fq * 8), boff = lds_byte(wc * 32 + fr, fq * 8);
#define PG8_SA(b, h) (((b) * 2 + (h)) * HTB)
#define PG8_SB(b, h) ((4 + (b) * 2 + (h)) * HTB)
#define PG8_STAGE(bufoff, gbase, voff) do { _Pragma("unroll") for (int _i = 0; _i < 2; ++_i) \
        __builtin_amdgcn_global_load_lds((const unsigned*)((const char*)(gbase) + (voff)[_i]), (LAS unsigned*)(lds + (bufoff) + ldsw + _i * 8192), 16, 0, 0); } while (0)
#define PG8_LDA(dst, b, h) do { _Pragma("unroll") for (int m = 0; m < 4; ++m) _Pragma("unroll") for (int k = 0; k < 2; ++k) dst[m][k] = *(const LAS bf16x8*)(lds + PG8_SA(b, h) + aoff + m * 2048 + k * 1024); } while (0)
#define PG8_LDB(dst, b, h) do { _Pragma("unroll") for (int n = 0; n < 2; ++n) _Pragma("unroll") for (int k = 0; k < 2; ++k) dst[n][k] = *(const LAS bf16x8*)(lds + PG8_SB(b, h) + boff + n * 2048 + k * 1024); } while (0)
#define PG8_MMA(ai, bj, At, Bt) do { __builtin_amdgcn_s_setprio(1); _Pragma("unroll") for (int m = 0; m < 4; ++m) _Pragma("unroll") for (int n = 0; n < 2; ++n) _Pragma("unroll") for (int k = 0; k < 2; ++k) \
        acc[ai][bj][m][n] = __builtin_amdgcn_mfma_f32_16x16x32_bf16(Bt[n][k], At[m][k], acc[ai][bj][m][n], 0, 0, 0); __builtin_amdgcn_s_setprio(0); } while (0)
#define PG8_WAIT_V(n) asm volatile("s_waitcnt vmcnt(" #n ")" ::: "memory")
#define PG8_WAIT_L(n) asm volatile("s_waitcnt lgkmcnt(" #n ")" ::: "memory")
#define PG8_BAR __builtin_amdgcn_s_barrier()
#define PG8_SCHED __builtin_amdgcn_sched_barrier(0)
    Unit cur, nxt; int ui = 0;
    if (!S.next(0, cur)) return;
    f32x4 acc[2][2][4][2];
#pragma unroll
    for (int a = 0; a < 2; ++a)
#pragma unroll
        for (int b = 0; b < 2; ++b)
#pragma unroll
            for (int m = 0; m < 4; ++m)
#pragma unroll
                for (int n = 0; n < 2; ++n) acc[a][b][m][n] = (f32x4){0.f, 0.f, 0.f, 0.f};
    bf16x8 At[4][2], B0[2][2], B1[2][2];
    const char* cA = S.aptr(cur); const char* cB = S.bptr(cur);
    PG8_STAGE(PG8_SB(0, 0), cB, voffB); PG8_STAGE(PG8_SB(0, 1), cB + hstepB, voffB); PG8_STAGE(PG8_SA(0, 0), cA, voffA); PG8_STAGE(PG8_SA(0, 1), cA + hstepA, voffA);
    if (wr == 1) PG8_BAR;
    PG8_WAIT_V(2); PG8_BAR;
    PG8_STAGE(PG8_SB(1, 0), cB + kstep, voffB); PG8_STAGE(PG8_SA(1, 0), cA + kstep, voffA); PG8_STAGE(PG8_SB(1, 1), cB + hstepB + kstep, voffB);
    PG8_WAIT_V(6); PG8_BAR;
    for (;;) {
        const bool has_next = S.next(ui + 1, nxt);
        const char* nA = has_next ? S.aptr(nxt) : cA; const char* nB = has_next ? S.bptr(nxt) : cB;
        for (int t = 0; t < nt; t += 2) {
            const bool last = (t == nt - 2);
            const char* a1 = cA + (size_t)(t + 1) * kstep;
            const char* a2 = last ? nA : cA + (size_t)(t + 2) * kstep; const char* b2 = last ? nB : cB + (size_t)(t + 2) * kstep;
            const char* a3 = a2 + kstep; const char* b3 = b2 + kstep;
            PG8_LDB(B0, 0, 0); PG8_LDB(B1, 0, 1); PG8_SCHED; PG8_LDA(At, 0, 0); PG8_STAGE(PG8_SA(1, 1), a1 + hstepA, voffA);
            PG8_WAIT_V(8); PG8_WAIT_L(0); PG8_BAR; PG8_MMA(0, 0, At, B0); PG8_MMA(0, 1, At, B1); PG8_BAR; PG8_SCHED;
            PG8_LDA(At, 0, 1); PG8_STAGE(PG8_SB(0, 0), b2, voffB); PG8_STAGE(PG8_SB(0, 1), b2 + hstepB, voffB); PG8_STAGE(PG8_SA(0, 0), a2, voffA);
            PG8_WAIT_V(8); PG8_WAIT_L(0); PG8_BAR; PG8_MMA(1, 0, At, B0); PG8_MMA(1, 1, At, B1); PG8_BAR; PG8_SCHED;
            PG8_LDB(B0, 1, 0); PG8_LDB(B1, 1, 1); PG8_SCHED; PG8_LDA(At, 1, 0); PG8_STAGE(PG8_SA(0, 1), a2 + hstepA, voffA);
            PG8_WAIT_V(8); PG8_WAIT_L(0); PG8_BAR; PG8_MMA(0, 0, At, B0); PG8_MMA(0, 1, At, B1); PG8_BAR; PG8_SCHED;
            PG8_LDA(At, 1, 1); PG8_STAGE(PG8_SB(1, 0), b3, voffB); PG8_STAGE(PG8_SB(1, 1), b3 + hstepB, voffB); PG8_STAGE(PG8_SA(1, 0), a3, voffA);
            PG8_WAIT_V(8); PG8_WAIT_L(0); PG8_BAR; PG8_MMA(1, 0, At, B0); PG8_MMA(1, 1, At, B1); PG8_BAR; PG8_SCHED;
        }
#if PROBE_GROUP == 9 || PROBE_GROUP == 61
        const unsigned long long _pt0 = __builtin_amdgcn_s_memrealtime();
#endif
        if (wr == 0) PG8_BAR;
        epi_tile(E, acc, cur, wr, wc, fr, fq);
#if PROBE_GROUP == 9
        asm volatile("" ::: "memory"); if (blockIdx.x == 0 && tid == 0) *(LAS unsigned long long*)(lds + LDSCTL_OFF + 8192) += __builtin_amdgcn_s_memrealtime() - _pt0;
#endif
#if PROBE_GROUP == 61
        asm volatile("" ::: "memory"); if (!Epi::BATCH && !Epi::HASPRE && blockIdx.x == 0 && tid == 0) *(LAS unsigned long long*)(lds + LDSCTL_OFF + 8192) += __builtin_amdgcn_s_memrealtime() - _pt0;
#endif
        if (!has_next) break;
#pragma unroll
        for (int a = 0; a < 2; ++a)
#pragma unroll
            for (int b = 0; b < 2; ++b)
#pragma unroll
                for (int m = 0; m < 4; ++m)
#pragma unroll
                    for (int n = 0; n < 2; ++n) acc[a][b][m][n] = (f32x4){0.f, 0.f, 0.f, 0.f};
        cur = nxt; cA = nA; cB = nB; ++ui;
        if (wr == 1) PG8_BAR;
    }
    PG8_WAIT_V(0);
    PG8_BAR;
#undef PG8_SA
#undef PG8_SB
#undef PG8_STAGE
#undef PG8_LDA
#undef PG8_LDB
#undef PG8_MMA
#undef PG8_WAIT_V
#undef PG8_WAIT_L
#undef PG8_BAR
#undef PG8_SCHED
}

__device__ __forceinline__ float clamp8(float x) { return __builtin_amdgcn_fmed3f(x, -448.0f, 448.0f); }
__device__ __forceinline__ u32x2 pack_fp8x8(float a0, float a1, float a2, float a3, float a4, float a5, float a6, float a7) {
    int lo = __builtin_amdgcn_cvt_pk_fp8_f32(clamp8(a0), clamp8(a1), 0, false); lo = __builtin_amdgcn_cvt_pk_fp8_f32(clamp8(a2), clamp8(a3), lo, true);
    int hi = __builtin_amdgcn_cvt_pk_fp8_f32(clamp8(a4), clamp8(a5), 0, false); hi = __builtin_amdgcn_cvt_pk_fp8_f32(clamp8(a6), clamp8(a7), hi, true);
    return (u32x2){(unsigned)lo, (unsigned)hi}; }
typedef f32x4 Acc[2][2][4][2];
__device__ __forceinline__ float gload1_asm(const float* p) { float v; asm volatile("global_load_dword %0, %1, off" : "=v"(v) : "v"(p) : "memory"); return v; }
__device__ __forceinline__ f32x4 gload4f_asm(const float* p) { f32x4 v; asm volatile("global_load_dwordx4 %0, %1, off" : "=v"(v) : "v"(p) : "memory"); return v; }
__device__ __forceinline__ void gload4f_tied(f32x4& v, const float* p) { asm volatile("global_load_dwordx4 %0, %1, off" : "+v"(v) : "v"(p) : "memory"); }
#define PG8_WAIT_PIN8(r) asm volatile("s_waitcnt vmcnt(0)" : "+v"(r[0][0]), "+v"(r[0][1]), "+v"(r[0][2]), "+v"(r[0][3]), "+v"(r[1][0]), "+v"(r[1][1]), "+v"(r[1][2]), "+v"(r[1][3]) : : "memory")
template <bool ROW> struct PreRaw { typedef f32x4 T; };
template <> struct PreRaw<true> { typedef float T; };
__device__ __forceinline__ float rstd_fin(const f32x4 a) { float s = (a[0] + a[1]) + (a[2] + a[3]); s += __shfl_xor(s, 16); s += __shfl_xor(s, 32); return __builtin_amdgcn_rsqf(s * (1.0f / D) + EPS); }
__device__ __forceinline__ float rstd_of(const float* ssqp, int row) {
    const f32x4* p = (const f32x4*)(ssqp + (size_t)row * 16); const f32x4 a = p[0], b = p[1], c = p[2], d = p[3];
    const float s = ((a[0] + a[1]) + (a[2] + a[3])) + ((b[0] + b[1]) + (b[2] + b[3])) + ((c[0] + c[1]) + (c[2] + c[3])) + ((d[0] + d[1]) + (d[2] + d[3]));
    return __builtin_amdgcn_rsqf(s * (1.0f / D) + EPS); }
__device__ __forceinline__ float rstd_coop(const float* ssqp, int row, int fq) {
    const f32x4 a = *(const f32x4*)(ssqp + (size_t)row * 16 + 4 * fq);
    float s = (a[0] + a[1]) + (a[2] + a[3]);
    s += __shfl_xor(s, 16); s += __shfl_xor(s, 32);
    return __builtin_amdgcn_rsqf(s * (1.0f / D) + EPS); }
__device__ __forceinline__ void ssq_store_single(float* ssqp, int row, float ss, int lane) { if (lane < 16) ssqp[(size_t)row * 16 + lane] = (lane == 0) ? ss : 0.f; }
template <class Epi> __device__ __forceinline__ void epi_tile(const Epi& E, const Acc& acc, const Unit& u, int wr, int wc, int fr, int fq) {
    if constexpr (Epi::BATCH) { E.tile(acc, u, wr, wc, fr, fq); return; }
    else if constexpr (Epi::HASPRE) {
        typename Epi::Raw raw[2][4]; float pre[2][4];
#pragma unroll
        for (int ai = 0; ai < 2; ++ai)
#pragma unroll
            for (int m = 0; m < 4; ++m) raw[ai][m] = E.pre_load(u.pm * BM + ai * HALF + wr * 64 + m * 16 + fr, fq);
        PG8_WAIT_PIN8(raw);
#pragma unroll
        for (int ai = 0; ai < 2; ++ai)
#pragma unroll
            for (int m = 0; m < 4; ++m) pre[ai][m] = E.pre_fin(raw[ai][m], fq);
#pragma unroll
        for (int ai = 0; ai < 2; ++ai)
#pragma unroll
            for (int m = 0; m < 4; ++m) E.frag(u.pm * BM + ai * HALF + wr * 64 + m * 16 + fr, u.pn, wc, fq, pre[ai][m], acc[ai][0][m][0], acc[ai][0][m][1], acc[ai][1][m][0], acc[ai][1][m][1]);
    } else {
#pragma unroll
        for (int ai = 0; ai < 2; ++ai)
#pragma unroll
            for (int m = 0; m < 4; ++m) E.frag(u.pm * BM + ai * HALF + wr * 64 + m * 16 + fr, u.pn, wc, fq, acc[ai][0][m][0], acc[ai][0][m][1], acc[ai][1][m][0], acc[ai][1][m][1]);
    }
}
template <class Epi> __device__ __forceinline__ void epi_frag(const Epi& E, int row, int pn, int wc, int fq, const f32x4 a00, const f32x4 a01, const f32x4 a10, const f32x4 a11) {
    if constexpr (Epi::HASPRE) { typename Epi::Raw r = E.pre_load(row, fq); asm volatile("s_waitcnt vmcnt(0)" : "+v"(r) : : "memory"); E.frag(row, pn, wc, fq, E.pre_fin(r, fq), a00, a01, a10, a11); }
    else E.frag(row, pn, wc, fq, a00, a01, a10, a11);
}

template <int MODE> struct EpiProj {
    static constexpr bool BATCH = true, HASPRE = false;
    const float* ssq; const f32x2* tab; bf16_t* Q; bf16_t* Kk; bf16_t* V; bf16_t* Gt; float ascale;
    __device__ __forceinline__ void tile(const Acc& acc, const Unit& u, int wr, int wc, int fr, int fq) const {
        const int pn = u.pn; int seg, colt, ld; size_t boff;
        if (MODE == 0) { if (pn < 4) { seg = 0; colt = pn * 256; ld = 1024; boff = PO_Q; } else if (pn < 8) { seg = 1; colt = (pn - 4) * 256; ld = 1024; boff = PO_K; }
                         else if (pn < 16) { seg = 2; colt = (pn - 8) * 256; ld = 2048; boff = PO_V; } else { seg = 3; colt = (pn - 16) * 256; ld = 2048; boff = PO_G; } }
        else { ld = 1024; if (pn < 4) { seg = 4; colt = pn * 256; boff = PO_Q; } else if (pn < 8) { seg = 2; colt = (pn - 4) * 256; boff = PO_K; } else { seg = 2; colt = (pn - 8) * 256; boff = PO_V; } }
        bf16_t* base = (bf16_t*)((unsigned char*)Q + boff);
        const int col0 = colt + wc * 32 + 8 * fq, row0 = u.pm * BM + wr * 64 + fr;
        f32x4 raw[2][4]; float rsv[2][4];
#pragma unroll
        for (int ai = 0; ai < 2; ++ai)
#pragma unroll
            for (int m = 0; m < 4; ++m) raw[ai][m] = gload4f_asm(ssq + (size_t)(row0 + ai * HALF + m * 16) * 16 + 4 * fq);
        PG8_WAIT_PIN8(raw);
#pragma unroll
        for (int ai = 0; ai < 2; ++ai)
#pragma unroll
            for (int m = 0; m < 4; ++m) rsv[ai][m] = rstd_fin(raw[ai][m]);
        if (MODE == 0 && seg < 2) {
            asm volatile("" ::: "memory");
            float invr[2][4], l2g[2];
#pragma unroll
            for (int bj = 0; bj < 2; ++bj) { const int i0 = ((col0 + bj * HALF) & 127) >> 1;
#pragma unroll
                for (int jj = 0; jj < 4; ++jj) invr[bj][jj] = fast_exp2(-(float)(i0 + jj) * (13.287712379549449f / 64.0f)) * 0.15915494309189535f;
                const int hh = ((pn & 3) << 1) + bj; l2g[bj] = __builtin_amdgcn_logf(1.0f - fast_exp2(-5.0f - (float)hh)) * (seg == 0 ? 1.0f : -1.0f); }
            const float kscale = (seg == 1) ? 0.08838834764831845f : 1.0f;
#pragma unroll
            for (int ai = 0; ai < 2; ++ai)
#pragma unroll
                for (int m = 0; m < 4; ++m) {
                    const int row = row0 + ai * HALF + m * 16; const float rs = rsv[ai][m] * (kscale * ascale);
                    const float pf = (float)row_pos(row); const float cl = (float)(row & 127);
#pragma unroll
                    for (int bj = 0; bj < 2; ++bj) {
                        const float ks = NAIVE_RET ? rs : rs * fast_exp2(cl * l2g[bj]);
                        const f32x4 v0 = acc[ai][bj][m][0] * ks, v1 = acc[ai][bj][m][1] * ks;
                        float c[4], sn[4];
#pragma unroll
                        for (int jj = 0; jj < 4; ++jj) { const float rev = __builtin_amdgcn_fractf(pf * invr[bj][jj]); c[jj] = __builtin_amdgcn_cosf(rev); sn[jj] = __builtin_amdgcn_sinf(rev); }
                        u32x4 w;
                        w.x = pk2(v0[0] * c[0] - v0[1] * sn[0], v0[0] * sn[0] + v0[1] * c[0]); w.y = pk2(v0[2] * c[1] - v0[3] * sn[1], v0[2] * sn[1] + v0[3] * c[1]);
                        w.z = pk2(v1[0] * c[2] - v1[1] * sn[2], v1[0] * sn[2] + v1[1] * c[2]); w.w = pk2(v1[2] * c[3] - v1[3] * sn[3], v1[2] * sn[3] + v1[3] * c[3]);
                        *(u32x4*)(base + (size_t)row * ld + col0 + bj * HALF) = w;
                    }
                }
        } else if (MODE == 0 && seg == 3) {
            asm volatile("" ::: "memory");
#pragma unroll
            for (int ai = 0; ai < 2; ++ai)
#pragma unroll
                for (int m = 0; m < 4; ++m) {
                    const int row = row0 + ai * HALF + m * 16; const float rs = rsv[ai][m] * ascale; const float nrs = -1.4426950408889634f * rs;
#pragma unroll
                    for (int bj = 0; bj < 2; ++bj) {
                        const f32x4 a0 = acc[ai][bj][m][0], a1 = acc[ai][bj][m][1];
                        f32x4 e0 = a0 * nrs, e1 = a1 * nrs;
#pragma unroll
                        for (int j = 0; j < 4; ++j) { e0[j] = fast_exp2(e0[j]); e1[j] = fast_exp2(e1[j]); }
                        e0 = e0 + 1.0f; e1 = e1 + 1.0f;
#pragma unroll
                        for (int j = 0; j < 4; ++j) { e0[j] = fast_rcp(e0[j]); e1[j] = fast_rcp(e1[j]); }
                        const f32x4 o0 = a0 * (e0 * rs), o1 = a1 * (e1 * rs);
                        u32x4 w; w.x = pk2(o0[0], o0[1]); w.y = pk2(o0[2], o0[3]); w.z = pk2(o1[0], o1[1]); w.w = pk2(o1[2], o1[3]);
                        *(u32x4*)(base + (size_t)row * ld + col0 + bj * HALF) = w;
                    }
                }
        } else {
            asm volatile("" ::: "memory");
            const float sc = (MODE == 1 && seg == 4) ? 0.18033688011112042f : 1.0f;
#pragma unroll
            for (int ai = 0; ai < 2; ++ai)
#pragma unroll
                for (int m = 0; m < 4; ++m) {
                    const int row = row0 + ai * HALF + m * 16; const float rs = rsv[ai][m] * (sc * ascale);
#pragma unroll
                    for (int bj = 0; bj < 2; ++bj) {
                        const f32x4 v0 = acc[ai][bj][m][0] * rs, v1 = acc[ai][bj][m][1] * rs;
                        u32x4 w; w.x = pk2(v0[0], v0[1]); w.y = pk2(v0[2], v0[3]); w.z = pk2(v1[0], v1[1]); w.w = pk2(v1[2], v1[3]);
                        *(u32x4*)(base + (size_t)row * ld + col0 + bj * HALF) = w;
                    }
                }
        }
    }
    __device__ __forceinline__ void frag(int row, int pn, int wc, int fq, const f32x4 a00, const f32x4 a01, const f32x4 a10, const f32x4 a11) const {
        int seg, colt, ld; size_t boff;
        if (MODE == 0) { if (pn < 4) { seg = 0; colt = pn * 256; ld = 1024; boff = PO_Q; } else if (pn < 8) { seg = 1; colt = (pn - 4) * 256; ld = 1024; boff = PO_K; }
                         else if (pn < 16) { seg = 2; colt = (pn - 8) * 256; ld = 2048; boff = PO_V; } else { seg = 3; colt = (pn - 16) * 256; ld = 2048; boff = PO_G; } }
        else { ld = 1024; if (pn < 4) { seg = 4; colt = pn * 256; boff = PO_Q; } else if (pn < 8) { seg = 2; colt = (pn - 4) * 256; boff = PO_K; } else { seg = 2; colt = (pn - 8) * 256; boff = PO_V; } }
        bf16_t* base = (bf16_t*)((unsigned char*)Q + boff);
        const int col0 = colt + wc * 32 + 8 * fq;
        const float rs = rstd_coop(ssq, row, fq) * ((MODE == 1 && seg == 4) ? 0.18033688011112042f : 1.0f) * ascale;
        const int p = row_pos(row);
#pragma unroll
        for (int bj = 0; bj < 2; ++bj) {
            f32x4 v0 = (bj ? a10 : a00) * rs, v1 = (bj ? a11 : a01) * rs;
            const int col = col0 + bj * HALF;
            if (MODE == 0 && seg < 2) {
                const int i0 = (col & 127) >> 1; const float pf = (float)p;
                f32x4 t0, t1;
#pragma unroll
                for (int jj = 0; jj < 4; ++jj) {
                    const float invr = fast_exp2(-(float)(i0 + jj) * (13.287712379549449f / 64.0f)) * 0.15915494309189535f;
                    const float rev = __builtin_amdgcn_fractf(pf * invr);
                    const float c = __builtin_amdgcn_cosf(rev), sn = __builtin_amdgcn_sinf(rev);
                    if (jj < 2) { t0[2 * jj] = c; t0[2 * jj + 1] = sn; } else { t1[2 * (jj - 2)] = c; t1[2 * (jj - 2) + 1] = sn; }
                }
                f32x4 o0, o1;
                o0[0] = v0[0] * t0[0] - v0[1] * t0[1]; o0[1] = v0[0] * t0[1] + v0[1] * t0[0];
                o0[2] = v0[2] * t0[2] - v0[3] * t0[3]; o0[3] = v0[2] * t0[3] + v0[3] * t0[2];
                o1[0] = v1[0] * t1[0] - v1[1] * t1[1]; o1[1] = v1[0] * t1[1] + v1[1] * t1[0];
                o1[2] = v1[2] * t1[2] - v1[3] * t1[3]; o1[3] = v1[2] * t1[3] + v1[3] * t1[2];
                float ks = (seg == 1) ? 0.08838834764831845f : 1.0f;
                if (!NAIVE_RET) {
                    const int hh = ((pn & 3) << 1) + bj; const float l2g = __builtin_amdgcn_logf(1.0f - fast_exp2(-5.0f - (float)hh));
                    const int cl = row < MREAL ? (row & 127) : 112 + ((row - MREAL) & 15);
                    ks *= fast_exp2((seg == 0 ? (float)cl : -(float)cl) * l2g);
                }
                v0 = o0 * ks; v1 = o1 * ks;
            }
            if (MODE == 0 && seg == 3) {
#pragma unroll
                for (int j = 0; j < 4; ++j) { v0[j] = silu_f(v0[j]); v1[j] = silu_f(v1[j]); }
            }
            u32x4 w; w.x = pk2(v0[0], v0[1]); w.y = pk2(v0[2], v0[3]); w.z = pk2(v1[0], v1[1]); w.w = pk2(v1[2], v1[3]);
            *(u32x4*)(base + (size_t)row * ld + col) = w;
        }
    }
};
struct EpiResid {
    static constexpr bool BATCH = true, HASPRE = false;
    bf16_t* H; float* ssq_out; const float* colscale; unsigned char* H8; float ascale;
    __device__ __forceinline__ void frag_r(int row, int pn, int wc, int fq, const u32x4 hv0, const u32x4 hv1, const f32x4 c00, const f32x4 c01, const f32x4 c10, const f32x4 c11,
                                           const f32x4 a00, const f32x4 a01, const f32x4 a10, const f32x4 a11) const {
        const int col0 = pn * BM + wc * 32 + 8 * fq; float ss = 0.f;
#pragma unroll
        for (int bj = 0; bj < 2; ++bj) {
            f32x4 a0 = (bj ? a10 : a00) * ascale, a1 = (bj ? a11 : a01) * ascale;
            if (colscale) { a0 = a0 * (bj ? c10 : c00); a1 = a1 * (bj ? c11 : c01); }
            bf16_t* hp = H + (size_t)row * D + col0 + bj * HALF;
            const u32x4 hv = bj ? hv1 : hv0;
            u32x4 w;
            w.x = pk2(bflo(hv.x) + a0[0], bfhi(hv.x) + a0[1]); w.y = pk2(bflo(hv.y) + a0[2], bfhi(hv.y) + a0[3]);
            w.z = pk2(bflo(hv.z) + a1[0], bfhi(hv.z) + a1[1]); w.w = pk2(bflo(hv.w) + a1[2], bfhi(hv.w) + a1[3]);
            *(u32x4*)hp = w;
            if (H8) *(u32x2*)(H8 + (size_t)row * D + col0 + bj * HALF) = pack_fp8x8(bflo(w.x), bfhi(w.x), bflo(w.y), bfhi(w.y), bflo(w.z), bfhi(w.z), bflo(w.w), bfhi(w.w));
            ss += bflo(w.x) * bflo(w.x) + bfhi(w.x) * bfhi(w.x) + bflo(w.y) * bflo(w.y) + bfhi(w.y) * bfhi(w.y)
                + bflo(w.z) * bflo(w.z) + bfhi(w.z) * bfhi(w.z) + bflo(w.w) * bflo(w.w) + bfhi(w.w) * bfhi(w.w);
        }
        ss += __shfl_xor(ss, 16); ss += __shfl_xor(ss, 32);
        if (fq == 0) ssq_out[(size_t)row * 16 + pn * 4 + wc] = ss;
    }
    __device__ __forceinline__ void frag(int row, int pn, int wc, int fq, const f32x4 a00, const f32x4 a01, const f32x4 a10, const f32x4 a11) const {
        const int col0 = pn * BM + wc * 32 + 8 * fq;
        const u32x4 hv0 = *(const u32x4*)(H + (size_t)row * D + col0), hv1 = *(const u32x4*)(H + (size_t)row * D + col0 + HALF);
        f32x4 c00 = {1.f, 1.f, 1.f, 1.f}, c01 = c00, c10 = c00, c11 = c00;
        if (colscale) { c00 = *(const f32x4*)(colscale + col0); c01 = *(const f32x4*)(colscale + col0 + 4); c10 = *(const f32x4*)(colscale + col0 + HALF); c11 = *(const f32x4*)(colscale + col0 + HALF + 4); }
        frag_r(row, pn, wc, fq, hv0, hv1, c00, c01, c10, c11, a00, a01, a10, a11);
    }
    __device__ __forceinline__ void tile(const Acc& acc, const Unit& u, int wr, int wc, int fr, int fq) const {
        const int col0 = u.pn * BM + wc * 32 + 8 * fq, row0 = u.pm * BM + wr * 64 + fr;
        f32x4 c00 = {1.f, 1.f, 1.f, 1.f}, c01 = c00, c10 = c00, c11 = c00;
        if (colscale) { c00 = *(const f32x4*)(colscale + col0); c01 = *(const f32x4*)(colscale + col0 + 4); c10 = *(const f32x4*)(colscale + col0 + HALF); c11 = *(const f32x4*)(colscale + col0 + HALF + 4); }
#pragma unroll
        for (int ai = 0; ai < 2; ++ai) {
            f32x4 r[2][4];
#pragma unroll
            for (int m = 0; m < 4; ++m) { const bf16_t* hp = H + (size_t)(row0 + ai * HALF + m * 16) * D + col0; r[0][m] = gload4f_asm((const float*)hp); r[1][m] = gload4f_asm((const float*)(hp + HALF)); }
            PG8_WAIT_PIN8(r);
#pragma unroll
            for (int m = 0; m < 4; ++m) frag_r(row0 + ai * HALF + m * 16, u.pn, wc, fq, __builtin_bit_cast(u32x4, r[0][m]), __builtin_bit_cast(u32x4, r[1][m]), c00, c01, c10, c11,
                                               acc[ai][0][m][0], acc[ai][0][m][1], acc[ai][1][m][0], acc[ai][1][m][1]);
        }
    }
};
template <bool ROWRSTD> struct EpiSwiglu {
    static constexpr bool BATCH = false, HASPRE = true;
    const float* rsrc; bf16_t* HID;
    typedef typename PreRaw<ROWRSTD>::T Raw;
    __device__ __forceinline__ Raw pre_load(int row, int fq) const { if constexpr (ROWRSTD) return gload1_asm(rsrc + row); else return gload4f_asm(rsrc + (size_t)row * 16 + 4 * fq); }
    __device__ __forceinline__ float pre_fin(const Raw r, int fq) const { if constexpr (ROWRSTD) return r; else return rstd_fin(r); }
    __device__ __forceinline__ void frag(int row, int pn, int wc, int fq, const float rs, const f32x4 a00, const f32x4 a01, const f32x4 a10, const f32x4 a11) const {
        const int col0 = pn * HALF + wc * 32 + 8 * fq;
        const float nrs = -1.4426950408889634f * rs, rs2 = rs * rs;
        f32x4 e0 = a00 * nrs, e1 = a01 * nrs;
#pragma unroll
        for (int j = 0; j < 4; ++j) { e0[j] = fast_exp2(e0[j]); e1[j] = fast_exp2(e1[j]); }
        e0 = e0 + 1.0f; e1 = e1 + 1.0f;
#pragma unroll
        for (int j = 0; j < 4; ++j) { e0[j] = fast_rcp(e0[j]); e1[j] = fast_rcp(e1[j]); }
        const f32x4 o0 = (a00 * a10) * (e0 * rs2), o1 = (a01 * a11) * (e1 * rs2);
        u32x4 w; w.x = pk2(o0[0], o0[1]); w.y = pk2(o0[2], o0[3]); w.z = pk2(o1[0], o1[1]); w.w = pk2(o1[2], o1[3]);
        *(u32x4*)(HID + (size_t)row * FF + col0) = w;
    }
};
struct EpiMoeW2 {
    static constexpr bool BATCH = false, HASPRE = true;
    const float* gate; bf16_t* YS;
    typedef float Raw;
    __device__ __forceinline__ Raw pre_load(int row, int fq) const { return gload1_asm(gate + row); }
    __device__ __forceinline__ float pre_fin(const Raw r, int fq) const { return r; }
    __device__ __forceinline__ void frag(int row, int pn, int wc, int fq, const float g, const f32x4 a00, const f32x4 a01, const f32x4 a10, const f32x4 a11) const {
        const int col0 = pn * BM + wc * 32 + 8 * fq;
#pragma unroll
        for (int bj = 0; bj < 2; ++bj) {
            const f32x4 v0 = (bj ? a10 : a00) * g, v1 = (bj ? a11 : a01) * g;
            u32x4 w; w.x = pk2(v0[0], v0[1]); w.y = pk2(v0[2], v0[3]); w.z = pk2(v1[0], v1[1]); w.w = pk2(v1[2], v1[3]);
            *(u32x4*)(YS + (size_t)row * D + col0 + bj * HALF) = w;
        }
    }
};

typedef int v8i __attribute__((ext_vector_type(8)));
typedef int v4i __attribute__((ext_vector_type(4)));
__host__ __device__ __forceinline__ int lds_byte8(int r, int cb) { const int st = (r >> 4) * 2 + (cb >> 6), rr = r & 15, cc = cb & 63, ob = rr * 64 + cc; return st * 1024 + (ob ^ (((ob >> 9) & 1) << 4)); }
__host__ __device__ __forceinline__ void stage_rc8(int b, int& R, int& Cb) { const int st = b / 1024, sb = b % 1024, swz = sb ^ (((sb >> 9) & 1) << 4); R = (st >> 1) * 16 + swz / 64; Cb = (st & 1) * 64 + (swz % 64); }
template <class Epi, class SchedT>
__device__ __forceinline__ void gemm_phase8(LAS unsigned char* lds, const int K  , const int lda  , const SchedT& S, const Epi& E) {
    const int tid = threadIdx.x, wid = __builtin_amdgcn_readfirstlane(tid >> 6), lane = tid & 63, wr = wid >> 2, wc = wid & 3, fr = lane & 15, fq = lane >> 4;
    const int nt = K / 128;
    unsigned voffA[2], voffB[2];
#pragma unroll
    for (int i = 0; i < 2; ++i) { int R, Cb; stage_rc8(tid * 16 + i * 8192, R, Cb); const int Rb = (R & ~31) + perm32(R & 31);
        voffA[i] = (unsigned)(R * lda + Cb); voffB[i] = (unsigned)(Rb * K + Cb); }
    const size_t kstep = 128;
    const size_t hstepA = (size_t)HALF * lda, hstepB = (size_t)HALF * K;
    const unsigned ldsw = (unsigned)wid * 1024u;
    const int a0 = lds_byte8(wr * 64 + fr, 32 * fq), a1 = lds_byte8(wr * 64 + fr, 32 * fq + 16), b0 = lds_byte8(wc * 32 + fr, 32 * fq), b1 = lds_byte8(wc * 32 + fr, 32 * fq + 16);
#define PG8_SA(b, h) (((b) * 2 + (h)) * HTB)
#define PG8_SB(b, h) ((4 + (b) * 2 + (h)) * HTB)
#define PG8_STAGE(bufoff, gbase, voff) do { _Pragma("unroll") for (int _i = 0; _i < 2; ++_i) \
        __builtin_amdgcn_global_load_lds((const unsigned*)((const char*)(gbase) + (voff)[_i]), (LAS unsigned*)(lds + (bufoff) + ldsw + _i * 8192), 16, 0, 0); } while (0)
#define PG8_RD32(o0, o1) __builtin_shufflevector(*(const LAS v4i*)(lds + (o0)), *(const LAS v4i*)(lds + (o1)), 0, 1, 2, 3, 4, 5, 6, 7)
#define PG8_LDA(dst, b, h) do { _Pragma("unroll") for (int m = 0; m < 4; ++m) dst[m] = PG8_RD32(PG8_SA(b, h) + a0 + m * 2048, PG8_SA(b, h) + a1 + m * 2048); } while (0)
#define PG8_LDB(dst, b, h) do { _Pragma("unroll") for (int n = 0; n < 2; ++n) dst[n] = PG8_RD32(PG8_SB(b, h) + b0 + n * 2048, PG8_SB(b, h) + b1 + n * 2048); } while (0)
#define PG8_MMA(ai, bj, At, Bt) do { __builtin_amdgcn_s_setprio(1); _Pragma("unroll") for (int m = 0; m < 4; ++m) _Pragma("unroll") for (int n = 0; n < 2; ++n) \
        asm volatile("v_mfma_scale_f32_16x16x128_f8f6f4 %0, %1, %2, %0, %3, %3 op_sel_hi:[0,0,0]" : "+v"(acc[ai][bj][m][n]) : "v"(Bt[n]), "v"(At[m]), "v"(one8)); __builtin_amdgcn_s_setprio(0); } while (0)
#define PG8_MMA0(ai, bj, At, Bt) do { __builtin_amdgcn_s_setprio(1); _Pragma("unroll") for (int m = 0; m < 4; ++m) _Pragma("unroll") for (int n = 0; n < 2; ++n) \
        asm volatile("v_mfma_scale_f32_16x16x128_f8f6f4 %0, %1, %2, 0, %3, %3 op_sel_hi:[0,0,0]" : "=&v"(acc[ai][bj][m][n]) : "v"(Bt[n]), "v"(At[m]), "v"(one8)); __builtin_amdgcn_s_setprio(0); } while (0)
#define PG8_WAIT_V(n) asm volatile("s_waitcnt vmcnt(" #n ")" ::: "memory")
#define PG8_WAIT_L(n) asm volatile("s_waitcnt lgkmcnt(" #n ")" ::: "memory")
#define PG8_BAR __builtin_amdgcn_s_barrier()
#define PG8_SCHED __builtin_amdgcn_sched_barrier(0)
    int one8 = 0x7f7f7f7f; asm volatile("" : "+v"(one8));
    Unit cur, nxt; int ui = 0;
    if (!S.next(0, cur)) return;
    f32x4 acc[2][2][4][2];
#pragma unroll
    for (int a = 0; a < 2; ++a)
#pragma unroll
        for (int b = 0; b < 2; ++b)
#pragma unroll
            for (int m = 0; m < 4; ++m)
#pragma unroll
                for (int n = 0; n < 2; ++n) acc[a][b][m][n] = (f32x4){0.f, 0.f, 0.f, 0.f};
    v8i At[4], B0[2], B1[2];
    const char* cA = S.aptr(cur); const char* cB = S.bptr(cur);
    PG8_STAGE(PG8_SB(0, 0), cB, voffB); PG8_STAGE(PG8_SB(0, 1), cB + hstepB, voffB); PG8_STAGE(PG8_SA(0, 0), cA, voffA); PG8_STAGE(PG8_SA(0, 1), cA + hstepA, voffA);
    if (wr == 1) PG8_BAR;
    PG8_WAIT_V(2); PG8_BAR;
    PG8_STAGE(PG8_SB(1, 0), cB + kstep, voffB); PG8_STAGE(PG8_SA(1, 0), cA + kstep, voffA); PG8_STAGE(PG8_SB(1, 1), cB + hstepB + kstep, voffB);
    PG8_WAIT_V(6); PG8_BAR;
    for (;;) {
        const bool has_next = S.next(ui + 1, nxt);
        const char* nA = has_next ? S.aptr(nxt) : cA; const char* nB = has_next ? S.bptr(nxt) : cB;
        for (int t = 0; t < nt; t += 2) {
            const bool last = (t == nt - 2);
            const char* a1p = cA + (size_t)(t + 1) * kstep;
            const char* a2 = last ? nA : cA + (size_t)(t + 2) * kstep; const char* b2 = last ? nB : cB + (size_t)(t + 2) * kstep;
            const char* a3 = a2 + kstep; const char* b3 = b2 + kstep;
            PG8_LDB(B0, 0, 0); PG8_LDB(B1, 0, 1); PG8_SCHED; PG8_LDA(At, 0, 0); PG8_STAGE(PG8_SA(1, 1), a1p + hstepA, voffA);
            PG8_WAIT_V(8); PG8_WAIT_L(0); PG8_BAR; if (t == 0) { PG8_MMA0(0, 0, At, B0); PG8_MMA0(0, 1, At, B1); } else { PG8_MMA(0, 0, At, B0); PG8_MMA(0, 1, At, B1); } PG8_BAR; PG8_SCHED;
            PG8_LDA(At, 0, 1); PG8_STAGE(PG8_SB(0, 0), b2, voffB); PG8_STAGE(PG8_SB(0, 1), b2 + hstepB, voffB); PG8_STAGE(PG8_SA(0, 0), a2, voffA);
            PG8_WAIT_V(8); PG8_WAIT_L(0); PG8_BAR; if (t == 0) { PG8_MMA0(1, 0, At, B0); PG8_MMA0(1, 1, At, B1); } else { PG8_MMA(1, 0, At, B0); PG8_MMA(1, 1, At, B1); } PG8_BAR; PG8_SCHED;
            PG8_LDB(B0, 1, 0); PG8_LDB(B1, 1, 1); PG8_SCHED; PG8_LDA(At, 1, 0); PG8_STAGE(PG8_SA(0, 1), a2 + hstepA, voffA);
            PG8_WAIT_V(8); PG8_WAIT_L(0); PG8_BAR; PG8_MMA(0, 0, At, B0); PG8_MMA(0, 1, At, B1); PG8_BAR; PG8_SCHED;
            PG8_LDA(At, 1, 1); PG8_STAGE(PG8_SB(1, 0), b3, voffB); PG8_STAGE(PG8_SB(1, 1), b3 + hstepB, voffB); PG8_STAGE(PG8_SA(1, 0), a3, voffA);
            PG8_WAIT_V(8); PG8_WAIT_L(0); PG8_BAR; PG8_MMA(1, 0, At, B0); PG8_MMA(1, 1, At, B1); PG8_BAR; PG8_SCHED;
        }
        if (wr == 0) PG8_BAR;
        asm volatile("s_nop 15\n\ts_nop 7" ::: "memory");
        epi_tile(E, acc, cur, wr, wc, fr, fq);
        if (!has_next) break;
        cur = nxt; cA = nA; cB = nB; ++ui;
        if (wr == 1) PG8_BAR;
    }
    PG8_WAIT_V(0);
    PG8_BAR;
#undef PG8_SA
#undef PG8_SB
#undef PG8_STAGE
#undef PG8_RD32
#undef PG8_LDA
#undef PG8_LDB
#undef PG8_MMA
#undef PG8_MMA0
#undef PG8_WAIT_V
#undef PG8_WAIT_L
#undef PG8_BAR
#undef PG8_SCHED
}
template <class Epi, class SchedT>
__device__ __forceinline__ void gemm_phase8g(LAS unsigned char* lds, const int K  , const unsigned char* Ag  , const int* srow, const SchedT& S, const Epi& E) {
    const int tid = threadIdx.x, wid = __builtin_amdgcn_readfirstlane(tid >> 6), lane = tid & 63, wr = wid >> 2, wc = wid & 3, fr = lane & 15, fq = lane >> 4;
    const int nt = K / 128;
    unsigned voffB[2];
#pragma unroll
    for (int i = 0; i < 2; ++i) { int R, Cb; stage_rc8(tid * 16 + i * 8192, R, Cb); const int Rb = (R & ~31) + perm32(R & 31); voffB[i] = (unsigned)(Rb * K + Cb); }
    const size_t kstep = 128;
    const size_t hstepB = (size_t)HALF * K;
    LAS int* itab = (LAS int*)(lds + LDSCTL_OFF + 4096);
#define PG8_GFILL(slot0, par) do { if (wid < 4) __builtin_amdgcn_global_load_lds((const unsigned*)(srow + (slot0) + wid * 64 + lane), (LAS unsigned*)(itab + (par) * 256 + wid * 64), 4, 0, 0); } while (0)
#define PG8_GOFFS(dst, par) do { int _t = tid; asm volatile("" : "+v"(_t)); int _R0, _Cb0; stage_rc8(_t * 16, _R0, _Cb0); \
        _Pragma("unroll") for (int _h = 0; _h < 2; ++_h) _Pragma("unroll") for (int _i = 0; _i < 2; ++_i) dst[_h][_i] = (unsigned)itab[(par) * 256 + _h * 128 + _i * 64 + _R0] * (unsigned)K + (unsigned)_Cb0; } while (0)
    const unsigned ldsw = (unsigned)wid * 1024u;
    const int a0 = lds_byte8(wr * 64 + fr, 32 * fq), a1 = lds_byte8(wr * 64 + fr, 32 * fq + 16), b0 = lds_byte8(wc * 32 + fr, 32 * fq), b1 = lds_byte8(wc * 32 + fr, 32 * fq + 16);
#define PG8_SA(b, h) (((b) * 2 + (h)) * HTB)
#define PG8_SB(b, h) ((4 + (b) * 2 + (h)) * HTB)
#define PG8_STAGE(bufoff, gbase, voff) do { _Pragma("unroll") for (int _i = 0; _i < 2; ++_i) \
        __builtin_amdgcn_global_load_lds((const unsigned*)((const char*)(gbase) + (voff)[_i]), (LAS unsigned*)(lds + (bufoff) + ldsw + _i * 8192), 16, 0, 0); } while (0)
#define PG8_RD32(o0, o1) __builtin_shufflevector(*(const LAS v4i*)(lds + (o0)), *(const LAS v4i*)(lds + (o1)), 0, 1, 2, 3, 4, 5, 6, 7)
#define PG8_LDA(dst, b, h) do { _Pragma("unroll") for (int m = 0; m < 4; ++m) dst[m] = PG8_RD32(PG8_SA(b, h) + a0 + m * 2048, PG8_SA(b, h) + a1 + m * 2048); } while (0)
#define PG8_LDB(dst, b, h) do { _Pragma("unroll") for (int n = 0; n < 2; ++n) dst[n] = PG8_RD32(PG8_SB(b, h) + b0 + n * 2048, PG8_SB(b, h) + b1 + n * 2048); } while (0)
#define PG8_MMA(ai, bj, At, Bt) do { __builtin_amdgcn_s_setprio(1); _Pragma("unroll") for (int m = 0; m < 4; ++m) _Pragma("unroll") for (int n = 0; n < 2; ++n) \
        asm volatile("v_mfma_scale_f32_16x16x128_f8f6f4 %0, %1, %2, %0, %3, %3 op_sel_hi:[0,0,0]" : "+v"(acc[ai][bj][m][n]) : "v"(Bt[n]), "v"(At[m]), "v"(one8)); __builtin_amdgcn_s_setprio(0); } while (0)
#define PG8_MMA0(ai, bj, At, Bt) do { __builtin_amdgcn_s_setprio(1); _Pragma("unroll") for (int m = 0; m < 4; ++m) _Pragma("unroll") for (int n = 0; n < 2; ++n) \
        asm volatile("v_mfma_scale_f32_16x16x128_f8f6f4 %0, %1, %2, 0, %3, %3 op_sel_hi:[0,0,0]" : "=&v"(acc[ai][bj][m][n]) : "v"(Bt[n]), "v"(At[m]), "v"(one8)); __builtin_amdgcn_s_setprio(0); } while (0)
#define PG8_WAIT_V(n) asm volatile("s_waitcnt vmcnt(" #n ")" ::: "memory")
#define PG8_WAIT_L(n) asm volatile("s_waitcnt lgkmcnt(" #n ")" ::: "memory")
#define PG8_BAR __builtin_amdgcn_s_barrier()
#define PG8_SCHED __builtin_amdgcn_sched_barrier(0)
    int one8 = 0x7f7f7f7f; asm volatile("" : "+v"(one8));
    Unit cur, nxt; int ui = 0;
    if (!S.next(0, cur)) return;
    f32x4 acc[2][2][4][2];
#pragma unroll
    for (int a = 0; a < 2; ++a)
#pragma unroll
        for (int b = 0; b < 2; ++b)
#pragma unroll
            for (int m = 0; m < 4; ++m)
#pragma unroll
                for (int n = 0; n < 2; ++n) acc[a][b][m][n] = (f32x4){0.f, 0.f, 0.f, 0.f};
    v8i At[4], B0[2], B1[2];
    const char* const A0 = (const char*)Ag; const char* cB = S.bptr(cur);
    unsigned coff[2][2];
    PG8_GFILL(cur.pm * 256, 0); PG8_WAIT_V(0); PG8_BAR;
    PG8_GOFFS(coff, 0);
    PG8_STAGE(PG8_SB(0, 0), cB, voffB); PG8_STAGE(PG8_SB(0, 1), cB + hstepB, voffB); PG8_STAGE(PG8_SA(0, 0), A0, coff[0]); PG8_STAGE(PG8_SA(0, 1), A0, coff[1]);
    if (wr == 1) PG8_BAR;
    PG8_WAIT_V(2); PG8_BAR;
    PG8_STAGE(PG8_SB(1, 0), cB + kstep, voffB); PG8_STAGE(PG8_SA(1, 0), A0 + kstep, coff[0]); PG8_STAGE(PG8_SB(1, 1), cB + hstepB + kstep, voffB);
    PG8_WAIT_V(6); PG8_BAR;
    for (;;) {
        const bool has_next = S.next(ui + 1, nxt);
        const char* nB = has_next ? S.bptr(nxt) : cB;
        if (has_next) PG8_GFILL(nxt.pm * 256, (ui + 1) & 1);
        for (int t = 0; t < nt; t += 2) {
            const bool last = (t == nt - 2);
            const char* a1p = A0 + (size_t)(t + 1) * kstep;
            const bool usen = last && has_next;
            const char* a2 = last ? A0 : A0 + (size_t)(t + 2) * kstep; const char* b2 = last ? nB : cB + (size_t)(t + 2) * kstep;
            const char* a3 = a2 + kstep; const char* b3 = b2 + kstep;
            PG8_LDB(B0, 0, 0); PG8_LDB(B1, 0, 1); PG8_SCHED; PG8_LDA(At, 0, 0); PG8_STAGE(PG8_SA(1, 1), a1p, coff[1]);
            if (usen) PG8_GOFFS(coff, (ui + 1) & 1);
            PG8_WAIT_V(8); PG8_WAIT_L(0); PG8_BAR; if (t == 0) { PG8_MMA0(0, 0, At, B0); PG8_MMA0(0, 1, At, B1); } else { PG8_MMA(0, 0, At, B0); PG8_MMA(0, 1, At, B1); } PG8_BAR; PG8_SCHED;
            PG8_LDA(At, 0, 1); PG8_STAGE(PG8_SB(0, 0), b2, voffB); PG8_STAGE(PG8_SB(0, 1), b2 + hstepB, voffB); PG8_STAGE(PG8_SA(0, 0), a2, coff[0]);
            PG8_WAIT_V(8); PG8_WAIT_L(0); PG8_BAR; if (t == 0) { PG8_MMA0(1, 0, At, B0); PG8_MMA0(1, 1, At, B1); } else { PG8_MMA(1, 0, At, B0); PG8_MMA(1, 1, At, B1); } PG8_BAR; PG8_SCHED;
            PG8_LDB(B0, 1, 0); PG8_LDB(B1, 1, 1); PG8_SCHED; PG8_LDA(At, 1, 0); PG8_STAGE(PG8_SA(0, 1), a2, coff[1]);
            PG8_WAIT_V(8); PG8_WAIT_L(0); PG8_BAR; PG8_MMA(0, 0, At, B0); PG8_MMA(0, 1, At, B1); PG8_BAR; PG8_SCHED;
            PG8_LDA(At, 1, 1); PG8_STAGE(PG8_SB(1, 0), b3, voffB); PG8_STAGE(PG8_SB(1, 1), b3 + hstepB, voffB); PG8_STAGE(PG8_SA(1, 0), a3, coff[0]);
            PG8_WAIT_V(8); PG8_WAIT_L(0); PG8_BAR; PG8_MMA(1, 0, At, B0); PG8_MMA(1, 1, At, B1); PG8_BAR; PG8_SCHED;
        }
        if (wr == 0) PG8_BAR;
        asm volatile("s_nop 15\n\ts_nop 7" ::: "memory");
        epi_tile(E, acc, cur, wr, wc, fr, fq);
        if (!has_next) break;
        cur = nxt; cB = nB; ++ui;
        if (wr == 1) PG8_BAR;
    }
    PG8_WAIT_V(0);
    PG8_BAR;
#undef PG8_GFILL
#undef PG8_GOFFS
#undef PG8_SA
#undef PG8_SB
#undef PG8_STAGE
#undef PG8_RD32
#undef PG8_LDA
#undef PG8_LDB
#undef PG8_MMA
#undef PG8_MMA0
#undef PG8_WAIT_V
#undef PG8_WAIT_L
#undef PG8_BAR
#undef PG8_SCHED
}
constexpr float F8_W13 = 32.0f, F8_W2 = 64.0f, F8_HID = 4.0f;
template <bool ROWRSTD> struct EpiSwigluF8 {
    static constexpr bool BATCH = false, HASPRE = true;
    const float* rstd; unsigned char* HID8;
    typedef typename PreRaw<ROWRSTD>::T Raw;
    __device__ __forceinline__ Raw pre_load(int row, int fq) const { if constexpr (ROWRSTD) return gload1_asm(rstd + row); else return gload4f_asm(rstd + (size_t)row * 16 + 4 * fq); }
    __device__ __forceinline__ float pre_fin(const Raw r, int fq) const { if constexpr (ROWRSTD) return r * (1.0f / F8_W13); else return rstd_fin(r) * (1.0f / F8_W13); }
    __device__ __forceinline__ void frag(int row, int pn, int wc, int fq, const float rs, const f32x4 a00, const f32x4 a01, const f32x4 a10, const f32x4 a11) const {
        const int col0 = pn * HALF + wc * 32 + 8 * fq;
        const float nrs = -1.4426950408889634f * rs, rs2 = rs * rs * F8_HID;
        f32x4 e0 = a00 * nrs, e1 = a01 * nrs;
#pragma unroll
        for (int j = 0; j < 4; ++j) { e0[j] = fast_exp2(e0[j]); e1[j] = fast_exp2(e1[j]); }
        e0 = e0 + 1.0f; e1 = e1 + 1.0f;
#pragma unroll
        for (int j = 0; j < 4; ++j) { e0[j] = fast_rcp(e0[j]); e1[j] = fast_rcp(e1[j]); }
        const f32x4 o0 = (a00 * a10) * (e0 * rs2), o1 = (a01 * a11) * (e1 * rs2);
        *(u32x2*)(HID8 + (size_t)row * FF + col0) = pack_fp8x8(o0[0], o0[1], o0[2], o0[3], o1[0], o1[1], o1[2], o1[3]);
    }
};
template <class Epi> __device__ __forceinline__ void meta_gemm(LAS unsigned char* red, const bf16_t* A, int lda, size_t a_pn_el, const bf16_t* Bt, int K, int N, const Epi& E, int G) {
    const int tid = threadIdx.x, wid = __builtin_amdgcn_readfirstlane(tid >> 6), lane = tid & 63, fr = lane & 15, fq = lane >> 4;
    for (int task = blockIdx.x; task < N / 64; task += G) {
        const int pn = task >> 2, wc = task & 3;
        const bf16_t* ap = A + (size_t)(MREAL + fr) * lda + a_pn_el * pn + 8 * fq;
        const bf16_t* bp = Bt + (size_t)(256 * pn + 32 * wc + 8 * (fr >> 2) + (fr & 3)) * K + 8 * fq;
        f32x4 acc[2][2];
#pragma unroll
        for (int bj = 0; bj < 2; ++bj)
#pragma unroll
            for (int n = 0; n < 2; ++n) acc[bj][n] = (f32x4){0.f, 0.f, 0.f, 0.f};
        const int nst = K / 256;
        for (int s0 = 0; s0 < nst; s0 += 4) {
            bf16x8 af[4], bfr[4][4];
#pragma unroll
            for (int t = 0; t < 4; ++t) if (s0 + t < nst) { const int kk = wid * nst + s0 + t;
                af[t] = *(const bf16x8*)(ap + 32 * kk);
#pragma unroll
                for (int bj = 0; bj < 2; ++bj)
#pragma unroll
                    for (int n = 0; n < 2; ++n) bfr[t][bj * 2 + n] = *(const bf16x8*)(bp + (size_t)(128 * bj + 4 * n) * K + 32 * kk); }
#pragma unroll
            for (int t = 0; t < 4; ++t) if (s0 + t < nst) {
#pragma unroll
                for (int bj = 0; bj < 2; ++bj)
#pragma unroll
                    for (int n = 0; n < 2; ++n) acc[bj][n] = __builtin_amdgcn_mfma_f32_16x16x32_bf16(bfr[t][bj * 2 + n], af[t], acc[bj][n], 0, 0, 0); }
        }
        LAS f32x4* r4 = (LAS f32x4*)red;
#pragma unroll
        for (int bj = 0; bj < 2; ++bj)
#pragma unroll
            for (int n = 0; n < 2; ++n) r4[(wid * 4 + bj * 2 + n) * 64 + lane] = acc[bj][n];
        __syncthreads();
        if (wid == 0) {
            f32x4 s0 = r4[lane], s1 = r4[64 + lane], s2 = r4[128 + lane], s3 = r4[192 + lane];
#pragma unroll
            for (int w = 1; w < 8; ++w) { s0 = s0 + r4[(w * 4) * 64 + lane]; s1 = s1 + r4[(w * 4 + 1) * 64 + lane]; s2 = s2 + r4[(w * 4 + 2) * 64 + lane]; s3 = s3 + r4[(w * 4 + 3) * 64 + lane]; }
            epi_frag(E, MREAL + fr, pn, wc, fq, s0, s1, s2, s3);
        }
        __syncthreads();
    }
}

template <class Epi> __device__ __forceinline__ void meta_gemm8(LAS unsigned char* red, const unsigned char* A, int lda, const unsigned char* Bt, int K, int N, const Epi& E, int G) {
    const int tid = threadIdx.x, wid = __builtin_amdgcn_readfirstlane(tid >> 6), lane = tid & 63, fr = lane & 15, fq = lane >> 4;
    int one8 = 0x7f7f7f7f; asm volatile("" : "+v"(one8));
    for (int task = blockIdx.x; task < N / 64; task += G) {
        const int pn = task >> 2, wc = task & 3;
        const unsigned char* ap = A + (size_t)(MREAL + fr) * lda + 32 * fq;
        const unsigned char* bp = Bt + (size_t)(256 * pn + 32 * wc + 8 * (fr >> 2) + (fr & 3)) * K + 32 * fq;
        f32x4 acc[2][2];
#pragma unroll
        for (int bj = 0; bj < 2; ++bj)
#pragma unroll
            for (int n = 0; n < 2; ++n) acc[bj][n] = (f32x4){0.f, 0.f, 0.f, 0.f};
        asm volatile("s_nop 7" ::: "memory");
        for (int kk = wid; kk < K / 128; kk += 8) {
            const v8i af = __builtin_shufflevector(*(const v4i*)(ap + 128 * kk), *(const v4i*)(ap + 128 * kk + 16), 0, 1, 2, 3, 4, 5, 6, 7);
            v8i bf[2][2];
#pragma unroll
            for (int bj = 0; bj < 2; ++bj)
#pragma unroll
                for (int n = 0; n < 2; ++n) { const unsigned char* q = bp + (size_t)(128 * bj + 4 * n) * K + 128 * kk; bf[bj][n] = __builtin_shufflevector(*(const v4i*)q, *(const v4i*)(q + 16), 0, 1, 2, 3, 4, 5, 6, 7); }
#pragma unroll
            for (int bj = 0; bj < 2; ++bj)
#pragma unroll
                for (int n = 0; n < 2; ++n) asm volatile("v_mfma_scale_f32_16x16x128_f8f6f4 %0, %1, %2, %0, %3, %3 op_sel_hi:[0,0,0]" : "+v"(acc[bj][n]) : "v"(bf[bj][n]), "v"(af), "v"(one8));
        }
        asm volatile("s_nop 15\n\ts_nop 7" ::: "memory");
        LAS f32x4* r4 = (LAS f32x4*)red;
#pragma unroll
        for (int bj = 0; bj < 2; ++bj)
#pragma unroll
            for (int n = 0; n < 2; ++n) r4[(wid * 4 + bj * 2 + n) * 64 + lane] = acc[bj][n];
        __syncthreads();
        if (wid == 0) {
            f32x4 s0 = r4[lane], s1 = r4[64 + lane], s2 = r4[128 + lane], s3 = r4[192 + lane];
#pragma unroll
            for (int w = 1; w < 8; ++w) { s0 = s0 + r4[(w * 4) * 64 + lane]; s1 = s1 + r4[(w * 4 + 1) * 64 + lane]; s2 = s2 + r4[(w * 4 + 2) * 64 + lane]; s3 = s3 + r4[(w * 4 + 3) * 64 + lane]; }
            epi_frag(E, MREAL + fr, pn, wc, fq, s0, s1, s2, s3);
        }
        __syncthreads();
    }
}
}

#define XB_TMO      128
#define XB_XCNT(j)  (256  + 64 * (j))
#define XB_XSUB(j)  (1280 + 64 * (j))
#define XB_XGEN(j)  (2304 + 64 * (j))
#define XB_TOP      3328
#define XB_TOPGEN   3392
#define XCD_BAR_WORDS 3456
#define XB_SPIN_CAP (1u << 18)
__device__ __forceinline__ unsigned xb_ld(unsigned* p)              { return __hip_atomic_load(p, __ATOMIC_RELAXED, __HIP_MEMORY_SCOPE_AGENT); }
__device__ __forceinline__ unsigned xb_add(unsigned* p, unsigned v) { return __hip_atomic_fetch_add(p, v, __ATOMIC_RELAXED, __HIP_MEMORY_SCOPE_AGENT); }
__device__ __forceinline__ unsigned xb_xcc_id() { return (unsigned)__builtin_amdgcn_s_getreg((3 << 11) | 20) & 0xFu; }
#define XB_SPIN(cond, bar) do { unsigned _sp = 0; while (cond) { __builtin_amdgcn_s_sleep(1); \
    if ((++_sp & 255u) == 0u) { if (xb_ld(&(bar)[XB_TMO])) break; if (_sp > XB_SPIN_CAP) { atomicAdd(&(bar)[XB_TMO], 1u); break; } } } } while (0)
struct XcdBarrier { unsigned* bar; unsigned x; volatile LAS unsigned* st; };
__device__ __forceinline__ XcdBarrier xcd_barrier_post(unsigned* bar, volatile LAS unsigned* st) {
    XcdBarrier b; b.bar = bar; b.x = xb_xcc_id(); b.st = st;
    if (threadIdx.x == 0) (void)xb_add(&bar[XB_XCNT(b.x)], 1u);
    return b;
}
__device__ __forceinline__ void xcd_barrier_complete(unsigned* bar, unsigned x, unsigned& nloc, unsigned& nx) {
    const unsigned G = gridDim.x * gridDim.y * gridDim.z;
    unsigned sum, cnt, mine, sp = 0u;
    for (;;) {
        sum = 0u; cnt = 0u; mine = 0u;
#pragma unroll
        for (unsigned j = 0; j < 16; ++j) { const unsigned c = xb_ld(&bar[XB_XCNT(j)]); sum += c; cnt += (c > 0u) ? 1u : 0u; mine = (j == x) ? c : mine; }
        if (sum == G) break;
        __builtin_amdgcn_s_sleep(1);
        if ((++sp & 255u) == 0u) { if (xb_ld(&bar[XB_TMO])) break; if (sp > XB_SPIN_CAP) { atomicAdd(&bar[XB_TMO], 1u); break; } }
    }
    nloc = mine > 0u ? mine : 1u; nx = cnt > 0u ? cnt : 1u;
}
__device__ __forceinline__ void xcd_barrier(const XcdBarrier& b) {
    asm volatile("s_waitcnt vmcnt(0)" ::: "memory");
    __syncthreads();
    if (threadIdx.x == 0) {
        unsigned* bar = b.bar;
        __builtin_amdgcn_s_waitcnt(0);
        unsigned nloc = b.st[0], nx = b.st[1];
        if (nloc == 0u) { xcd_barrier_complete(bar, b.x, nloc, nx); b.st[0] = nloc; b.st[1] = nx; }
        const unsigned old = xb_add(&bar[XB_XSUB(b.x)], 1u);
        const unsigned gen = old / nloc;
        if (old + 1u == (gen + 1u) * nloc) {
            __builtin_amdgcn_fence(__ATOMIC_RELEASE, "agent");
            asm volatile("s_waitcnt vmcnt(0)" ::: "memory");
            const unsigned og = xb_add(&bar[XB_TOP], 1u);
            const unsigned tg = og / nx;
            if (og + 1u == (tg + 1u) * nx) xb_add(&bar[XB_TOPGEN], 1u);
            else XB_SPIN(xb_ld(&bar[XB_TOPGEN]) == tg, bar);
            __builtin_amdgcn_fence(__ATOMIC_ACQUIRE, "agent");
            xb_add(&bar[XB_XGEN(b.x)], 1u);
            asm volatile("s_waitcnt vmcnt(0)" ::: "memory");
        } else {
            XB_SPIN(xb_ld(&bar[XB_XGEN(b.x)]) == gen, bar);
            __builtin_amdgcn_fence(__ATOMIC_ACQUIRE, "agent");
            asm volatile("s_waitcnt vmcnt(0)" ::: "memory");
        }
    }
    __syncthreads();
}

struct Args { const float* in[22]; float* out; unsigned char* ws; int ph_lo, ph_hi; };

template <int MAP> __device__ __forceinline__ int map_row(int n) {
    if (MAP == 1) { const int i = n & 127; return (n & ~127) + 2 * (i & 63) + (i >> 6); }
    if (MAP == 2) return (n >> 7) * 256 + (n & 127);
    if (MAP == 3) return (n >> 7) * 256 + 128 + (n & 127);
    return n;
}
template <int MAP> __device__ __forceinline__ void wt_item(const float* W, int K, int ldw, int N, bf16_t* WT, const float* gain, LAS float* scr, int item, int lane) {
    const int nblk = N / 32, kb = item / nblk, nb = item % nblk, k0 = 64 * kb, n0 = 32 * nb;
    { f32x4 v[8]; float gv[8];
#pragma unroll
      for (int i = 0; i < 8; ++i) { const int kk = 8 * i + (lane >> 3); v[i] = *(const f32x4*)(W + (size_t)(k0 + kk) * ldw + n0 + 4 * (lane & 7)); gv[i] = gain ? gain[k0 + kk] : 1.0f; }
#pragma unroll
      for (int i = 0; i < 8; ++i) { const int kk = 8 * i + (lane >> 3); LAS float* d = scr + kk * 33 + 4 * (lane & 7); d[0] = v[i][0] * gv[i]; d[1] = v[i][1] * gv[i]; d[2] = v[i][2] * gv[i]; d[3] = v[i][3] * gv[i]; } }
    LDS_WAIT(); asm volatile("" ::: "memory");
    const int c = lane & 7;
#pragma unroll
    for (int j = 0; j < 4; ++j) { const int n = (lane >> 3) + 8 * j; const LAS float* s = scr + (8 * c) * 33 + n;
        u32x4 o; o.x = pk2(s[0 * 33], s[1 * 33]); o.y = pk2(s[2 * 33], s[3 * 33]); o.z = pk2(s[4 * 33], s[5 * 33]); o.w = pk2(s[6 * 33], s[7 * 33]);
        *(u32x4*)(WT + (size_t)map_row<MAP>(n0 + n) * K + k0 + 8 * c) = o; }
    LDS_WAIT(); asm volatile("" ::: "memory");
}
template <int MAP> __device__ __forceinline__ void wt_item8(const float* W, int K, int ldw, int N, unsigned char* WT, const float* gain, float scale, LAS float* scr, int item, int lane) {
    const int nblk = N / 32, kb = item / nblk, nb = item % nblk, k0 = 64 * kb, n0 = 32 * nb;
    { f32x4 v[8]; float gv[8];
#pragma unroll
      for (int i = 0; i < 8; ++i) { const int kk = 8 * i + (lane >> 3); v[i] = *(const f32x4*)(W + (size_t)(k0 + kk) * ldw + n0 + 4 * (lane & 7)); gv[i] = (gain ? gain[k0 + kk] : 1.0f) * scale; }
#pragma unroll
      for (int i = 0; i < 8; ++i) { const int kk = 8 * i + (lane >> 3); LAS float* d = scr + kk * 33 + 4 * (lane & 7); d[0] = v[i][0] * gv[i]; d[1] = v[i][1] * gv[i]; d[2] = v[i][2] * gv[i]; d[3] = v[i][3] * gv[i]; } }
    LDS_WAIT(); asm volatile("" ::: "memory");
    const int c = lane & 7;
#pragma unroll
    for (int j = 0; j < 4; ++j) { const int n = (lane >> 3) + 8 * j; const LAS float* sp = scr + (8 * c) * 33 + n;
        *(u32x2*)(WT + (size_t)map_row<MAP>(n0 + n) * K + k0 + 8 * c) = pg8::pack_fp8x8(sp[0 * 33], sp[1 * 33], sp[2 * 33], sp[3 * 33], sp[4 * 33], sp[5 * 33], sp[6 * 33], sp[7 * 33]); }
    LDS_WAIT(); asm volatile("" ::: "memory");
}
template <int MAP> __device__ __forceinline__ void wt_matrix8(const float* W, int K, int ldw, int N, unsigned char* WT, const float* gain, float scale, LAS float* scr, int gw, int NGW, int lane) {
    const int nitems = (K / 64) * (N / 32);
    for (int it = gw; it < nitems; it += NGW) wt_item8<MAP>(W, K, ldw, N, WT, gain, scale, scr, it, lane);
}
template <int MAP> __device__ __forceinline__ void wt_matrix(const float* W, int K, int ldw, int N, bf16_t* WT, const float* gain, LAS float* scr, int gw, int NGW, int lane) {
    const int nitems = (K / 64) * (N / 32);
    for (int it = gw; it < nitems; it += NGW) wt_item<MAP>(W, K, ldw, N, WT, gain, scr, it, lane);
}

enum Phase { P_PRO = 0,
    P0_QKVG, P0_RET, P0_FIN, P0_WO, P0_W13, P0_W2,
    P1_QKV, P1_SB, P1_WO, P1_RA, P1_RB, P1_M13, P1_M2, P1_CMB,
    P2_PREP, P2_POOL, P2_W13, P2_W2,
    P3_QKVG, P3_RET, P3_FIN, P3_WO, P3_RA, P3_RB, P3_M13, P3_M2, P3_CMB,
    P_FINAL, P_COUNT };

struct Ctx {
    LAS unsigned char* lds; int tid, lane, wave, G, gw, NGW;
    const float* const* in; float* out; unsigned char* ws;
    bf16_t* H; float* ssq; float* gst; bf16_t* WA; bf16_t* WB; unsigned char* pool; unsigned char* misc; f32x2* tab; int* moe;
};

__device__ __forceinline__ void conv_ret(const Ctx& C, int j, int layer, bf16_t* mix, bf16_t* wo) {
    LAS float* scr = (LAS float*)(C.lds + C.wave * 16384);
    const float* g = C.in[2] + (size_t)layer * D;
    wt_matrix<1>(C.in[4] + (size_t)j * D * D, D, D, D, mix, g, scr, C.gw, C.NGW, C.lane);
    wt_matrix<1>(C.in[5] + (size_t)j * D * D, D, D, D, mix + (size_t)1024 * D, g, scr, C.gw, C.NGW, C.lane);
    wt_matrix<0>(C.in[6] + (size_t)j * D * 2 * D, D, 2 * D, 2 * D, mix + (size_t)2048 * D, g, scr, C.gw, C.NGW, C.lane);
    wt_matrix<0>(C.in[7] + (size_t)j * D * 2 * D, D, 2 * D, 2 * D, mix + (size_t)4096 * D, g, scr, C.gw, C.NGW, C.lane);
    wt_matrix<0>(C.in[8] + (size_t)j * 2 * D * D, 2 * D, D, D, wo, nullptr, scr, C.gw, C.NGW, C.lane);
}
constexpr float F8_WP = 32.0f, F8_WO = 32.0f, F8_A2 = 8.0f;
__device__ __forceinline__ void conv_ret8(const Ctx& C, int j, int layer, bf16_t* mix_, bf16_t* wo_) {
    LAS float* scr = (LAS float*)(C.lds + C.wave * 16384);
    const float* g = C.in[2] + (size_t)layer * D;
    unsigned char* mix = (unsigned char*)mix_; unsigned char* wo = (unsigned char*)wo_;
    wt_matrix8<1>(C.in[4] + (size_t)j * D * D, D, D, D, mix, g, F8_WP, scr, C.gw, C.NGW, C.lane);
    wt_matrix8<1>(C.in[5] + (size_t)j * D * D, D, D, D, mix + (size_t)1024 * D, g, F8_WP, scr, C.gw, C.NGW, C.lane);
    wt_matrix8<0>(C.in[6] + (size_t)j * D * 2 * D, D, 2 * D, 2 * D, mix + (size_t)2048 * D, g, F8_WP, scr, C.gw, C.NGW, C.lane);
    wt_matrix8<0>(C.in[7] + (size_t)j * D * 2 * D, D, 2 * D, 2 * D, mix + (size_t)4096 * D, g, F8_WP, scr, C.gw, C.NGW, C.lane);
    wt_matrix8<0>(C.in[8] + (size_t)j * 2 * D * D, 2 * D, D, D, wo, nullptr, F8_WO, scr, C.gw, C.NGW, C.lane);
}
__device__ __forceinline__ void conv_dense(const Ctx& C, int c, int layer, bf16_t* w13_, bf16_t* w2_) {
    LAS float* scr = (LAS float*)(C.lds + C.wave * 16384);
    const float* g = C.in[3] + (size_t)layer * D;
    unsigned char* w13 = (unsigned char*)w13_; unsigned char* w2 = (unsigned char*)w2_;
    wt_matrix8<2>(C.in[14] + (size_t)c * D * FF, D, FF, FF, w13, g, pg8::F8_W13, scr, C.gw, C.NGW, C.lane);
    wt_matrix8<3>(C.in[15] + (size_t)c * D * FF, D, FF, FF, w13, g, pg8::F8_W13, scr, C.gw, C.NGW, C.lane);
    wt_matrix8<0>(C.in[16] + (size_t)c * FF * D, FF, D, D, w2, nullptr, pg8::F8_W2, scr, C.gw, C.NGW, C.lane);
}
__device__ __forceinline__ void conv_dense_bf16(const Ctx& C, int c, int layer, bf16_t* w13, bf16_t* w2) {
    LAS float* scr = (LAS float*)(C.lds + C.wave * 16384);
    const float* g = C.in[3] + (size_t)layer * D;
    wt_matrix<2>(C.in[14] + (size_t)c * D * FF, D, FF, FF, w13, g, scr, C.gw, C.NGW, C.lane);
    wt_matrix<3>(C.in[15] + (size_t)c * D * FF, D, FF, FF, w13, g, scr, C.gw, C.NGW, C.lane);
    wt_matrix<0>(C.in[16] + (size_t)c * FF * D, FF, D, D, w2, nullptr, scr, C.gw, C.NGW, C.lane);
}
__device__ __forceinline__ void conv_moe(const Ctx& C, int c, int layer, bf16_t* w13_, bf16_t* w2_) {
    LAS float* scr = (LAS float*)(C.lds + C.wave * 16384);
    const float* g = C.in[3] + (size_t)layer * D;
    unsigned char* w13 = (unsigned char*)w13_; unsigned char* w2 = (unsigned char*)w2_;
    for (int e = 0; e < NE; ++e) {
        wt_matrix8<2>(C.in[18] + ((size_t)c * NE + e) * D * FF, D, FF, FF, w13 + (size_t)e * 5632 * D, g, pg8::F8_W13, scr, C.gw, C.NGW, C.lane);
        wt_matrix8<3>(C.in[19] + ((size_t)c * NE + e) * D * FF, D, FF, FF, w13 + (size_t)e * 5632 * D, g, pg8::F8_W13, scr, C.gw, C.NGW, C.lane);
        wt_matrix8<0>(C.in[20] + ((size_t)c * NE + e) * FF * D, FF, D, D, w2 + (size_t)e * D * FF, nullptr, pg8::F8_W2, scr, C.gw, C.NGW, C.lane);
    }
}

template <class Epi> __device__ __forceinline__ void run_dense(const Ctx& C, const bf16_t* A, int lda, size_t a_pn_bytes, const bf16_t* Bt, int K, int N, const Epi& E) {
#if PROBE_GROUP == 60
    const unsigned long long _pt0 = __builtin_amdgcn_s_memrealtime();
#endif
    pg8::meta_gemm(C.lds, A, lda, a_pn_bytes / 2, Bt, K, N, E, C.G);
#if PROBE_GROUP == 60
    asm volatile("s_waitcnt vmcnt(0)" ::: "memory"); if (blockIdx.x == 0 && C.tid == 0) *(LAS unsigned long long*)(C.lds + LDSCTL_OFF + 8192) += __builtin_amdgcn_s_memrealtime() - _pt0;
#endif
    pg8::Sched<false> S; S.nM = MREAL / 256; S.nN = N / 256; S.nwg = S.nM * S.nN; S.G = C.G; S.c = (int)blockIdx.x;
    S.A = (const char*)A; S.Bt = (const char*)Bt; S.a_pm = (size_t)256 * lda * 2; S.a_pn = a_pn_bytes; S.b_pn = (size_t)256 * K * 2; S.b_e = 0; S.pexp = nullptr;
    pg8::gemm_phase(C.lds, K, lda, S, E);
}
template <class Epi> __device__ __forceinline__ void run_dense8(const Ctx& C, const unsigned char* A, int lda, const unsigned char* Bt, int K, int N, const Epi& E) {
#if PROBE_GROUP == 60
    const unsigned long long _pt0 = __builtin_amdgcn_s_memrealtime();
#endif
    pg8::meta_gemm8(C.lds, A, lda, Bt, K, N, E, C.G);
#if PROBE_GROUP == 60
    asm volatile("s_waitcnt vmcnt(0)" ::: "memory"); if (blockIdx.x == 0 && C.tid == 0) *(LAS unsigned long long*)(C.lds + LDSCTL_OFF + 8192) += __builtin_amdgcn_s_memrealtime() - _pt0;
#endif
    pg8::Sched<false> S; S.nM = MREAL / 256; S.nN = N / 256; S.nwg = S.nM * S.nN; S.G = C.G; S.c = (int)blockIdx.x;
    S.A = (const char*)A; S.Bt = (const char*)Bt; S.a_pm = (size_t)256 * lda; S.a_pn = 0; S.b_pn = (size_t)256 * K; S.b_e = 0; S.pexp = nullptr;
    pg8::gemm_phase8(C.lds, K, lda, S, E);
}
template <class Epi> __device__ __forceinline__ void run_moe(const Ctx& C, const int* seg, const bf16_t* A, const bf16_t* Bt, size_t b_e_bytes, int K, int N, const Epi& E) {
    LAS int* pexp = (LAS int*)(C.lds + LDS_PEXP);
    const int total = seg[8] / 256;
    for (int p = C.tid; p < total; p += 512) { int e = 0;
#pragma unroll
        for (int j = 1; j < 8; ++j) e += (p * 256 >= seg[j]) ? 1 : 0;
        pexp[p] = e; }
    __syncthreads();
    pg8::Sched<true> S; S.nM = total; S.nN = N / 256; S.nwg = S.nM * S.nN; S.G = C.G; S.c = (int)blockIdx.x;
    S.A = (const char*)A; S.Bt = (const char*)Bt; S.a_pm = (size_t)256 * K * 2; S.a_pn = 0; S.b_pn = (size_t)256 * K * 2; S.b_e = b_e_bytes; S.pexp = pexp;
    pg8::gemm_phase(C.lds, K, K, S, E);
    __syncthreads();
}

template <class Epi> __device__ __forceinline__ void run_moe8(const Ctx& C, const int* seg, const unsigned char* A, const unsigned char* Bt, size_t b_e_bytes, int K, int N, const Epi& E, const int* srow = nullptr) {
    LAS int* pexp = (LAS int*)(C.lds + LDS_PEXP);
    const int total = seg[8] / 256;
    for (int p = C.tid; p < total; p += 512) { int e = 0;
#pragma unroll
        for (int j = 1; j < 8; ++j) e += (p * 256 >= seg[j]) ? 1 : 0;
        pexp[p] = e; }
    __syncthreads();
    pg8::Sched<true> S; S.nM = total; S.nN = N / 256; S.nwg = S.nM * S.nN; S.G = C.G; S.c = (int)blockIdx.x;
    S.A = (const char*)A; S.Bt = (const char*)Bt; S.a_pm = (size_t)256 * K; S.a_pn = 0; S.b_pn = (size_t)256 * K; S.b_e = b_e_bytes; S.pexp = pexp;
    if (srow) pg8::gemm_phase8g(C.lds, K, A, srow, S, E); else pg8::gemm_phase8(C.lds, K, K, S, E);
    __syncthreads();
}
__device__ __forceinline__ void ret_finalize(const Ctx& C, int j, const bf16_t* Y, const bf16_t* YM, bf16_t* Gt, const float* gst, unsigned char* A8 = nullptr) {
    const float* gn = C.in[9] + (size_t)j * 2 * D;
    for (int row = C.gw; row < MVALID; row += C.NGW) {
        const bf16_t* yrow = row < MREAL ? Y + (size_t)row * 2048 : YM + (size_t)(row - MREAL) * 2048;
        u32x4 yv[4], gv[4]; f32x4 ga[4], gb[4];
#pragma unroll
        for (int q = 0; q < 4; ++q) { const int col = q * 512 + C.lane * 8, h = col >> 8;
            yv[q] = *(const u32x4*)(yrow + col); gv[q] = *(const u32x4*)(Gt + (size_t)row * 2048 + col);
            ga[q] = *(const f32x4*)(gst + ((size_t)row * 8 + h) * 8); gb[q] = *(const f32x4*)(gst + ((size_t)row * 8 + h) * 8 + 4); }
#pragma unroll
        for (int q = 0; q < 4; ++q) {
            const int col = q * 512 + C.lane * 8;
            const float s1 = (ga[q][0] + ga[q][2]) + (gb[q][0] + gb[q][2]), s2 = (ga[q][1] + ga[q][3]) + (gb[q][1] + gb[q][3]);
            const float mu = s1 * (1.0f / 256.0f); const float var = fmaxf(s2 * (1.0f / 256.0f) - mu * mu, 0.f); const float rs = __builtin_amdgcn_rsqf(var + EPS);
            const f32x4 g0 = *(const f32x4*)(gn + col) * rs, g1 = *(const f32x4*)(gn + col + 4) * rs;
            if (A8) {
                *(u32x2*)(A8 + (size_t)row * 2048 + col) = pg8::pack_fp8x8(
                    F8_A2 * bflo(gv[q].x) * (bflo(yv[q].x) - mu) * g0[0], F8_A2 * bfhi(gv[q].x) * (bfhi(yv[q].x) - mu) * g0[1], F8_A2 * bflo(gv[q].y) * (bflo(yv[q].y) - mu) * g0[2], F8_A2 * bfhi(gv[q].y) * (bfhi(yv[q].y) - mu) * g0[3],
                    F8_A2 * bflo(gv[q].z) * (bflo(yv[q].z) - mu) * g1[0], F8_A2 * bfhi(gv[q].z) * (bfhi(yv[q].z) - mu) * g1[1], F8_A2 * bflo(gv[q].w) * (bflo(yv[q].w) - mu) * g1[2], F8_A2 * bfhi(gv[q].w) * (bfhi(yv[q].w) - mu) * g1[3]);
                continue;
            }
            u32x4 w;
            w.x = pk2(bflo(gv[q].x) * (bflo(yv[q].x) - mu) * g0[0], bfhi(gv[q].x) * (bfhi(yv[q].x) - mu) * g0[1]);
            w.y = pk2(bflo(gv[q].y) * (bflo(yv[q].y) - mu) * g0[2], bfhi(gv[q].y) * (bfhi(yv[q].y) - mu) * g0[3]);
            w.z = pk2(bflo(gv[q].z) * (bflo(yv[q].z) - mu) * g1[0], bfhi(gv[q].z) * (bfhi(yv[q].z) - mu) * g1[1]);
            w.w = pk2(bflo(gv[q].w) * (bflo(yv[q].w) - mu) * g1[2], bfhi(gv[q].w) * (bfhi(yv[q].w) - mu) * g1[3]);
            *(u32x4*)(Gt + (size_t)row * 2048 + col) = w;
        }
    }
}

__device__ __forceinline__ void ret_naive(const Ctx& C, const bf16_t* Q, const bf16_t* Kk, bf16_t* V, bf16_t* YM, float* gst) {
    for (int item = blockIdx.x; item < NBATCH * 8 * 2; item += C.G) {
        const int half = item & 1, h = (item >> 1) & 7, b = item >> 4;
        if (C.tid < 128) {
            const int e = half * 128 + C.tid;
            const float gamma = 1.0f - exp2f(-5.0f - (float)h);
            float S[128];
#pragma unroll
            for (int d = 0; d < 128; ++d) S[d] = 0.f;
            for (int p = 0; p < LPOS; ++p) {
                const int row = pos_row(b, p);
                const u32x4* qp = (const u32x4*)(Q + (size_t)row * D + h * 128);
                const u32x4* kp = (const u32x4*)(Kk + (size_t)row * D + h * 128);
                bf16_t* vp = V + (size_t)row * 2048 + h * 256 + e;
                const float v = bf1(*vp);
                float y = 0.f;
#pragma unroll
                for (int jj = 0; jj < 16; ++jj) {
                    const u32x4 kq = kp[jj], qq = qp[jj];
                    const unsigned kw[4] = {kq.x, kq.y, kq.z, kq.w}, qw[4] = {qq.x, qq.y, qq.z, qq.w};
#pragma unroll
                    for (int i = 0; i < 4; ++i) {
                        S[8 * jj + 2 * i] = gamma * S[8 * jj + 2 * i] + bflo(kw[i]) * v; y += bflo(qw[i]) * S[8 * jj + 2 * i];
                        S[8 * jj + 2 * i + 1] = gamma * S[8 * jj + 2 * i + 1] + bfhi(kw[i]) * v; y += bfhi(qw[i]) * S[8 * jj + 2 * i + 1];
                    }
                }
                if (p >= NMETA || b == 0) {
                    if (p >= NMETA) *vp = (bf16_t)f2bf(y); else YM[(size_t)p * 2048 + h * 256 + e] = (bf16_t)f2bf(y);
                    const float s1 = wave_sum(y), s2 = wave_sum(y * y);
                    if (C.lane == 0) { *(f32x2*)(gst + ((size_t)row * 8 + h) * 8 + (half * 2 + C.wave) * 2) = (f32x2){s1, s2}; }
                }
            }
        }
    }
}


__device__ __forceinline__ void glds16(const void* gsrc, unsigned lds_dst) { unsigned keep;
    asm volatile("s_mov_b32 %0, m0\n\ts_mov_b32 m0, %2\n\ts_nop 0\n\tglobal_load_lds_dwordx4 %1, off\n\ts_mov_b32 m0, %0" : "=&s"(keep) : "v"(gsrc), "s"(lds_dst) : "memory"); }
__device__ __forceinline__ void gstore8_asm(void* p, u32x2 v) { asm volatile("global_store_dwordx2 %0, %1, off" :: "v"(p), "v"(v) : "memory"); }
__device__ __forceinline__ void gstore16_asm(void* p, f32x4 v) { asm volatile("global_store_dwordx4 %0, %1, off\n\ts_nop 1" :: "v"(p), "v"(v) : "memory"); }
namespace retm {
typedef float f32x16 __attribute__((ext_vector_type(16)));
typedef short s16x4 __attribute__((ext_vector_type(4)));
typedef short v4i16_t __attribute__((ext_vector_type(4)));
constexpr int L_KROW = 0, L_KTR = 32768, L_V = 65536, L_ST = 98304;
__device__ __forceinline__ int crow(int r, int hi) { return (r & 3) + 8 * (r >> 2) + 4 * hi; }
__device__ __forceinline__ s16x4 vtr(const LAS unsigned char* p) { return __builtin_bit_cast(s16x4, __builtin_amdgcn_ds_read_tr16_b64_v4i16((LAS v4i16_t*)p)); }
__device__ __forceinline__ float partner32(float x, int hi) { auto rr = __builtin_amdgcn_permlane32_swap(__float_as_uint(x), __float_as_uint(x), false, false); return __uint_as_float(hi ? rr[0] : rr[1]); }
__device__ __forceinline__ int grow(int b, int i, int j) { return i == 0 ? (j >= 112 ? MREAL + (j - 112) : MVALID) : b * SEQ + (i - 1) * 128 + j; }
__device__ __forceinline__ bf16x8 pack8(const f32x16& v, int o) { u32x4 a; a.x = pk2(v[o], v[o + 1]); a.y = pk2(v[o + 2], v[o + 3]); a.z = pk2(v[o + 4], v[o + 5]); a.w = pk2(v[o + 6], v[o + 7]); return __builtin_bit_cast(bf16x8, a); }
__device__ __forceinline__ bf16x8 trfrag(const LAS unsigned char* p) { const s16x4 a = vtr(p), c = vtr(p + 512); return (bf16x8){a[0], a[1], a[2], a[3], c[0], c[1], c[2], c[3]}; }

__device__ __forceinline__ void stats_flush(const LAS float* st, int b, int h, int half, int i, float* gst, int tid) {
    if (tid < 128) {
        const int j = tid; const bool ok = (i > 0) || (j >= 112 && b == 0);
        if (ok) { const int row = grow(b, i, j);
            const LAS f32x2* p = (const LAS f32x2*)(st + j * 8);
            const f32x2 a = p[0], c = p[1], d = p[2], e = p[3];
            *(f32x4*)(gst + ((size_t)row * 8 + h) * 8 + half * 4) = (f32x4){a[0] + c[0], a[1] + c[1], d[0] + e[0], d[1] + e[1]}; }
    }
}

constexpr int STAGE = 49152, S_K = 0, S_Q = 16384, S_V = 32768;
constexpr int L_ST2 = LDSCTL_OFF + 2048;

__device__ __forceinline__ void stats_flush64(const LAS float* st, int b, int h, int half, int j, float* gst, int tid) {
    if (tid < 64) {
        const int i = j >> 1, jr = 64 * (j & 1) + tid; const bool ok = (i > 0) || (jr >= 112 && b == 0);
        if (ok) { const int row = grow(b, i, jr);
            const LAS f32x2* p = (const LAS f32x2*)(st + tid * 8);
            const f32x2 a = p[0], c = p[1], d = p[2], e = p[3];
            gstore16_asm(gst + ((size_t)row * 8 + h) * 8 + half * 4, (f32x4){a[0] + c[0], a[1] + c[1], d[0] + e[0], d[1] + e[1]}); }
    }
}

__device__ __forceinline__ void ret_item(LAS unsigned char* lds, int b, int h, int half, const bf16_t* Q, const bf16_t* K, bf16_t* V, bf16_t* YM, float* gst, int wid, int lane, int tid) {
    const int r32 = lane & 31, hi = lane >> 5, et = wid & 3, cbl = wid >> 2;
    const float gamma = 1.0f - exp2f(-5.0f - (float)h); const float g128 = exp2f(128.0f * log2f(gamma));
    f32x16 T[4];
#pragma unroll
    for (int d = 0; d < 4; ++d) T[d] = (f32x16){};
    LAS float* st = (LAS float*)(lds + L_ST2);
    const unsigned lds0 = (unsigned)(size_t)lds;
    const int trq = (lane & 15) >> 2, trp = lane & 3, trb = (lane >> 4) & 1;
    const int troff = (4 * hi + trq) * 64 + trb * 32 + trp * 8;
    const int trp2 = ((trp & 1) << 1) | (trp >> 1);
    const int ktr_ch = 2 * trb + (trp2 >> 1);
    const int ktr_lane = ktr_ch * 1024 + (trp2 & 1) * 8;
    const int ktr_r0 = ((4 * hi + trq) ^ (4 * ktr_ch)) * 16, ktr_r1 = ((4 * hi + 8 + trq) ^ (4 * ktr_ch)) * 16;
    const int krA = hi * 1024 + (r32 ^ (4 * hi)) * 16, krB = hi * 1024 + (r32 ^ (8 + 4 * hi)) * 16;
    const int qro = hi * 1024 + (32 * cbl + r32) * 16;
    const int vrow = lane >> 2;
#define RET_DMA(jj, stg) do { const int _i = (jj) >> 1, _r0 = 64 * ((jj) & 1); const unsigned _base = lds0 + (stg) * STAGE; \
        _Pragma("unroll") for (int u = 0; u < 2; ++u) { const int pc = wid * 2 + u; \
            { const int rowk = grow(b, _i, _r0 + (lane ^ (4 * (pc & 3)))); glds16(K + (size_t)rowk * D + h * 128 + pc * 8, (unsigned)__builtin_amdgcn_readfirstlane(_base + S_K + pc * 1024)); } \
            { const int rowq = grow(b, _i, _r0 + lane); glds16(Q + (size_t)rowq * D + h * 128 + pc * 8, (unsigned)__builtin_amdgcn_readfirstlane(_base + S_Q + pc * 1024)); } \
            { const int rowv = grow(b, _i, _r0 + (pc & 3) * 16 + vrow); glds16(V + (size_t)rowv * 2048 + h * 256 + half * 128 + (pc >> 2) * 32 + (lane & 3) * 8, (unsigned)__builtin_amdgcn_readfirstlane(_base + S_V + pc * 1024)); } } } while (0)
    const bf16_t* kpt[2]; const bf16_t* qpt[2]; const bf16_t* vpt[2];
#pragma unroll
    for (int u = 0; u < 2; ++u) { const int pc = wid * 2 + u;
        kpt[u] = K + (size_t)(b * SEQ + (lane ^ (4 * (pc & 3)))) * D + h * 128 + pc * 8;
        qpt[u] = Q + (size_t)(b * SEQ + lane) * D + h * 128 + pc * 8;
        vpt[u] = V + (size_t)(b * SEQ + (pc & 3) * 16 + vrow) * 2048 + h * 256 + half * 128 + (pc >> 2) * 32 + (lane & 3) * 8; }
#define RET_DMA_FAST(stg) do { const unsigned _base = lds0 + (stg) * STAGE; \
        _Pragma("unroll") for (int u = 0; u < 2; ++u) { const int pc = wid * 2 + u; \
            glds16(kpt[u], (unsigned)__builtin_amdgcn_readfirstlane(_base + S_K + pc * 1024)); glds16(qpt[u], (unsigned)__builtin_amdgcn_readfirstlane(_base + S_Q + pc * 1024)); \
            glds16(vpt[u], (unsigned)__builtin_amdgcn_readfirstlane(_base + S_V + pc * 1024)); \
            kpt[u] += (size_t)64 * D; qpt[u] += (size_t)64 * D; vpt[u] += (size_t)64 * 2048; } } while (0)
    __builtin_amdgcn_s_waitcnt(0);
    RET_DMA(1, 1); RET_DMA_FAST(2);
    for (int j = 1; j < 34; ++j) {
#if PROBE_GROUP == 10 || PROBE_GROUP == 11
        const unsigned long long _pt0 = __builtin_amdgcn_s_memrealtime();
#endif
        if (j < 33) asm volatile("s_waitcnt vmcnt(6) lgkmcnt(0)" ::: "memory"); else asm volatile("s_waitcnt vmcnt(0) lgkmcnt(0)" ::: "memory");
        __builtin_amdgcn_s_barrier(); asm volatile("" ::: "memory");
#if PROBE_GROUP == 10
        if (blockIdx.x == 0 && tid == 0) *(LAS unsigned long long*)(lds + LDSCTL_OFF + 8192) += __builtin_amdgcn_s_memrealtime() - _pt0;
#endif
#if PROBE_GROUP == 11
        if (blockIdx.x == 0 && tid == 256) *(LAS unsigned long long*)(lds + LDSCTL_OFF + 8192) += __builtin_amdgcn_s_memrealtime() - _pt0;
#endif
        if (j > 1) stats_flush64(st, b, h, half, j - 1, gst, tid);
        const LAS unsigned char* sb_ = lds + (j % 3) * STAGE;
        const int i = j >> 1, hh = j & 1;
        if (hh == 0) {
#pragma unroll
            for (int d = 0; d < 4; ++d) T[d] *= g128;
        }
        bf16x8 qf[8];
#pragma unroll
        for (int ks = 0; ks < 8; ++ks) qf[ks] = *(const LAS bf16x8*)(sb_ + S_Q + (2 * ks) * 1024 + qro);
        __builtin_amdgcn_sched_barrier(0);
        f32x16 yT = {};
#pragma unroll
        for (int db = 0; db < 4; ++db) {
            yT = __builtin_amdgcn_mfma_f32_32x32x16_bf16(pack8(T[db], 0), qf[2 * db], yT, 0, 0, 0);
            yT = __builtin_amdgcn_mfma_f32_32x32x16_bf16(pack8(T[db], 8), qf[2 * db + 1], yT, 0, 0, 0);
        }
        for (int sb = 0; sb <= cbl; ++sb) {
            f32x16 sc = {};
            bf16x8 kfr[8];
#pragma unroll
            for (int ks = 0; ks < 8; ++ks) kfr[ks] = *(const LAS bf16x8*)(sb_ + S_K + sb * 512 + (2 * ks) * 1024 + ((ks & 1) ? krB : krA));
            const LAS unsigned char* vb = sb_ + S_V + et * 4096 + (32 * sb) * 64 + troff;
            const bf16x8 vf0 = trfrag(vb), vf1 = trfrag(vb + 1024);
            __builtin_amdgcn_sched_barrier(0);
#pragma unroll
            for (int ks = 0; ks < 8; ++ks) sc = __builtin_amdgcn_mfma_f32_32x32x16_bf16(kfr[ks], qf[ks], sc, 0, 0, 0);
            if (sb == cbl) {
#pragma unroll
                for (int r = 0; r < 16; ++r) if (crow(r, hi) > r32) sc[r] = 0.f;
            }
            yT = __builtin_amdgcn_mfma_f32_32x32x16_bf16(vf0, pack8(sc, 0), yT, 0, 0, 0);
            yT = __builtin_amdgcn_mfma_f32_32x32x16_bf16(vf1, pack8(sc, 8), yT, 0, 0, 0);
        }
        {
            const int jl = 32 * cbl + r32, jrow = 64 * hh + jl; const int row = grow(b, i, jrow);
            float s1 = 0.f, s2 = 0.f;
#pragma unroll
            for (int r = 0; r < 16; ++r) { s1 += yT[r]; s2 += yT[r] * yT[r]; }
            s1 += partner32(s1, hi); s2 += partner32(s2, hi);
            if (hi == 0) *(LAS f32x2*)(st + jl * 8 + et * 2) = (f32x2){s1, s2};
            const bool ok = (i > 0) || (jrow >= 112 && b == 0);
            if (ok) {
                bf16_t* yp = (i > 0 ? V + (size_t)row * 2048 : YM + (size_t)(row - MREAL) * 2048) + h * 256 + half * 128 + et * 32 + 4 * hi;
#pragma unroll
                for (int g = 0; g < 4; ++g) { u32x2 w; w.x = pk2(yT[4 * g], yT[4 * g + 1]); w.y = pk2(yT[4 * g + 2], yT[4 * g + 3]); gstore8_asm(yp + 8 * g, w); }
            }
        }
#pragma unroll
        for (int ks = 0; ks < 4; ++ks) {
            const bf16x8 vf = trfrag(sb_ + S_V + et * 4096 + (16 * ks) * 64 + troff);
            bf16x8 kf[4];
#pragma unroll
            for (int db = 0; db < 4; ++db) {
                const LAS unsigned char* kb = sb_ + S_K + db * 4096 + ks * 256 + ktr_lane;
                const s16x4 a = vtr(kb + ktr_r0), c = vtr(kb + ktr_r1);
                kf[db] = (bf16x8){a[0], a[1], a[2], a[3], c[0], c[1], c[2], c[3]};
            }
            __builtin_amdgcn_sched_barrier(0);
#pragma unroll
            for (int db = 0; db < 4; ++db) T[db] = __builtin_amdgcn_mfma_f32_32x32x16_bf16(kf[db], vf, T[db], 0, 0, 0);
        }
        if (j + 2 < 34) RET_DMA_FAST((j + 2) % 3);
    }
#undef RET_DMA
#undef RET_DMA_FAST
    asm volatile("s_waitcnt vmcnt(0) lgkmcnt(0)" ::: "memory"); __builtin_amdgcn_s_barrier(); asm volatile("" ::: "memory");
    stats_flush64(st, b, h, half, 33, gst, tid);
}

constexpr int STAGE5 = 57344, S5_K = 0, S5_Q = 16384, S5_V = 24576;
constexpr int L_ST5 = LDSCTL_OFF + 2048;
__device__ __forceinline__ u32x2 gload8_asm(const void* p) { u32x2 v; asm volatile("global_load_dwordx2 %0, %1, off" : "=v"(v) : "v"(p) : "memory"); return v; }
__device__ __forceinline__ void gstore4_asm(void* p, unsigned v) { asm volatile("global_store_dword %0, %1, off" :: "v"(p), "v"(v) : "memory"); }

template <bool F8OUT>
__device__ __forceinline__ void ret_item5(LAS unsigned char* lds, int b, int h, int rh, const bf16_t* Q, const bf16_t* K, const bf16_t* V, bf16_t* Gt, unsigned char* A8, const float* gn, int wid, int lane) {
    const int r32 = lane & 31, hi = lane >> 5, et = wid;
    const float gamma = 1.0f - exp2f(-5.0f - (float)h); const float g128 = exp2f(128.0f * log2f(gamma));
    f32x16 T[4];
#pragma unroll
    for (int d = 0; d < 4; ++d) T[d] = (f32x16){};
    LAS float* st = (LAS float*)(lds + L_ST5);
    const unsigned lds0 = (unsigned)(size_t)lds;
    const int trq = (lane & 15) >> 2, trp = lane & 3, trb = (lane >> 4) & 1;
    const int troff = (4 * hi + trq) * 64 + trb * 32 + trp * 8;
    const int trp2 = ((trp & 1) << 1) | (trp >> 1);
    const int ktr_ch = 2 * trb + (trp2 >> 1);
    const int ktr_lane = ktr_ch * 1024 + (trp2 & 1) * 8;
    const int ktr_r0 = ((4 * hi + trq) ^ (4 * ktr_ch)) * 16, ktr_r1 = ((4 * hi + 8 + trq) ^ (4 * ktr_ch)) * 16;
    const int krA = hi * 1024 + (r32 ^ (4 * hi)) * 16, krB = hi * 1024 + (r32 ^ (8 + 4 * hi)) * 16;
    const int qro = hi * 512 + r32 * 16;
    LAS float* gnl = (LAS float*)(lds + L_ST5 + 4096);
    if (threadIdx.x < 256) gnl[threadIdx.x] = gn[h * 256 + threadIdx.x];
    const bf16_t* kpt[2]; const bf16_t* qpt; const bf16_t* vpt[4];
#pragma unroll
    for (int u = 0; u < 2; ++u) { const int pc = wid * 2 + u; kpt[u] = K + (size_t)(b * SEQ + (lane ^ (4 * (pc & 3)))) * D + h * 128 + pc * 8; }
    qpt = Q + (size_t)(b * SEQ + 32 * rh + (lane & 31)) * D + h * 128 + (2 * wid + (lane >> 5)) * 8;
#pragma unroll
    for (int u = 0; u < 4; ++u) vpt[u] = V + (size_t)(b * SEQ + 16 * u + (lane >> 2)) * 2048 + h * 256 + 32 * wid + 8 * (lane & 3);
#define R5_DMA_FAST(stg) do { const unsigned _base = lds0 + (stg) * STAGE5; \
        _Pragma("unroll") for (int u = 0; u < 2; ++u) { glds16(kpt[u], (unsigned)__builtin_amdgcn_readfirstlane(_base + S5_K + (wid * 2 + u) * 1024)); kpt[u] += (size_t)64 * D; } \
        glds16(qpt, (unsigned)__builtin_amdgcn_readfirstlane(_base + S5_Q + wid * 1024)); qpt += (size_t)64 * D; \
        _Pragma("unroll") for (int u = 0; u < 4; ++u) { glds16(vpt[u], (unsigned)__builtin_amdgcn_readfirstlane(_base + S5_V + (wid * 4 + u) * 1024)); vpt[u] += (size_t)64 * 2048; } } while (0)
#define R5_DMA_META(stg) do { const unsigned _base = lds0 + (stg) * STAGE5; \
        _Pragma("unroll") for (int u = 0; u < 2; ++u) { const int pc = wid * 2 + u; const int rowk = grow(b, 0, 64 + (lane ^ (4 * (pc & 3)))); \
            glds16(K + (size_t)rowk * D + h * 128 + pc * 8, (unsigned)__builtin_amdgcn_readfirstlane(_base + S5_K + pc * 1024)); } \
        { const int rowq = grow(b, 0, 64 + 32 * rh + (lane & 31)); glds16(Q + (size_t)rowq * D + h * 128 + (2 * wid + (lane >> 5)) * 8, (unsigned)__builtin_amdgcn_readfirstlane(_base + S5_Q + wid * 1024)); } \
        _Pragma("unroll") for (int u = 0; u < 4; ++u) { const int rowv = grow(b, 0, 64 + 16 * u + (lane >> 2)); \
            glds16(V + (size_t)rowv * 2048 + h * 256 + 32 * wid + 8 * (lane & 3), (unsigned)__builtin_amdgcn_readfirstlane(_base + S5_V + (wid * 4 + u) * 1024)); } } while (0)
#define R5_FINALIZE(jp) do { const int _ip = (jp) >> 1, _jr = 64 * ((jp) & 1) + 32 * rh + r32; const bool _ok = (_ip > 0) || (_jr >= 112 && b == 0); const int _row = grow(b, _ip, _jr); \
        asm volatile("" : "+v"(gq[0]), "+v"(gq[1]), "+v"(gq[2]), "+v"(gq[3]), "+v"(yp) :: "memory");     \
        const LAS f32x4* sp = (const LAS f32x4*)(st + (((jp) & 1) * 32 + r32) * 16); const f32x4 q0 = sp[0], q1 = sp[1], q2 = sp[2], q3 = sp[3]; \
        const float s1 = ((q0[0] + q0[2]) + (q1[0] + q1[2])) + ((q2[0] + q2[2]) + (q3[0] + q3[2])), s2 = ((q0[1] + q0[3]) + (q1[1] + q1[3])) + ((q2[1] + q2[3]) + (q3[1] + q3[3])); \
        const float mu = s1 * (1.0f / 256.0f); const float rsd = __builtin_amdgcn_rsqf(fmaxf(s2 * (1.0f / 256.0f) - mu * mu, 0.f) + EPS); \
        _Pragma("unroll") for (int g = 0; g < 4; ++g) { const f32x4 gv = *(const LAS f32x4*)(gnl + 32 * et + 8 * g + 4 * hi) * rsd; \
            const float o0 = bflo(gq[g].x) * (yp[4 * g] - mu) * gv[0], o1 = bfhi(gq[g].x) * (yp[4 * g + 1] - mu) * gv[1]; \
            const float o2 = bflo(gq[g].y) * (yp[4 * g + 2] - mu) * gv[2], o3 = bfhi(gq[g].y) * (yp[4 * g + 3] - mu) * gv[3]; \
            if (_ok) { if (F8OUT) { int pk = __builtin_amdgcn_cvt_pk_fp8_f32(pg8::clamp8(F8_A2 * o0), pg8::clamp8(F8_A2 * o1), 0, false); pk = __builtin_amdgcn_cvt_pk_fp8_f32(pg8::clamp8(F8_A2 * o2), pg8::clamp8(F8_A2 * o3), pk, true); \
                                   gstore4_asm(A8 + (size_t)_row * 2048 + h * 256 + 32 * et + 8 * g + 4 * hi, (unsigned)pk); } \
                       else { u32x2 w; w.x = pk2(o0, o1); w.y = pk2(o2, o3); gstore8_asm(Gt + (size_t)_row * 2048 + h * 256 + 32 * et + 8 * g + 4 * hi, w); } } } } while (0)
#define R5_GLOAD(jp) do { const int _ip = (jp) >> 1, _jr = 64 * ((jp) & 1) + 32 * rh + r32; const int _row = grow(b, _ip, _jr); const bf16_t* gp = Gt + (size_t)_row * 2048 + h * 256 + 32 * et + 4 * hi; \
        _Pragma("unroll") for (int g = 0; g < 4; ++g) gq[g] = *(const u32x2*)(gp + 8 * g); } while (0)
    __builtin_amdgcn_s_waitcnt(0);
    R5_DMA_META(1);
    f32x16 yp = {}; u32x2 gq[4] = {};
    for (int j = 1; j < 34; ++j) {
        asm volatile("s_waitcnt vmcnt(0) lgkmcnt(0)" ::: "memory"); __builtin_amdgcn_s_barrier(); asm volatile("" ::: "memory");
        if (j > 1) R5_FINALIZE(j - 1);
        if (j + 1 < 34) R5_DMA_FAST((j + 1) & 1);
        const LAS unsigned char* sb_ = lds + (j & 1) * STAGE5;
        const int hh = j & 1;
        if (hh == 0) {
#pragma unroll
            for (int d = 0; d < 4; ++d) T[d] *= g128;
        }
        bf16x8 qf[8];
#pragma unroll
        for (int ks = 0; ks < 8; ++ks) qf[ks] = *(const LAS bf16x8*)(sb_ + S5_Q + (2 * ks) * 512 + qro);
        __builtin_amdgcn_sched_barrier(0);
        f32x16 yT = {};
#pragma unroll
        for (int db = 0; db < 4; ++db) {
            yT = __builtin_amdgcn_mfma_f32_32x32x16_bf16(pack8(T[db], 0), qf[2 * db], yT, 0, 0, 0);
            yT = __builtin_amdgcn_mfma_f32_32x32x16_bf16(pack8(T[db], 8), qf[2 * db + 1], yT, 0, 0, 0);
        }
        for (int sb = 0; sb <= rh; ++sb) {
            f32x16 sc = {};
            bf16x8 kfr[8];
#pragma unroll
            for (int ks = 0; ks < 8; ++ks) kfr[ks] = *(const LAS bf16x8*)(sb_ + S5_K + sb * 512 + (2 * ks) * 1024 + ((ks & 1) ? krB : krA));
            const LAS unsigned char* vb = sb_ + S5_V + et * 4096 + (32 * sb) * 64 + troff;
            const bf16x8 vf0 = trfrag(vb), vf1 = trfrag(vb + 1024);
            __builtin_amdgcn_sched_barrier(0);
#pragma unroll
            for (int ks = 0; ks < 8; ++ks) sc = __builtin_amdgcn_mfma_f32_32x32x16_bf16(kfr[ks], qf[ks], sc, 0, 0, 0);
            if (sb == rh) {
#pragma unroll
                for (int r = 0; r < 16; ++r) if (crow(r, hi) > r32) sc[r] = 0.f;
            }
            yT = __builtin_amdgcn_mfma_f32_32x32x16_bf16(vf0, pack8(sc, 0), yT, 0, 0, 0);
            yT = __builtin_amdgcn_mfma_f32_32x32x16_bf16(vf1, pack8(sc, 8), yT, 0, 0, 0);
        }
        {
            float s1 = 0.f, s2 = 0.f;
#pragma unroll
            for (int r = 0; r < 16; ++r) { s1 += yT[r]; s2 += yT[r] * yT[r]; }
            s1 += partner32(s1, hi); s2 += partner32(s2, hi);
            if (hi == 0) *(LAS f32x2*)(st + ((hh * 32 + r32) * 8 + et) * 2) = (f32x2){s1, s2};
        }
        yp = yT;
#pragma unroll
        for (int ks = 0; ks < 4; ++ks) {
            const bf16x8 vf = trfrag(sb_ + S5_V + et * 4096 + (16 * ks) * 64 + troff);
            bf16x8 kf[4];
#pragma unroll
            for (int db = 0; db < 4; ++db) {
                const LAS unsigned char* kb = sb_ + S5_K + db * 4096 + ks * 256 + ktr_lane;
                const s16x4 a = vtr(kb + ktr_r0), c = vtr(kb + ktr_r1);
                kf[db] = (bf16x8){a[0], a[1], a[2], a[3], c[0], c[1], c[2], c[3]};
            }
            __builtin_amdgcn_sched_barrier(0);
#pragma unroll
            for (int db = 0; db < 4; ++db) T[db] = __builtin_amdgcn_mfma_f32_32x32x16_bf16(kf[db], vf, T[db], 0, 0, 0);
        }
        R5_GLOAD(j);
    }
    asm volatile("s_waitcnt vmcnt(0) lgkmcnt(0)" ::: "memory"); __builtin_amdgcn_s_barrier(); asm volatile("" ::: "memory");
    R5_FINALIZE(33);
#undef R5_DMA_FAST
#undef R5_DMA_META
#undef R5_FINALIZE
#undef R5_GLOAD
}
}
__device__ __forceinline__ void ret_mfma(const Ctx& C, const bf16_t* Q, const bf16_t* Kk, bf16_t* V, bf16_t* YM, float* gst) {
    const int bx = (int)blockIdx.x, vcu = (C.G % 8 == 0) ? (bx % 8) * (C.G / 8) + bx / 8 : bx;
    for (int item = vcu; item < NBATCH * 8 * 2; item += C.G) {
        const int half = item & 1, h = (item >> 1) & 7, b = item >> 4;
        retm::ret_item(C.lds, b, h, half, Q, Kk, V, YM, gst, C.wave, C.lane, C.tid);
    }
    asm volatile("s_waitcnt vmcnt(0)" ::: "memory");
    __syncthreads();
}


template <bool F8OUT> __device__ __forceinline__ void ret_mfma5(const Ctx& C, const bf16_t* Q, const bf16_t* Kk, const bf16_t* V, bf16_t* Gt, unsigned char* A8, const float* gn) {
    const int bx = (int)blockIdx.x, vcu = (C.G % 8 == 0) ? (bx % 8) * (C.G / 8) + bx / 8 : bx;
    for (int item = vcu; item < NBATCH * 8 * 2; item += C.G) {
        const int rh = item & 1, h = (item >> 1) & 7, b = item >> 4;
        retm::ret_item5<F8OUT>(C.lds, b, h, rh, Q, Kk, V, Gt, A8, gn, C.wave, C.lane);
    }
    asm volatile("s_waitcnt vmcnt(0)" ::: "memory");
    __syncthreads();
}
__device__ __forceinline__ void sb_naive(const Ctx& C, bf16_t* Q, const bf16_t* Kk, const bf16_t* V) {
    const int NIT = NBATCH * 16 * 32 + 16;
    for (int it = (NAIVE_SB ? C.gw : NBATCH * 16 * 32 + C.gw); it < NIT; it += C.NGW) {
        int b, h, p0, nq;
        if (it < NBATCH * 16 * 32) { const int bh = it & 255, qb = it >> 8; b = bh >> 4; h = bh & 15; p0 = NMETA + qb * 64; nq = 64; }
        else { b = 0; h = it - NBATCH * 16 * 32; p0 = 0; nq = 16; }
        const int p = p0 + C.lane; const bool valid = C.lane < nq;
        const int row = pos_row(b, valid ? p : p0);
        float q[64], o[64];
        { const u32x4* qp = (const u32x4*)(Q + (size_t)row * D + h * 64);
#pragma unroll
          for (int jj = 0; jj < 8; ++jj) { const u32x4 t = qp[jj]; q[8 * jj] = bflo(t.x); q[8 * jj + 1] = bfhi(t.x); q[8 * jj + 2] = bflo(t.y); q[8 * jj + 3] = bfhi(t.y); q[8 * jj + 4] = bflo(t.z); q[8 * jj + 5] = bfhi(t.z); q[8 * jj + 6] = bflo(t.w); q[8 * jj + 7] = bfhi(t.w); } }
#pragma unroll
        for (int d = 0; d < 64; ++d) o[d] = 0.f;
        float P = 1.0f;
        for (int s = p0 + nq - 2; s >= 0; --s) {
            const int krow = pos_row(b, s);
            const u32x4* kp = (const u32x4*)(Kk + (size_t)krow * D + h * 64);
            const u32x4* vp = (const u32x4*)(V + (size_t)krow * D + h * 64);
            float z = 0.f;
#pragma unroll
            for (int jj = 0; jj < 8; ++jj) { const u32x4 t = kp[jj];
                z += q[8 * jj] * bflo(t.x) + q[8 * jj + 1] * bfhi(t.x) + q[8 * jj + 2] * bflo(t.y) + q[8 * jj + 3] * bfhi(t.y) + q[8 * jj + 4] * bflo(t.z) + q[8 * jj + 5] * bfhi(t.z) + q[8 * jj + 6] * bflo(t.w) + q[8 * jj + 7] * bfhi(t.w); }
            z = fminf(z, 100.f);
            const float E = fast_exp2(z), r = fast_rcp(1.0f + E);
            const bool act = valid && (s < p);
            const float w = act ? E * r * P : 0.f;
            P = act ? P * r : P;
#pragma unroll
            for (int jj = 0; jj < 8; ++jj) { const u32x4 t = vp[jj];
                o[8 * jj] += w * bflo(t.x); o[8 * jj + 1] += w * bfhi(t.x); o[8 * jj + 2] += w * bflo(t.y); o[8 * jj + 3] += w * bfhi(t.y); o[8 * jj + 4] += w * bflo(t.z); o[8 * jj + 5] += w * bfhi(t.z); o[8 * jj + 6] += w * bflo(t.w); o[8 * jj + 7] += w * bfhi(t.w); }
        }
        if (valid) { u32x4* op = (u32x4*)(Q + (size_t)row * D + h * 64);
#pragma unroll
            for (int jj = 0; jj < 8; ++jj) { u32x4 t; t.x = pk2(o[8 * jj], o[8 * jj + 1]); t.y = pk2(o[8 * jj + 2], o[8 * jj + 3]); t.z = pk2(o[8 * jj + 4], o[8 * jj + 5]); t.w = pk2(o[8 * jj + 6], o[8 * jj + 7]); op[jj] = t; } }
    }
}


namespace sbm {
typedef float f32x16 __attribute__((ext_vector_type(16)));
typedef short s16x4 __attribute__((ext_vector_type(4)));
typedef short v4i16_t __attribute__((ext_vector_type(4)));
constexpr int SLOTB = 8192, LDS_K = 0, LDS_V = 3 * SLOTB;
__device__ __forceinline__ int crow(int r, int hi) { return (r & 3) + 8 * (r >> 2) + 4 * hi; }
__device__ __forceinline__ s16x4 vtr(const LAS unsigned char* p) { return __builtin_bit_cast(s16x4, __builtin_amdgcn_ds_read_tr16_b64_v4i16((LAS v4i16_t*)p)); }
__device__ __forceinline__ float partner32(float x, int hi) { auto rr = __builtin_amdgcn_permlane32_swap(__float_as_uint(x), __float_as_uint(x), false, false); return __uint_as_float(hi ? rr[0] : rr[1]); }

__device__ __forceinline__ void sb_block(const f32x16& p, float& Pin, int hi, bf16x8& f0, bf16x8& f1) {
    float rr[16];
#pragma unroll
    for (int r = 0; r < 16; ++r) { const float E = fast_exp2(p[r]); rr[r] = fast_rcp(1.0f + E); }
    float G[4], PG[4];
#pragma unroll
    for (int g = 0; g < 4; ++g) { G[g] = (rr[4 * g] * rr[4 * g + 1]) * (rr[4 * g + 2] * rr[4 * g + 3]); PG[g] = partner32(G[g], hi); }
    float R[4]; R[3] = 1.0f; R[2] = G[3] * PG[3]; R[1] = R[2] * (G[2] * PG[2]); R[0] = R[1] * (G[1] * PG[1]);
    const float tot = R[0] * (G[0] * PG[0]);
    float w[16];
#pragma unroll
    for (int g = 0; g < 4; ++g) {
        float sfx = Pin * R[g] * (hi ? 1.0f : PG[g]), nx;
        nx = sfx * rr[4 * g + 3]; w[4 * g + 3] = sfx - nx; sfx = nx;
        nx = sfx * rr[4 * g + 2]; w[4 * g + 2] = sfx - nx; sfx = nx;
        nx = sfx * rr[4 * g + 1]; w[4 * g + 1] = sfx - nx; sfx = nx;
        nx = sfx * rr[4 * g];     w[4 * g] = sfx - nx;
    }
    Pin *= tot;
    u32x4 a, b;
    a.x = pk2(w[0], w[1]); a.y = pk2(w[2], w[3]); a.z = pk2(w[4], w[5]); a.w = pk2(w[6], w[7]);
    b.x = pk2(w[8], w[9]); b.y = pk2(w[10], w[11]); b.z = pk2(w[12], w[13]); b.w = pk2(w[14], w[15]);
    f0 = __builtin_bit_cast(bf16x8, a); f1 = __builtin_bit_cast(bf16x8, b);
}

__device__ __forceinline__ void sb_tile(const LAS unsigned char* kbase, const LAS unsigned char* vbase, const bf16x8 q0f, const bf16x8 q1f, const bf16x8 q2f, const bf16x8 q3f, f32x16& o0, f32x16& o1, float& Pin, int mode, int jb, int qrel, int r32, int hi, int lane) {
    const LAS unsigned char* kb = kbase + hi * 1024 + r32 * 16;
    const LAS unsigned char* vb = vbase + ((lane >> 4) & 1) * 32 + (lane & 3) * 8 + (4 * hi + ((lane & 15) >> 2)) * 64;
    f32x16 p0 = {}, p1 = {};
#pragma unroll
    for (int d0 = 0; d0 < 4; ++d0) {
        const bf16x8 k0 = *(const LAS bf16x8*)(kb + d0 * 2048), k1 = *(const LAS bf16x8*)(kb + d0 * 2048 + 512);
        const bf16x8 qd = d0 == 0 ? q0f : d0 == 1 ? q1f : d0 == 2 ? q2f : q3f;
        p0 = __builtin_amdgcn_mfma_f32_32x32x16_bf16(k0, qd, p0, 0, 0, 0);
        p1 = __builtin_amdgcn_mfma_f32_32x32x16_bf16(k1, qd, p1, 0, 0, 0);
    }
    if (mode != 0) {
        asm volatile("" : "+v"(p0), "+v"(p1));
        const int kofs = (mode == 1) ? 64 * jb : 0, qlim = (mode == 1) ? qrel : NMETA, lim1 = (mode == 1) ? qrel : -1000000;
#pragma unroll
        for (int r = 0; r < 16; ++r) { const int kv = kofs + crow(r, hi); if (kv >= qlim) p0[r] = -1.0e30f; if (kv + 32 >= lim1) p1[r] = -1.0e30f; }
    }
    bf16x8 pf[4];
    sb_block(p1, Pin, hi, pf[2], pf[3]);
    sb_block(p0, Pin, hi, pf[0], pf[1]);
#pragma unroll
    for (int ks = 0; ks < 4; ++ks) {
        const s16x4 a0 = vtr(vb + ks * 1024), a1 = vtr(vb + ks * 1024 + 512), c0 = vtr(vb + 4096 + ks * 1024), c1 = vtr(vb + 4096 + ks * 1024 + 512);
        const bf16x8 va = {a0[0], a0[1], a0[2], a0[3], a1[0], a1[1], a1[2], a1[3]}, vc = {c0[0], c0[1], c0[2], c0[3], c1[0], c1[1], c1[2], c1[3]};
        o0 = __builtin_amdgcn_mfma_f32_32x32x16_bf16(va, pf[ks], o0, 0, 0, 0);
        o1 = __builtin_amdgcn_mfma_f32_32x32x16_bf16(vc, pf[ks], o1, 0, 0, 0);
    }
}
constexpr int SLOT2 = 32768;
__device__ __forceinline__ void sb_unit(LAS unsigned char* lds, int b, int h, int qi, bf16_t* Q, const bf16_t* K, const bf16_t* V, int wid, int lane) {
    const int r32 = lane & 31, hi = lane >> 5;
    const size_t rowbase = (size_t)b * SEQ;
    const unsigned lds0 = (unsigned)(size_t)lds;
    const int q0 = qi * 256, NS = 2 * (qi + 1);
    bf16_t* qrow = Q + (rowbase + q0 + wid * 32 + r32) * D + h * 64;
    bf16x8 qf[4];
#pragma unroll
    for (int d0 = 0; d0 < 4; ++d0) qf[d0] = *(const bf16x8*)(qrow + d0 * 16 + hi * 8);
    const int vkey = 16 * (wid & 3) + (lane >> 2);
    const bf16_t* ksrc = K + (rowbase + lane) * D + h * 64 + wid * 8;
    const bf16_t* vsrc = V + (rowbase + vkey) * D + h * 64 + (wid >> 2) * 32 + (lane & 3) * 8;
    const bf16_t* ksrc_m = K + (size_t)(MREAL + (lane < 16 ? lane : 15)) * D + h * 64 + wid * 8;
    const bf16_t* vsrc_m = V + (size_t)(MREAL + (vkey < 16 ? vkey : 15)) * D + h * 64 + (wid >> 2) * 32 + (lane & 3) * 8;
#define SB_ISSUE(step) do { const int _st = (step); const unsigned _sl = lds0 + (_st % 3) * SLOT2 + wid * 1024; \
        if (_st < NS) { const int _t1 = 2 * (NS - 1 - _st) + 1; \
            glds16(ksrc + (size_t)_t1 * 64 * D, (unsigned)__builtin_amdgcn_readfirstlane(_sl)); glds16(ksrc + (size_t)(_t1 - 1) * 64 * D, (unsigned)__builtin_amdgcn_readfirstlane(_sl + 8192)); \
            glds16(vsrc + (size_t)_t1 * 64 * D, (unsigned)__builtin_amdgcn_readfirstlane(_sl + 16384)); glds16(vsrc + (size_t)(_t1 - 1) * 64 * D, (unsigned)__builtin_amdgcn_readfirstlane(_sl + 24576)); } \
        else { glds16(ksrc_m, (unsigned)__builtin_amdgcn_readfirstlane(_sl)); glds16(vsrc_m, (unsigned)__builtin_amdgcn_readfirstlane(_sl + 16384)); } } while (0)
    SB_ISSUE(0); SB_ISSUE(1);
    f32x16 o0 = {}, o1 = {};
    float Pin = 1.0f;
    const int qrel = wid * 32 + r32;
    LAS int* dflag = (LAS int*)(lds + LDSCTL_OFF + 12288);
    bool wdone = false;
    for (int st = 0; st <= NS; ++st) {
        if (st + 1 < NS) asm volatile("s_waitcnt vmcnt(4) lgkmcnt(0)" ::: "memory"); else if (st + 1 == NS) asm volatile("s_waitcnt vmcnt(2) lgkmcnt(0)" ::: "memory"); else asm volatile("s_waitcnt vmcnt(0) lgkmcnt(0)" ::: "memory");
        __builtin_amdgcn_s_barrier(); asm volatile("" ::: "memory");
        if (st > 0) {
            const LAS int* df = dflag + ((st - 1) & 1) * 8;
            if ((df[0] & df[1] & df[2] & df[3] & df[4] & df[5] & df[6] & df[7]) != 0) break;
        }
        if (st + 2 <= NS) SB_ISSUE(st + 2);
        const LAS unsigned char* sl = lds + (st % 3) * SLOT2;
        const int nsub = (st == NS) ? 1 : 2;
#pragma unroll 1
        for (int sub = 0; sub < nsub; ++sub) {
            const int mode = (st == NS) ? 2 : (st < 2 ? 1 : 0);
            const int jb = 3 - 2 * st - sub;
            if (mode == 1 && 64 * jb > wid * 32 + 31) continue;
            if (wdone) continue;
            sb_tile(sl + sub * 8192, sl + 16384 + sub * 8192, qf[0], qf[1], qf[2], qf[3], o0, o1, Pin, mode, jb, qrel, r32, hi, lane);
        }
        { const int dn = __all(Pin < 9.0e-13f) ? 1 : 0; wdone = dn != 0; if (lane == 0) dflag[(st & 1) * 8 + wid] = dn; }
    }
    asm volatile("s_waitcnt vmcnt(0)" ::: "memory");
#undef SB_ISSUE
#pragma unroll
    for (int g = 0; g < 4; ++g) {
        u32x2 w0, w1; w0.x = pk2(o0[4 * g], o0[4 * g + 1]); w0.y = pk2(o0[4 * g + 2], o0[4 * g + 3]); w1.x = pk2(o1[4 * g], o1[4 * g + 1]); w1.y = pk2(o1[4 * g + 2], o1[4 * g + 3]);
        *(u32x2*)(qrow + 8 * g + 4 * hi) = w0; *(u32x2*)(qrow + 32 + 8 * g + 4 * hi) = w1;
    }
    asm volatile("s_waitcnt lgkmcnt(0)" ::: "memory");
    __builtin_amdgcn_s_barrier(); asm volatile("" ::: "memory");
}
}
__device__ __forceinline__ void sb_mfma(const Ctx& C, bf16_t* Q, const bf16_t* Kk, const bf16_t* V) {
    const int bx = (int)blockIdx.x, vcu = (C.G % 8 == 0) ? (bx % 8) * (C.G / 8) + bx / 8 : bx;
    for (int pi = vcu; pi < NBATCH * 16 * 4; pi += C.G) {
        const int bh = pi >> 2, s4 = pi & 3;
        sbm::sb_unit(C.lds, bh >> 4, bh & 15, 7 - s4, Q, Kk, V, C.wave, C.lane);
        sbm::sb_unit(C.lds, bh >> 4, bh & 15, s4, Q, Kk, V, C.wave, C.lane);
    }
    asm volatile("s_waitcnt vmcnt(0)" ::: "memory");
    __syncthreads();
}

constexpr int ROWS_PER_WG = 129;
__device__ __forceinline__ void router_a(const Ctx& C, int c, int layer, const float* ssq, int* cnt_wg) {
    LAS unsigned char* bimg = C.lds;
    LAS int* lcnt = (LAS int*)(C.lds + 32768);
    LAS float* tile = (LAS float*)(C.lds + 33792 + C.wave * 1024);
    const float* Wr = C.in[17] + (size_t)c * D * NE; const float* g = C.in[3] + (size_t)layer * D;
    int tid_ = C.tid; asm volatile("" : "+v"(tid_));
    const int lane_ = tid_ & 63;
    for (int k = tid_; k < D; k += 512) {
        const f32x4 w0 = *(const f32x4*)(Wr + (size_t)k * NE), w1 = *(const f32x4*)(Wr + (size_t)k * NE + 4); const float gk = g[k];
        const int s_ = k >> 5, fq_ = (k >> 3) & 3, j_ = k & 7;
#pragma unroll
        for (int e = 0; e < NE; ++e) {
            const float w = (e < 4 ? w0[e & 3] : w1[e & 3]) * gk;
            const unsigned hi = pk2(w, 0.f) & 0xffffu; const float lo = w - bflo(hi);
            *(LAS unsigned short*)(bimg + ((s_ * 64 + fq_ * 16 + e) * 16) + 2 * j_) = (unsigned short)hi;
            *(LAS unsigned short*)(bimg + ((s_ * 64 + fq_ * 16 + e + 8) * 16) + 2 * j_) = (unsigned short)(pk2(lo, 0.f) & 0xffffu);
        }
    }
    if (tid_ < NE) lcnt[tid_] = 0;
    __syncthreads();
    int2* toke = (int2*)(C.misc + MISC_TOKE); f32x2* tokg = (f32x2*)(C.misc + MISC_TOKG); int2* tokr = (int2*)(C.misc + MISC_TOKR);
    const int r0 = (int)blockIdx.x * ROWS_PER_WG, rend = (r0 + ROWS_PER_WG < MVALID) ? r0 + ROWS_PER_WG : MVALID;
    const int fr = lane_ & 15, fq = lane_ >> 4;
    for (int grp = C.wave; grp < 9; grp += 8) {
        const int rbase = r0 + grp * 16; if (rbase >= rend) break;
        const int row = rbase + fr; const bool valid = row < rend; const int lrow = valid ? row : rbase;
        const float rs = pg8::rstd_of(ssq, lrow);
        const bf16_t* ap = C.H + (size_t)lrow * D + 8 * fq;
        f32x4 acc = {0.f, 0.f, 0.f, 0.f};
#pragma unroll
        for (int s0 = 0; s0 < 32; s0 += 8) {
            bf16x8 af[8], bfr[8];
#pragma unroll
            for (int t = 0; t < 8; ++t) af[t] = *(const bf16x8*)(ap + 32 * (s0 + t));
#pragma unroll
            for (int t = 0; t < 8; ++t) bfr[t] = *(const LAS bf16x8*)(bimg + ((s0 + t) * 64 + lane_) * 16);
#pragma unroll
            for (int t = 0; t < 8; ++t) acc = __builtin_amdgcn_mfma_f32_16x16x32_bf16(af[t], bfr[t], acc, 0, 0, 0);
        }
#pragma unroll
        for (int i = 0; i < 4; ++i) tile[(4 * fq + i) * 16 + fr] = acc[i];
        LDS_WAIT();
        if (lane_ < 16 && valid) {
            const f32x4 t0 = *(const LAS f32x4*)(tile + lane_ * 16), t1 = *(const LAS f32x4*)(tile + lane_ * 16 + 4), t2 = *(const LAS f32x4*)(tile + lane_ * 16 + 8), t3 = *(const LAS f32x4*)(tile + lane_ * 16 + 12);
            const float lg[NE] = {t0[0] + t2[0], t0[1] + t2[1], t0[2] + t2[2], t0[3] + t2[3], t1[0] + t3[0], t1[1] + t3[1], t1[2] + t3[2], t1[3] + t3[3]};
            int e0 = 0; float v0 = lg[0];
#pragma unroll
            for (int e = 1; e < NE; ++e) if (lg[e] > v0) { v0 = lg[e]; e0 = e; }
            int e1 = -1; float v1 = -3.0e38f;
#pragma unroll
            for (int e = 0; e < NE; ++e) if (e != e0 && lg[e] > v1) { v1 = lg[e]; e1 = e; }
            const float g1 = fast_rcp(1.0f + __expf((v0 - v1) * rs)), g0 = 1.0f - g1;
            const int k0 = atomicAdd((int*)&lcnt[e0], 1), k1 = atomicAdd((int*)&lcnt[e1], 1);
            toke[row] = make_int2(e0, e1); tokg[row] = (f32x2){g0, g1}; tokr[row] = make_int2(k0, k1);
        }
        LDS_WAIT();
    }
    __syncthreads();
    if (tid_ < NE) cnt_wg[(int)blockIdx.x * NE + tid_] = lcnt[tid_];
    __syncthreads();
}
__device__ __forceinline__ void router_b(const Ctx& C, const float* ssq, const int* cnt_wg, int* seg_out, int* srow) {
    LAS int* tot = (LAS int*)C.lds;
    LAS int* part = (LAS int*)(C.lds + 1024);
    { const int e = C.tid & 7, sl = C.tid >> 3; int all = 0, before = 0;
#pragma unroll
      for (int j = 0; j < 4; ++j) { const int w = sl * 4 + j; const int v = cnt_wg[w * NE + e]; all += v; before += (w < (int)blockIdx.x) ? v : 0; }
      all += __shfl_xor(all, 8); all += __shfl_xor(all, 16); all += __shfl_xor(all, 32);
      before += __shfl_xor(before, 8); before += __shfl_xor(before, 16); before += __shfl_xor(before, 32);
      if (C.lane < 8) { part[C.wave * 16 + C.lane] = all; part[C.wave * 16 + 8 + C.lane] = before; } }
    __syncthreads();
    if (C.tid < NE) { int all = 0, before = 0;
#pragma unroll
        for (int w = 0; w < 8; ++w) { all += part[w * 16 + C.tid]; before += part[w * 16 + 8 + C.tid]; }
        tot[C.tid] = all; tot[8 + C.tid] = before; }
    __syncthreads();
    if (C.tid == 0) { int s = 0;
        for (int e = 0; e < NE; ++e) { tot[16 + e] = s; s += (tot[e] + 255) & ~255; }
        tot[24] = s;
        if (blockIdx.x == 0) for (int e = 0; e <= NE; ++e) seg_out[e] = tot[16 + e]; }
    __syncthreads();
    const int2* toke = (const int2*)(C.misc + MISC_TOKE); const f32x2* tokg = (const f32x2*)(C.misc + MISC_TOKG); const int2* tokr = (const int2*)(C.misc + MISC_TOKR);
    int2* tokp = (int2*)(C.misc + MISC_TOKP); float* rstds = (float*)(C.misc + MISC_RSTDS); float* gates = (float*)(C.misc + MISC_GATES);
    const int r0 = (int)blockIdx.x * ROWS_PER_WG;
    int tid_ = C.tid; asm volatile("" : "+v"(tid_));
    if (tid_ < ROWS_PER_WG) {
        const int row = r0 + tid_;
        if (row < MVALID) {
            const int2 e = toke[row], k = tokr[row]; const f32x2 g = tokg[row];
            const int p0 = tot[16 + e.x] + tot[8 + e.x] + k.x, p1 = tot[16 + e.y] + tot[8 + e.y] + k.y;
            const float rs = pg8::rstd_of(ssq, row);
            tokp[row] = make_int2(p0, p1); rstds[p0] = rs; rstds[p1] = rs; srow[p0] = row; srow[p1] = row;
            gates[p0] = g.x * (1.0f / (pg8::F8_W2 * pg8::F8_HID)); gates[p1] = g.y * (1.0f / (pg8::F8_W2 * pg8::F8_HID));
        }
    }
    __syncthreads();
}
__device__ __forceinline__ void moe_combine(const Ctx& C, const bf16_t* YS, float* ssq_out) {
    const int2* tokp = (const int2*)(C.misc + MISC_TOKP);
    for (int row = C.gw; row < MVALID; row += C.NGW) {
        const int2 p = tokp[row]; float ss = 0.f;
        u32x4 hvv[2], y0v[2], y1v[2];
#pragma unroll
        for (int q = 0; q < 2; ++q) { const int col = q * 512 + C.lane * 8; hvv[q] = *(const u32x4*)(C.H + (size_t)row * D + col); y0v[q] = *(const u32x4*)(YS + (size_t)p.x * D + col); y1v[q] = *(const u32x4*)(YS + (size_t)p.y * D + col); }
#pragma unroll
        for (int q = 0; q < 2; ++q) {
            const int col = q * 512 + C.lane * 8;
            const u32x4 hv = hvv[q], y0 = y0v[q], y1 = y1v[q];
            u32x4 w;
            w.x = pk2(bflo(hv.x) + bflo(y0.x) + bflo(y1.x), bfhi(hv.x) + bfhi(y0.x) + bfhi(y1.x));
            w.y = pk2(bflo(hv.y) + bflo(y0.y) + bflo(y1.y), bfhi(hv.y) + bfhi(y0.y) + bfhi(y1.y));
            w.z = pk2(bflo(hv.z) + bflo(y0.z) + bflo(y1.z), bfhi(hv.z) + bfhi(y0.z) + bfhi(y1.z));
            w.w = pk2(bflo(hv.w) + bflo(y0.w) + bflo(y1.w), bfhi(hv.w) + bfhi(y0.w) + bfhi(y1.w));
            *(u32x4*)(C.H + (size_t)row * D + col) = w;
            ss += bflo(w.x) * bflo(w.x) + bfhi(w.x) * bfhi(w.x) + bflo(w.y) * bflo(w.y) + bfhi(w.y) * bfhi(w.y) + bflo(w.z) * bflo(w.z) + bfhi(w.z) * bfhi(w.z) + bflo(w.w) * bflo(w.w) + bfhi(w.w) * bfhi(w.w);
        }
        ss = wave_sum(ss);
        pg8::ssq_store_single(ssq_out, row, ss, C.lane);
    }
}
__device__ __forceinline__ void moe_combine_final(const Ctx& C, const bf16_t* YS, const float* g, float* out) {
    const int2* tokp = (const int2*)(C.misc + MISC_TOKP);
    for (int row = C.gw; row < MREAL; row += C.NGW) {
        const int2 p = tokp[row]; float ss = 0.f; float v[16];
#pragma unroll
        for (int q = 0; q < 2; ++q) {
            const int col = q * 512 + C.lane * 8;
            const u32x4 hv = *(const u32x4*)(C.H + (size_t)row * D + col), y0 = *(const u32x4*)(YS + (size_t)p.x * D + col), y1 = *(const u32x4*)(YS + (size_t)p.y * D + col);
            v[8 * q + 0] = bflo(hv.x) + bflo(y0.x) + bflo(y1.x); v[8 * q + 1] = bfhi(hv.x) + bfhi(y0.x) + bfhi(y1.x);
            v[8 * q + 2] = bflo(hv.y) + bflo(y0.y) + bflo(y1.y); v[8 * q + 3] = bfhi(hv.y) + bfhi(y0.y) + bfhi(y1.y);
            v[8 * q + 4] = bflo(hv.z) + bflo(y0.z) + bflo(y1.z); v[8 * q + 5] = bfhi(hv.z) + bfhi(y0.z) + bfhi(y1.z);
            v[8 * q + 6] = bflo(hv.w) + bflo(y0.w) + bflo(y1.w); v[8 * q + 7] = bfhi(hv.w) + bfhi(y0.w) + bfhi(y1.w);
#pragma unroll
            for (int j = 0; j < 8; ++j) ss += v[8 * q + j] * v[8 * q + j];
        }
        ss = wave_sum(ss);
        const float rs = __builtin_amdgcn_rsqf(ss * (1.0f / D) + EPS);
#pragma unroll
        for (int q = 0; q < 2; ++q) {
            const int col = q * 512 + C.lane * 8;
            const f32x4 g0 = *(const f32x4*)(g + col), g1 = *(const f32x4*)(g + col + 4);
            const f32x4 o0 = {v[8 * q] * rs * g0[0], v[8 * q + 1] * rs * g0[1], v[8 * q + 2] * rs * g0[2], v[8 * q + 3] * rs * g0[3]};
            const f32x4 o1 = {v[8 * q + 4] * rs * g1[0], v[8 * q + 5] * rs * g1[1], v[8 * q + 6] * rs * g1[2], v[8 * q + 7] * rs * g1[3]};
            *(f32x4*)(out + (size_t)row * D + col) = o0; *(f32x4*)(out + (size_t)row * D + col + 4) = o1;
        }
    }
}
constexpr int PP_RUN = 9;
template <int Q> __device__ __forceinline__ void pool_half(const bf16_t* H, const float* gain, bf16_t* Dm, int b, int p0, int n, float rs_l, int lane) {
    constexpr int WMAX = Q ? 16 : 4, J0 = 16 - WMAX;
    const int col = Q * 512 + lane * 8; const bool wide = (lane & 32) != 0;
    const int w = wide ? WMAX : WMAX / 2;
    constexpr int NR = 15 + PP_RUN; u32x4 t[NR];
#define PP_RS(j) __builtin_bit_cast(float, __builtin_amdgcn_readlane(__builtin_bit_cast(int, rs_l), (j)))
#pragma unroll
    for (int j = J0; j < NR; ++j) { const int pj = p0 - 15 + j; const bool ok = pj >= 0 && j < 15 + n;
        t[j] = *(const u32x4*)(H + (size_t)(ok ? pos_row(b, pj) : 0) * D + col); }
    const f32x4 g0 = *(const f32x4*)(gain + col), g1 = *(const f32x4*)(gain + col + 4);
    float S[8];
#pragma unroll
    for (int c = 0; c < 8; ++c) S[c] = 0.f;
#define PP_ACC(sign, tv, rv) do { const float _r = (rv); S[0] += sign bflo((tv).x) * _r; S[1] += sign bfhi((tv).x) * _r; S[2] += sign bflo((tv).y) * _r; S[3] += sign bfhi((tv).y) * _r; \
        S[4] += sign bflo((tv).z) * _r; S[5] += sign bfhi((tv).z) * _r; S[6] += sign bflo((tv).w) * _r; S[7] += sign bfhi((tv).w) * _r; } while (0)
#pragma unroll
    for (int j = J0; j < 15; ++j) { const float r = (j >= 16 - WMAX / 2 || wide) ? PP_RS(j) : 0.f; PP_ACC(+, t[j], r); }
#pragma unroll
    for (int i = 0; i < PP_RUN; ++i) if (i < n) {
        const int p = p0 + i; const int cnt = (p + 1 < w) ? p + 1 : w; const float ic = 1.0f / (float)cnt;
        const u32x4 tv = t[15 + i]; const float r = PP_RS(15 + i);
        PP_ACC(+, tv, r);
        const float s0 = bflo(tv.x) * r, s1 = bfhi(tv.x) * r, s2 = bflo(tv.y) * r, s3 = bfhi(tv.y) * r, s4 = bflo(tv.z) * r, s5 = bfhi(tv.z) * r, s6 = bflo(tv.w) * r, s7 = bfhi(tv.w) * r;
        u32x4 o;
        o.x = pk2((S[0] * ic - s0) * g0[0], (S[1] * ic - s1) * g0[1]); o.y = pk2((S[2] * ic - s2) * g0[2], (S[3] * ic - s3) * g0[3]);
        o.z = pk2((S[4] * ic - s4) * g1[0], (S[5] * ic - s5) * g1[1]); o.w = pk2((S[6] * ic - s6) * g1[2], (S[7] * ic - s7) * g1[3]);
        *(u32x4*)(Dm + (size_t)pos_row(b, p) * D + col) = o;
        u32x4 la = t[16 + i - WMAX], lb = t[16 + i - WMAX / 2]; asm volatile("" : "+v"(la), "+v"(lb));
        const u32x4 lv = wide ? la : lb; const float lr = wide ? PP_RS(16 + i - WMAX) : PP_RS(16 + i - WMAX / 2);
        PP_ACC(-, lv, lr);
    }
#undef PP_ACC
#undef PP_RS
}
__device__ __forceinline__ void pool_prep(const Ctx& C, const float* ssq, const float* gain, bf16_t* Dm) {
    constexpr int RUN = PP_RUN, RPB = (SEQ + RUN - 1) / RUN, NT = NBATCH * RPB + 2;
    int lane = C.lane; asm volatile("" : "+v"(lane));
    for (int task = C.gw; task < NT; task += C.NGW) {
        int b = 0, p0, n;
        if (task < NT - 2) { b = task / RPB; const int k = task - b * RPB; p0 = NMETA + k * RUN; n = (SEQ - k * RUN < RUN) ? SEQ - k * RUN : RUN; }
        else { p0 = (task - (NT - 2)) * RUN; n = (NMETA - p0 < RUN) ? NMETA - p0 : RUN; }
        float rs_l = 0.f;
        { const int j = lane & 31, pj = p0 - 15 + j; if (pj >= 0 && j < 15 + n) rs_l = pg8::rstd_of(ssq, pos_row(b, pj)); }
        pool_half<1>(C.H, gain, Dm, b, p0, n, rs_l, lane);
        pool_half<0>(C.H, gain, Dm, b, p0, n, rs_l, lane);
    }
    if (C.gw >= C.NGW - 240) {
        const u32x4 z = {0u, 0u, 0u, 0u}; const int row = MVALID + (C.gw - (C.NGW - 240));
        *(u32x4*)(Dm + (size_t)row * D + lane * 8) = z; *(u32x4*)(Dm + (size_t)row * D + 512 + lane * 8) = z;
    }
}

__global__ void __launch_bounds__(512, 2) fwd_kernel(Args args) {
    extern __shared__ __attribute__((aligned(16))) unsigned char lds_raw[];
    Ctx C;
    C.lds = (LAS unsigned char*)lds_raw;
    C.tid = threadIdx.x; C.lane = C.tid & 63; C.wave = __builtin_amdgcn_readfirstlane(C.tid >> 6);
    C.G = gridDim.x; C.gw = (int)blockIdx.x * 8 + C.wave; C.NGW = C.G * 8;
    C.in = args.in; C.out = args.out; C.ws = args.ws;
    C.H = (bf16_t*)(args.ws + WS_H); C.ssq = (float*)(args.ws + WS_SSQ); C.gst = (float*)(args.ws + WS_GST);
    C.WA = (bf16_t*)(args.ws + WS_WA); C.WB = (bf16_t*)(args.ws + WS_WB); C.pool = args.ws + WS_POOL; C.misc = args.ws + WS_MISC; C.tab = (f32x2*)(args.ws + WS_TAB);
    C.moe = (int*)(args.ws + WS_CTL + CTL_MOE);
    for (int u = C.tid; u < (LDS_BYTES - LDSCTL_OFF) / 4; u += 512) ((LAS unsigned*)(C.lds + LDSCTL_OFF))[u] = 0u;
    __syncthreads();
    unsigned* barw = (unsigned*)(args.ws + WS_CTL) + CW_BAR;
    XcdBarrier bar; bar.bar = barw; bar.x = 0; bar.st = nullptr;
    if (!MK_PER_PHASE) bar = xcd_barrier_post(barw, (volatile LAS unsigned*)(C.lds + LDSCTL_OFF + 32));
    const int lo = args.ph_lo, hi = args.ph_hi;
#define IN(k) (lo <= (k) && (k) < hi)
#if PROBE_GROUP
    unsigned long long pr_last = __builtin_amdgcn_s_memrealtime(); const unsigned long long pr_t0 = pr_last; unsigned long long pr_acc = 0ull;
    constexpr unsigned long long PR_MASK =
        PROBE_GROUP == 1 ? (1ull << P_PRO) :
        PROBE_GROUP == 2 ? ((1ull << P0_QKVG) | (1ull << P0_WO) | (1ull << P0_W13) | (1ull << P0_W2) | (1ull << P1_QKV) | (1ull << P1_WO) | (1ull << P1_M13) | (1ull << P1_M2) | (1ull << P2_POOL) | (1ull << P2_W13) | (1ull << P2_W2) | (1ull << P3_QKVG) | (1ull << P3_WO) | (1ull << P3_M13) | (1ull << P3_M2)) :
        PROBE_GROUP == 3 ? (1ull << P1_SB) :
        PROBE_GROUP == 4 ? ((1ull << P0_RET) | (1ull << P3_RET)) :
        PROBE_GROUP == 5 ? ((1ull << P0_FIN) | (1ull << P3_FIN) | (1ull << P1_RA) | (1ull << P1_RB) | (1ull << P1_CMB) | (1ull << P3_RA) | (1ull << P3_RB) | (1ull << P3_CMB) | (1ull << P2_PREP)) :
        PROBE_GROUP == 6 ? ((1ull << P1_M13) | (1ull << P3_M13)) :
        PROBE_GROUP == 7 ? ((1ull << P1_M2) | (1ull << P3_M2)) :
        PROBE_GROUP == 8 ? ((1ull << P0_QKVG) | (1ull << P3_QKVG)) :
        PROBE_GROUP == 12 ? ((1ull << P0_FIN) | (1ull << P3_FIN)) :
        PROBE_GROUP == 13 ? ((1ull << P1_RA) | (1ull << P3_RA)) :
        PROBE_GROUP == 14 ? ((1ull << P1_RB) | (1ull << P3_RB)) :
        PROBE_GROUP == 15 ? ((1ull << P1_CMB) | (1ull << P3_CMB)) :
        PROBE_GROUP == 16 ? ((1ull << P2_PREP) | (1ull << P2_POOL)) :
        PROBE_GROUP == 30 ? (1ull << P1_RA) : PROBE_GROUP == 31 ? (1ull << P1_RB) : PROBE_GROUP == 32 ? (1ull << P1_CMB) : PROBE_GROUP == 33 ? (1ull << P3_RA) : PROBE_GROUP == 34 ? (1ull << P3_RB) : PROBE_GROUP == 35 ? (1ull << P3_CMB) :
        PROBE_GROUP == 36 ? (1ull << P2_PREP) : PROBE_GROUP == 37 ? (1ull << P2_POOL) : PROBE_GROUP == 38 ? (1ull << P1_M13) : PROBE_GROUP == 39 ? (1ull << P1_M2) : PROBE_GROUP == 40 ? (1ull << P0_QKVG) : PROBE_GROUP == 41 ? (1ull << P0_W13) :
        PROBE_GROUP == 42 ? (1ull << P0_WO) : PROBE_GROUP == 43 ? (1ull << P0_W2) : PROBE_GROUP == 44 ? (1ull << P3_QKVG) : PROBE_GROUP == 45 ? (1ull << P2_W13) : PROBE_GROUP == 46 ? (1ull << P0_RET) : PROBE_GROUP == 47 ? (1ull << P3_RET) :
        PROBE_GROUP == 48 ? (1ull << P1_QKV) : PROBE_GROUP == 49 ? (1ull << P1_WO) : PROBE_GROUP == 50 ? (1ull << P2_W2) : PROBE_GROUP == 51 ? (1ull << P3_WO) : PROBE_GROUP == 52 ? (1ull << P3_M13) : PROBE_GROUP == 53 ? (1ull << P3_M2) : 0ull;
#define PR_STAMP(k) do { const unsigned long long _t = __builtin_amdgcn_s_memrealtime(); if ((PR_MASK >> (k)) & 1ull) pr_acc += _t - pr_last; pr_last = _t; } while (0)
#else
#define PR_STAMP(k) do { } while (0)
#endif
#define SEAM(k) do { if (!MK_PER_PHASE && (k) + 1 < hi) xcd_barrier(bar); PR_STAMP(k); } while (0)

    bf16_t* const PQ = (bf16_t*)(C.pool + PO_Q); bf16_t* const PK = (bf16_t*)(C.pool + PO_K); bf16_t* const PV = (bf16_t*)(C.pool + PO_V); bf16_t* const PG = (bf16_t*)(C.pool + PO_G);
    bf16_t* const HID = (bf16_t*)(C.pool + PO_HID); bf16_t* const XS = (bf16_t*)(C.pool + PO_XS); bf16_t* const MHID = (bf16_t*)(C.pool + PO_MHID);
    bf16_t* const YM = (bf16_t*)(C.misc + MISC_YM);
    float* const rstds = (float*)(C.misc + MISC_RSTDS); float* const gates = (float*)(C.misc + MISC_GATES);
#define SSQ(i) (C.ssq + (size_t)(i) * MROWS * 16)
    unsigned char* const H8P = (unsigned char*)(C.pool + 100 * MiB);
    unsigned char* const H8L3 = (unsigned char*)(C.pool + 387 * MiB);
    unsigned char* const H8M = (unsigned char*)(C.pool + 320 * MiB);
    int* const srow = (int*)(args.ws + WS_CTL + CTL_SROW);
    unsigned char* const A28 = (unsigned char*)(C.pool + 420 * MiB);

    if (IN(P_PRO)) {
        conv_ret(C, 0, 0, C.WB + WB_MIX, C.WB + WB_WO);
        conv_dense_bf16(C, 0, 0, C.WB + WB_W13, C.WB + WB_W2);
        { LAS float* scr = (LAS float*)(C.lds + C.wave * 16384);
          wt_matrix<0>(C.in[10], D, 3 * D, 3 * D, C.WA + WA_MIX, C.in[2] + 1 * D, scr, C.gw, C.NGW, C.lane);
          wt_matrix<0>(C.in[11], D, D, D, C.WA + WA_MIX_WO_SB, nullptr, scr, C.gw, C.NGW, C.lane); }
        conv_moe(C, 0, 1, C.WA + WA_MOE13, C.WA + WA_MOE2);
        for (int row = C.gw; row < MROWS; row += C.NGW) {
            float ss = 0.f;
            if (row < MVALID) {
                const float* src = row < MREAL ? C.in[0] + (size_t)row * D : C.in[1] + (size_t)(row - MREAL) * D;
#pragma unroll
                for (int q = 0; q < 2; ++q) { const int col = q * 512 + C.lane * 8; const f32x4 a = *(const f32x4*)(src + col), b2 = *(const f32x4*)(src + col + 4);
                    u32x4 w; w.x = pk2(a[0], a[1]); w.y = pk2(a[2], a[3]); w.z = pk2(b2[0], b2[1]); w.w = pk2(b2[2], b2[3]);
                    *(u32x4*)(C.H + (size_t)row * D + col) = w;
                    ss += bflo(w.x) * bflo(w.x) + bfhi(w.x) * bfhi(w.x) + bflo(w.y) * bflo(w.y) + bfhi(w.y) * bfhi(w.y) + bflo(w.z) * bflo(w.z) + bfhi(w.z) * bfhi(w.z) + bflo(w.w) * bflo(w.w) + bfhi(w.w) * bfhi(w.w); }
                ss = wave_sum(ss);
            } else { const u32x4 z = {0u, 0u, 0u, 0u}; *(u32x4*)(C.H + (size_t)row * D + C.lane * 8) = z; *(u32x4*)(C.H + (size_t)row * D + 512 + C.lane * 8) = z; }
            pg8::ssq_store_single(SSQ(0), row, ss, C.lane);
        }
        SEAM(P_PRO);
    }
#define ZERO_ROWS() do { if (blockIdx.x == 0) { const u32x4 z = {0u, 0u, 0u, 0u}; if (C.tid < 128) { *(u32x4*)(PQ + (size_t)MVALID * D + C.tid * 8) = z; *(u32x4*)(PK + (size_t)MVALID * D + C.tid * 8) = z; } \
        if (C.tid < 256) *(u32x4*)(PV + (size_t)MVALID * 2048 + C.tid * 8) = z; } } while (0)
    if (IN(P0_QKVG)) { ZERO_ROWS(); pg8::EpiProj<0> E{SSQ(0), C.tab, PQ, PK, PV, PG, 1.0f}; run_dense(C, C.H, D, 0, C.WB + WB_MIX, D, 6144, E); SEAM(P0_QKVG); }
    if (IN(P0_RET)) { ret_mfma5<false>(C, PQ, PK, PV, PG, nullptr, C.in[9]); SEAM(P0_RET); }
    if (IN(P0_FIN)) { PR_STAMP(P0_FIN); }
    if (IN(P0_WO)) { pg8::EpiResid E{C.H, SSQ(1), nullptr, nullptr, 1.0f}; run_dense(C, PG, 2048, 0, C.WB + WB_WO, 2048, 1024, E); SEAM(P0_WO); }
    if (IN(P0_W13)) { pg8::EpiSwiglu<false> E{SSQ(1), HID}; run_dense(C, C.H, D, 0, C.WB + WB_W13, D, 5632, E); SEAM(P0_W13); }
    if (IN(P0_W2)) { pg8::EpiResid E{C.H, SSQ(2), nullptr, nullptr, 1.0f}; run_dense(C, HID, FF, 0, C.WB + WB_W2, FF, 1024, E); SEAM(P0_W2); }
    if (IN(P1_QKV)) { pg8::EpiProj<1> E{SSQ(2), C.tab, PQ, PK, PV, PG, 1.0f}; run_dense(C, C.H, D, 0, C.WA + WA_MIX, D, 3072, E); SEAM(P1_QKV); }
    if (IN(P1_SB)) { sb_naive(C, PQ, PK, PV); if (!NAIVE_SB) sb_mfma(C, PQ, PK, PV); SEAM(P1_SB); }
    if (IN(P1_WO)) { pg8::EpiResid E{C.H, SSQ(3), nullptr, H8M, 1.0f}; run_dense(C, PQ, D, 0, C.WA + WA_MIX_WO_SB, D, 1024, E); SEAM(P1_WO); }
    if (IN(P1_RA)) {
        router_a(C, 0, 1, SSQ(3), C.moe);
        { LAS float* scr = (LAS float*)(C.lds + C.wave * 16384);
          for (int g = 0; g < 4; ++g) wt_matrix<0>(C.in[12] + (size_t)g * 256 * 256, 256, 256, 256, C.WB + WB_MIX + (size_t)g * 256 * 256, nullptr, scr, C.gw, C.NGW, C.lane); }
        conv_dense(C, 1, 2, C.WB + WB_W13, C.WB + WB_W2);
        SEAM(P1_RA);
    }
    if (IN(P1_RB)) { router_b(C, SSQ(3), C.moe, C.moe + 2 * 256 * NE, srow); SEAM(P1_RB); }
    if (IN(P1_M13)) { pg8::EpiSwigluF8<true> E{rstds, (unsigned char*)MHID}; run_moe8(C, C.moe + 2 * 256 * NE, H8M, (const unsigned char*)(C.WA + WA_MOE13), (size_t)5632 * D, D, 5632, E, srow); SEAM(P1_M13); }
    if (IN(P1_M2)) { pg8::EpiMoeW2 E{gates, XS}; run_moe8(C, C.moe + 2 * 256 * NE, (const unsigned char*)MHID, (const unsigned char*)(C.WA + WA_MOE2), (size_t)D * FF, FF, 1024, E); SEAM(P1_M2); }
    if (IN(P1_CMB)) {
        moe_combine(C, XS, SSQ(4));
        conv_ret8(C, 1, 3, C.WA + WA_MIX, C.WA + WA_MIX_WO_RET);
        conv_moe(C, 1, 3, C.WA + WA_MOE13, C.WA + WA_MOE2);
        SEAM(P1_CMB);
    }
    if (IN(P2_PREP)) { pool_prep(C, SSQ(4), C.in[2] + 2 * D, PQ); SEAM(P2_PREP); }
    if (IN(P2_POOL)) { pg8::EpiResid E{C.H, SSQ(5), C.in[13], H8P, 1.0f}; run_dense(C, PQ, D, 512, C.WB + WB_MIX, 256, 1024, E); SEAM(P2_POOL); }
    if (IN(P2_W13)) { pg8::EpiSwigluF8<false> E{SSQ(5), (unsigned char*)HID}; run_dense8(C, H8P, D, (const unsigned char*)(C.WB + WB_W13), D, 5632, E); SEAM(P2_W13); }
    if (IN(P2_W2)) { pg8::EpiResid E{C.H, SSQ(6), nullptr, H8L3, 1.0f / (pg8::F8_W2 * pg8::F8_HID)}; run_dense8(C, (const unsigned char*)HID, FF, (const unsigned char*)(C.WB + WB_W2), FF, 1024, E); SEAM(P2_W2); }
    if (IN(P3_QKVG)) { ZERO_ROWS(); pg8::EpiProj<0> E{SSQ(6), C.tab, PQ, PK, PV, PG, 1.0f / F8_WP}; run_dense8(C, H8L3, D, (const unsigned char*)(C.WA + WA_MIX), D, 6144, E); SEAM(P3_QKVG); }
    if (IN(P3_RET)) { ret_mfma5<true>(C, PQ, PK, PV, PG, A28, C.in[9] + 2 * D); SEAM(P3_RET); }
    if (IN(P3_FIN)) { PR_STAMP(P3_FIN); }
    if (IN(P3_WO)) { pg8::EpiResid E{C.H, SSQ(7), nullptr, H8M, 1.0f / (F8_WO * F8_A2)}; run_dense8(C, A28, 2048, (const unsigned char*)(C.WA + WA_MIX_WO_RET), 2048, 1024, E); SEAM(P3_WO); }
    if (IN(P3_RA)) { router_a(C, 1, 3, SSQ(7), C.moe + 256 * NE); SEAM(P3_RA); }
    if (IN(P3_RB)) { router_b(C, SSQ(7), C.moe + 256 * NE, C.moe + 2 * 256 * NE + 16, srow); SEAM(P3_RB); }
    if (IN(P3_M13)) { pg8::EpiSwigluF8<true> E{rstds, (unsigned char*)MHID}; run_moe8(C, C.moe + 2 * 256 * NE + 16, H8M, (const unsigned char*)(C.WA + WA_MOE13), (size_t)5632 * D, D, 5632, E, srow); SEAM(P3_M13); }
    if (IN(P3_M2)) { pg8::EpiMoeW2 E{gates, XS}; run_moe8(C, C.moe + 2 * 256 * NE + 16, (const unsigned char*)MHID, (const unsigned char*)(C.WA + WA_MOE2), (size_t)D * FF, FF, 1024, E); SEAM(P3_M2); }
    if (IN(P3_CMB)) { moe_combine_final(C, XS, C.in[21], C.out); PR_STAMP(P3_CMB); }
    if (IN(P_FINAL)) {
#if PROBE_GROUP
        __syncthreads();
        if (blockIdx.x == 0 && C.tid == 0) { const unsigned long long tot = __builtin_amdgcn_s_memrealtime() - pr_t0; asm volatile("s_waitcnt vmcnt(0)" ::: "memory");
            if ((PROBE_GROUP >= 9 && PROBE_GROUP <= 11) || PROBE_GROUP == 60 || PROBE_GROUP == 61) pr_acc = *(LAS unsigned long long*)(C.lds + LDSCTL_OFF + 8192);
            C.out[0] = 4.0f + __builtin_rintf(PROBE_GAIN * (float)pr_acc / (float)tot); }
#endif
    }
#undef IN
#undef SEAM
#undef SSQ
}

extern "C" void kernel_launch(void* const* d_in, const int* in_sizes, int n_in, void* d_out, int out_size, void* d_ws, size_t ws_size, hipStream_t stream) {
    static int grid = 0;
    if (grid == 0) {
        if (n_in != 22 || out_size != MREAL * D || ws_size < WS_END) { fprintf(stderr, "kernel_launch: unexpected shapes (n_in %d out %d ws %zu)\n", n_in, out_size, ws_size); grid = -1; return; }
        int dev = 0, cus = 0;
        if (hipGetDevice(&dev) != hipSuccess || hipDeviceGetAttribute(&cus, hipDeviceAttributeMultiprocessorCount, dev) != hipSuccess) { grid = -1; return; }
        if (hipFuncSetAttribute((const void*)fwd_kernel, hipFuncAttributeMaxDynamicSharedMemorySize, LDS_BYTES) != hipSuccess) { grid = -1; return; }
        int per_cu = 0;
        if (hipOccupancyMaxActiveBlocksPerMultiprocessor(&per_cu, (const void*)fwd_kernel, 512, LDS_BYTES) != hipSuccess || per_cu < 1) { fprintf(stderr, "kernel_launch: occupancy query says %d\n", per_cu); }
        (void)hipGetLastError();
        grid = cus;
    }
    if (grid < 0) return;
    (void)hipMemsetAsync((char*)d_ws + WS_CTL, 0, CTL_BYTES, stream);
    Args a{};
    for (int i = 0; i < 22; ++i) a.in[i] = (const float*)d_in[i];
    a.out = (float*)d_out; a.ws = (unsigned char*)d_ws;
#if MK_PER_PHASE
    for (int k = 0; k < P_COUNT; ++k) { a.ph_lo = k; a.ph_hi = k + 1; hipLaunchKernelGGL(fwd_kernel, dim3(grid), dim3(512), LDS_BYTES, stream, a); }
#else
    a.ph_lo = 0; a.ph_hi = P_COUNT;
    hipLaunchKernelGGL(fwd_kernel, dim3(grid), dim3(512), LDS_BYTES, stream, a);
#endif
}
```

```cpp
#include <hip/hip_runtime.h>
#include <cstdio>
#include <cstdint>

#ifndef MK_PER_PHASE
#define MK_PER_PHASE 0
#endif
#ifndef PROBE_GAIN
#define PROBE_GAIN 92.0f
#endif
#ifndef PROBE_GROUP
#define PROBE_GROUP 0
#endif
#ifndef NAIVE_RET
#define NAIVE_RET 0
#endif
#ifndef NAIVE_SB
#define NAIVE_SB 0
#endif

#define GAS __attribute__((address_space(1)))
#define LAS __attribute__((address_space(3)))
typedef unsigned short bf16_t;
typedef short bf16x8 __attribute__((ext_vector_type(8)));
typedef float f32x4 __attribute__((ext_vector_type(4)));
typedef float f32x2 __attribute__((ext_vector_type(2)));
typedef unsigned u32x4 __attribute__((ext_vector_type(4)));
typedef unsigned u32x2 __attribute__((ext_vector_type(2)));

constexpr int D = 1024, NBATCH = 16, SEQ = 2048, NMETA = 16;
constexpr int MREAL = NBATCH * SEQ;
constexpr int MVALID = MREAL + NMETA;
constexpr int MROWS = 33024;
constexpr int FF = 2816, NE = 8;
constexpr int LPOS = SEQ + NMETA;
constexpr float EPS = 1e-6f;
constexpr int MOE_ROWS = 67840;

constexpr size_t MiB = 1u << 20;
constexpr size_t WS_CTL = 0, CTL_BYTES = 1 * MiB;
constexpr int CW_BAR = 4096;
constexpr size_t CTL_SROW = 64 * 1024;
constexpr size_t CTL_MOE = 512 * 1024;
constexpr size_t WS_SSQ = 1 * MiB;
constexpr size_t WS_GST = 20 * MiB;
constexpr size_t WS_WA = 29 * MiB, WS_WB = 185 * MiB, WS_H = 221 * MiB, WS_TAB = 289 * MiB, WS_MISC = 291 * MiB, WS_POOL = 297 * MiB, WS_END = 795 * MiB;
static_assert(WS_SSQ + (size_t)9 * MROWS * 64 <= WS_GST && WS_GST + (size_t)MROWS * 8 * 8 * 4 <= WS_WA, "ssq/gst");
constexpr size_t WA_MOE13 = 0, WA_MOE2 = (size_t)NE * 5632 * 1024, WA_MIX = WA_MOE2 + (size_t)NE * 1024 * 2816;
constexpr size_t WA_MIX_WO_SB = WA_MIX + (size_t)3072 * 1024, WA_MIX_WO_RET = WA_MIX + (size_t)6144 * 1024;
constexpr size_t WB_MIX = 0, WB_WO = (size_t)6144 * 1024, WB_W13 = WB_WO + (size_t)1024 * 2048, WB_W2 = WB_W13 + (size_t)5632 * 1024;
static_assert((WA_MIX + 8388608) * 2 <= 156 * MiB && (WB_W2 + (size_t)1024 * 2816) * 2 <= 36 * MiB, "weight regions");
constexpr size_t MISC_TOKE = 0, MISC_TOKG = 512 * 1024, MISC_TOKR = 1024 * 1024, MISC_TOKP = 1536 * 1024, MISC_RSTDS = 2 * MiB, MISC_GATES = 2 * MiB + 512 * 1024, MISC_YM = 3 * MiB;
constexpr size_t ACT1 = (size_t)MROWS * 1024 * 2;
constexpr size_t PO_Q = 0, PO_K = ACT1, PO_V = 2 * ACT1, PO_G = 4 * ACT1;
constexpr size_t PO_HID = 0, PO_D = 0;
constexpr size_t PO_XS = 0, PO_MHID = 133 * MiB;
static_assert(PO_G + 2 * ACT1 <= 498 * MiB && PO_MHID + (size_t)MOE_ROWS * FF * 2 <= 498 * MiB && (size_t)MOE_ROWS * 2048 <= 133 * MiB, "pool");

constexpr int RING_BYTES = 147456;
constexpr int LDSCTL_OFF = RING_BYTES;
constexpr int LDS_PEXP = LDSCTL_OFF + 256;
constexpr int LDS_BYTES = 163840;

__device__ __forceinline__ unsigned f2bf(float f) { unsigned u = __builtin_bit_cast(unsigned, f); return (u + 0x7fffu + ((u >> 16) & 1u)) >> 16; }
typedef __bf16 bf16x2_t __attribute__((ext_vector_type(2)));
__device__ __forceinline__ unsigned pk2(float lo, float hi) { const f32x2 v = {lo, hi}; const bf16x2_t b = __builtin_convertvector(v, bf16x2_t); return __builtin_bit_cast(unsigned, b); }
__device__ __forceinline__ float bflo(unsigned u) { return __builtin_bit_cast(float, u << 16); }
__device__ __forceinline__ float bfhi(unsigned u) { return __builtin_bit_cast(float, u & 0xffff0000u); }
__device__ __forceinline__ float bf1(bf16_t u) { return __builtin_bit_cast(float, ((unsigned)u) << 16); }
__device__ __forceinline__ float fast_rcp(float x) { return __builtin_amdgcn_rcpf(x); }
__device__ __forceinline__ float fast_exp2(float x) { return __builtin_amdgcn_exp2f(x); }
__device__ __forceinline__ float silu_f(float v) { return v * fast_rcp(1.0f + fast_exp2(-1.4426950408889634f * v)); }
__device__ __forceinline__ float wave_sum(float v) {
#pragma unroll
    for (int o = 1; o < 64; o <<= 1) v += __shfl_xor(v, o);
    return v;
}
__device__ __forceinline__ int row_pos(int row) { return row < MREAL ? NMETA + (row & (SEQ - 1)) : (row - MREAL < NMETA ? row - MREAL : NMETA - 1); }
__device__ __forceinline__ int pos_row(int b, int p) { return p < NMETA ? MREAL + p : b * SEQ + p - NMETA; }
#define LDS_WAIT() asm volatile("s_waitcnt lgkmcnt(0)" ::: "memory")

namespace pg8 {
constexpr int BM = 256, BK = 64, HALF = 128, HTB = HALF * BK * 2, NXCD = 8, WGM = 8;
__host__ __device__ __forceinline__ int lds_byte(int r, int c) { const int st = (r >> 4) * 2 + (c >> 5), rr = r & 15, cc = c & 31, ob = rr * 64 + cc * 2; return st * 1024 + (ob ^ (((ob >> 9) & 1) << 5)); }
__host__ __device__ __forceinline__ void stage_rc(int b, int& R, int& C) { const int st = b / 1024, sb = b % 1024, swz = sb ^ (((sb >> 9) & 1) << 5); R = (st >> 1) * 16 + swz / 64; C = (st & 1) * 32 + (swz % 64) / 2; }
__host__ __device__ __forceinline__ int perm32(int rho) { const int n = rho >> 4, i = rho & 15; return 8 * (i >> 2) + 4 * n + (i & 3); }
struct Unit { int pm, pn; };

template <bool MOE> struct Sched {
    int nM, nN, nwg, G, c; const char* A; const char* Bt; size_t a_pm, a_pn, b_pn, b_e; const LAS int* pexp;
    __device__ __forceinline__ bool next(int i, Unit& u) const {
        const long L = (long)i * G + c; if (L >= nwg) return false;
        int wgid = (int)L; { const int q = nwg / NXCD, r = nwg % NXCD, xcd = wgid % NXCD, off = wgid / NXCD; wgid = (xcd < r ? xcd * (q + 1) : r * (q + 1) + (xcd - r) * q) + off; }
        const int nig = WGM * nN, gid = wgid / nig, fm = gid * WGM, gsz = (nM - fm) < WGM ? (nM - fm) : WGM;
        u.pm = fm + ((wgid % nig) % gsz); u.pn = (wgid % nig) / gsz; return true;
    }
    __device__ __forceinline__ const char* aptr(const Unit& u) const { return A + (size_t)u.pm * a_pm + (size_t)u.pn * a_pn; }
    __device__ __forceinline__ const char* bptr(const Unit& u) const { const char* b = Bt + (size_t)u.pn * b_pn; if constexpr (MOE) b += (size_t)pexp[u.pm] * b_e; return b; }
};

template <class Epi, class SchedT>
__device__ __forceinline__ void gemm_phase(LAS unsigned char* lds, const int K, const int lda, const SchedT& S, const Epi& E) {
    const int tid = threadIdx.x, wid = __builtin_amdgcn_readfirstlane(tid >> 6), lane = tid & 63, wr = wid >> 2, wc = wid & 3, fr = lane & 15, fq = lane >> 4;
    const int nt = K / BK;
    unsigned voffA[2], voffB[2];
#pragma unroll
    for (int i = 0; i < 2; ++i) { int R, C; stage_rc(tid * 16 + i * 8192, R, C); const int Rb = (R & ~31) + perm32(R & 31);
        voffA[i] = (unsigned)(R * lda + C) * 2u; voffB[i] = (unsigned)(Rb * K + C) * 2u; }
    const size_t kstep = (size_t)(BK * 2);
    const size_t hstepA = (size_t)HALF * lda * 2, hstepB = (size_t)HALF * K * 2;
    const unsigned ldsw = (unsigned)wid * 1024u;
    const int aoff = lds_byte(wr * 64 + fr, fq * 8), boff = lds_byte(wc * 32 + fr, fq * 8);
#define PG8_SA(b, h) (((b) * 2 + (h)) * HTB)
#define PG8_SB(b, h) ((4 + (b) * 2 + (h)) * HTB)
#define PG8_STAGE(bufoff, gbase, voff) do { _Pragma("unroll") for (int _i = 0; _i < 2; ++_i) \
        __builtin_amdgcn_global_load_lds((const unsigned*)((const char*)(gbase) + (voff)[_i]), (LAS unsigned*)(lds + (bufoff) + ldsw + _i * 8192), 16, 0, 0); } while (0)
#define PG8_LDA(dst, b, h) do { _Pragma("unroll") for (int m = 0; m < 4; ++m) _Pragma("unroll") for (int k = 0; k < 2; ++k) dst[m][k] = *(const LAS bf16x8*)(lds + PG8_SA(b, h) + aoff + m * 2048 + k * 1024); } while (0)
#define PG8_LDB(dst, b, h) do { _Pragma("unroll") for (int n = 0; n < 2; ++n) _Pragma("unroll") for (int k = 0; k < 2; ++k) dst[n][k] = *(const LAS bf16x8*)(lds + PG8_SB(b, h) + boff + n * 2048 + k * 1024); } while (0)
#define PG8_MMA(ai, bj, At, Bt) do { __builtin_amdgcn_s_setprio(1); _Pragma("unroll") for (int m = 0; m < 4; ++m) _Pragma("unroll") for (int n = 0; n < 2; ++n) _Pragma("unroll") for (int k = 0; k < 2; ++k) \
        acc[ai][bj][m][n] = __builtin_amdgcn_mfma_f32_16x16x32_bf16(Bt[n][k], At[m][k], acc[ai][bj][m][n], 0, 0, 0); __builtin_amdgcn_s_setprio(0); } while (0)
#define PG8_WAIT_V(n) asm volatile("s_waitcnt vmcnt(" #n ")" ::: "memory")
#define PG8_WAIT_L(n) asm volatile("s_waitcnt lgkmcnt(" #n ")" ::: "memory")
#define PG8_BAR __builtin_amdgcn_s_barrier()
#define PG8_SCHED __builtin_amdgcn_sched_barrier(0)
    Unit cur, nxt; int ui = 0;
    if (!S.next(0, cur)) return;
    f32x4 acc[2][2][4][2];
#pragma unroll
    for (int a = 0; a < 2; ++a)
#pragma unroll
        for (int b = 0; b < 2; ++b)
#pragma unroll
            for (int m = 0; m < 4; ++m)
#pragma unroll
                for (int n = 0; n < 2; ++n) acc[a][b][m][n] = (f32x4){0.f, 0.f, 0.f, 0.f};
    bf16x8 At[4][2], B0[2][2], B1[2][2];
    const char* cA = S.aptr(cur); const char* cB = S.bptr(cur);
    PG8_STAGE(PG8_SB(0, 0), cB, voffB); PG8_STAGE(PG8_SB(0, 1), cB + hstepB, voffB); PG8_STAGE(PG8_SA(0, 0), cA, voffA); PG8_STAGE(PG8_SA(0, 1), cA + hstepA, voffA);
    if (wr == 1) PG8_BAR;
    PG8_WAIT_V(2); PG8_BAR;
    PG8_STAGE(PG8_SB(1, 0), cB + kstep, voffB); PG8_STAGE(PG8_SA(1, 0), cA + kstep, voffA); PG8_STAGE(PG8_SB(1, 1), cB + hstepB + kstep, voffB);
    PG8_WAIT_V(6); PG8_BAR;
    for (;;) {
        const bool has_next = S.next(ui + 1, nxt);
        const char* nA = has_next ? S.aptr(nxt) : cA; const char* nB = has_next ? S.bptr(nxt) : cB;
        for (int t = 0; t < nt; t += 2) {
            const bool last = (t == nt - 2);
            const char* a1 = cA + (size_t)(t + 1) * kstep;
            const char* a2 = last ? nA : cA + (size_t)(t + 2) * kstep; const char* b2 = last ? nB : cB + (size_t)(t + 2) * kstep;
            const char* a3 = a2 + kstep; const char* b3 = b2 + kstep;
            PG8_LDB(B0, 0, 0); PG8_LDB(B1, 0, 1); PG8_SCHED; PG8_LDA(At, 0, 0); PG8_STAGE(PG8_SA(1, 1), a1 + hstepA, voffA);
            PG8_WAIT_V(8); PG8_WAIT_L(0); PG8_BAR; PG8_MMA(0, 0, At, B0); PG8_MMA(0, 1, At, B1); PG8_BAR; PG8_SCHED;
            PG8_LDA(At, 0, 1); PG8_STAGE(PG8_SB(0, 0), b2, voffB); PG8_STAGE(PG8_SB(0, 1), b2 + hstepB, voffB); PG8_STAGE(PG8_SA(0, 0), a2, voffA);
            PG8_WAIT_V(8); PG8_WAIT_L(0); PG8_BAR; PG8_MMA(1, 0, At, B0); PG8_MMA(1, 1, At, B1); PG8_BAR; PG8_SCHED;
            PG8_LDB(B0, 1, 0); PG8_LDB(B1, 1, 1); PG8_SCHED; PG8_LDA(At, 1, 0); PG8_STAGE(PG8_SA(0, 1), a2 + hstepA, voffA);
            PG8_WAIT_V(8); PG8_WAIT_L(0); PG8_BAR; PG8_MMA(0, 0, At, B0); PG8_MMA(0, 1, At, B1); PG8_BAR; PG8_SCHED;
            PG8_LDA(At, 1, 1); PG8_STAGE(PG8_SB(1, 0), b3, voffB); PG8_STAGE(PG8_SB(1, 1), b3 + hstepB, voffB); PG8_STAGE(PG8_SA(1, 0), a3, voffA);
            PG8_WAIT_V(8); PG8_WAIT_L(0); PG8_BAR; PG8_MMA(1, 0, At, B0); PG8_MMA(1, 1, At, B1); PG8_BAR; PG8_SCHED;
        }
#if PROBE_GROUP == 9 || PROBE_GROUP == 61
        const unsigned long long _pt0 = __builtin_amdgcn_s_memrealtime();
#endif
        if (wr == 0) PG8_BAR;
        epi_tile(E, acc, cur, wr, wc, fr, fq);
#if PROBE_GROUP == 9
        asm volatile("" ::: "memory"); if (blockIdx.x == 0 && tid == 0) *(LAS unsigned long long*)(lds + LDSCTL_OFF + 8192) += __builtin_amdgcn_s_memrealtime() - _pt0;
#endif
#if PROBE_GROUP == 61
        asm volatile("" ::: "memory"); if (!Epi::BATCH && !Epi::HASPRE && blockIdx.x == 0 && tid == 0) *(LAS unsigned long long*)(lds + LDSCTL_OFF + 8192) += __builtin_amdgcn_s_memrealtime() - _pt0;
#endif
        if (!has_next) break;
#pragma unroll
        for (int a = 0; a < 2; ++a)
#pragma unroll
            for (int b = 0; b < 2; ++b)
#pragma unroll
                for (int m = 0; m < 4; ++m)
#pragma unroll
                    for (int n = 0; n < 2; ++n) acc[a][b][m][n] = (f32x4){0.f, 0.f, 0.f, 0.f};
        cur = nxt; cA = nA; cB = nB; ++ui;
        if (wr == 1) PG8_BAR;
    }
    PG8_WAIT_V(0);
    PG8_BAR;
#undef PG8_SA
#undef PG8_SB
#undef PG8_STAGE
#undef PG8_LDA
#undef PG8_LDB
#undef PG8_MMA
#undef PG8_WAIT_V
#undef PG8_WAIT_L
#undef PG8_BAR
#undef PG8_SCHED
}

__device__ __forceinline__ float clamp8(float x) { return __builtin_amdgcn_fmed3f(x, -448.0f, 448.0f); }
__device__ __forceinline__ u32x2 pack_fp8x8(float a0, float a1, float a2, float a3, float a4, float a5, float a6, float a7) {
    int lo = __builtin_amdgcn_cvt_pk_fp8_f32(clamp8(a0), clamp8(a1), 0, false); lo = __builtin_amdgcn_cvt_pk_fp8_f32(clamp8(a2), clamp8(a3), lo, true);
    int hi = __builtin_amdgcn_cvt_pk_fp8_f32(clamp8(a4), clamp8(a5), 0, false); hi = __builtin_amdgcn_cvt_pk_fp8_f32(clamp8(a6), clamp8(a7), hi, true);
    return (u32x2){(unsigned)lo, (unsigned)hi}; }
typedef f32x4 Acc[2][2][4][2];
__device__ __forceinline__ float gload1_asm(const float* p) { float v; asm volatile("global_load_dword %0, %1, off" : "=v"(v) : "v"(p) : "memory"); return v; }
__device__ __forceinline__ f32x4 gload4f_asm(const float* p) { f32x4 v; asm volatile("global_load_dwordx4 %0, %1, off" : "=v"(v) : "v"(p) : "memory"); return v; }
__device__ __forceinline__ void gload4f_tied(f32x4& v, const float* p) { asm volatile("global_load_dwordx4 %0, %1, off" : "+v"(v) : "v"(p) : "memory"); }
#define PG8_WAIT_PIN8(r) asm volatile("s_waitcnt vmcnt(0)" : "+v"(r[0][0]), "+v"(r[0][1]), "+v"(r[0][2]), "+v"(r[0][3]), "+v"(r[1][0]), "+v"(r[1][1]), "+v"(r[1][2]), "+v"(r[1][3]) : : "memory")
template <bool ROW> struct PreRaw { typedef f32x4 T; };
template <> struct PreRaw<true> { typedef float T; };
__device__ __forceinline__ float rstd_fin(const f32x4 a) { float s = (a[0] + a[1]) + (a[2] + a[3]); s += __shfl_xor(s, 16); s += __shfl_xor(s, 32); return __builtin_amdgcn_rsqf(s * (1.0f / D) + EPS); }
__device__ __forceinline__ float rstd_of(const float* ssqp, int row) {
    const f32x4* p = (const f32x4*)(ssqp + (size_t)row * 16); const f32x4 a = p[0], b = p[1], c = p[2], d = p[3];
    const float s = ((a[0] + a[1]) + (a[2] + a[3])) + ((b[0] + b[1]) + (b[2] + b[3])) + ((c[0] + c[1]) + (c[2] + c[3])) + ((d[0] + d[1]) + (d[2] + d[3]));
    return __builtin_amdgcn_rsqf(s * (1.0f / D) + EPS); }
__device__ __forceinline__ float rstd_coop(const float* ssqp, int row, int fq) {
    const f32x4 a = *(const f32x4*)(ssqp + (size_t)row * 16 + 4 * fq);
    float s = (a[0] + a[1]) + (a[2] + a[3]);
    s += __shfl_xor(s, 16); s += __shfl_xor(s, 32);
    return __builtin_amdgcn_rsqf(s * (1.0f / D) + EPS); }
__device__ __forceinline__ void ssq_store_single(float* ssqp, int row, float ss, int lane) { if (lane < 16) ssqp[(size_t)row * 16 + lane] = (lane == 0) ? ss : 0.f; }
template <class Epi> __device__ __forceinline__ void epi_tile(const Epi& E, const Acc& acc, const Unit& u, int wr, int wc, int fr, int fq) {
    if constexpr (Epi::BATCH) { E.tile(acc, u, wr, wc, fr, fq); return; }
    else if constexpr (Epi::HASPRE) {
        typename Epi::Raw raw[2][4]; float pre[2][4];
#pragma unroll
        for (int ai = 0; ai < 2; ++ai)
#pragma unroll
            for (int m = 0; m < 4; ++m) raw[ai][m] = E.pre_load(u.pm * BM + ai * HALF + wr * 64 + m * 16 + fr, fq);
        PG8_WAIT_PIN8(raw);
#pragma unroll
        for (int ai = 0; ai < 2; ++ai)
#pragma unroll
            for (int m = 0; m < 4; ++m) pre[ai][m] = E.pre_fin(raw[ai][m], fq);
#pragma unroll
        for (int ai = 0; ai < 2; ++ai)
#pragma unroll
            for (int m = 0; m < 4; ++m) E.frag(u.pm * BM + ai * HALF + wr * 64 + m * 16 + fr, u.pn, wc, fq, pre[ai][m], acc[ai][0][m][0], acc[ai][0][m][1], acc[ai][1][m][0], acc[ai][1][m][1]);
    } else {
#pragma unroll
        for (int ai = 0; ai < 2; ++ai)
#pragma unroll
            for (int m = 0; m < 4; ++m) E.frag(u.pm * BM + ai * HALF + wr * 64 + m * 16 + fr, u.pn, wc, fq, acc[ai][0][m][0], acc[ai][0][m][1], acc[ai][1][m][0], acc[ai][1][m][1]);
    }
}
template <class Epi> __device__ __forceinline__ void epi_frag(const Epi& E, int row, int pn, int wc, int fq, const f32x4 a00, const f32x4 a01, const f32x4 a10, const f32x4 a11) {
    if constexpr (Epi::HASPRE) { typename Epi::Raw r = E.pre_load(row, fq); asm volatile("s_waitcnt vmcnt(0)" : "+v"(r) : : "memory"); E.frag(row, pn, wc, fq, E.pre_fin(r, fq), a00, a01, a10, a11); }
    else E.frag(row, pn, wc, fq, a00, a01, a10, a11);
}

template <int MODE> struct EpiProj {
    static constexpr bool BATCH = true, HASPRE = false;
    const float* ssq; const f32x2* tab; bf16_t* Q; bf16_t* Kk; bf16_t* V; bf16_t* Gt; float ascale;
    __device__ __forceinline__ void tile(const Acc& acc, const Unit& u, int wr, int wc, int fr, int fq) const {
        const int pn = u.pn; int seg, colt, ld; size_t boff;
        if (MODE == 0) { if (pn < 4) { seg = 0; colt = pn * 256; ld = 1024; boff = PO_Q; } else if (pn < 8) { seg = 1; colt = (pn - 4) * 256; ld = 1024; boff = PO_K; }
                         else if (pn < 16) { seg = 2; colt = (pn - 8) * 256; ld = 2048; boff = PO_V; } else { seg = 3; colt = (pn - 16) * 256; ld = 2048; boff = PO_G; } }
        else { ld = 1024; if (pn < 4) { seg = 4; colt = pn * 256; boff = PO_Q; } else if (pn < 8) { seg = 2; colt = (pn - 4) * 256; boff = PO_K; } else { seg = 2; colt = (pn - 8) * 256; boff = PO_V; } }
        bf16_t* base = (bf16_t*)((unsigned char*)Q + boff);
        const int col0 = colt + wc * 32 + 8 * fq, row0 = u.pm * BM + wr * 64 + fr;
        f32x4 raw[2][4]; float rsv[2][4];
#pragma unroll
        for (int ai = 0; ai < 2; ++ai)
#pragma unroll
            for (int m = 0; m < 4; ++m) raw[ai][m] = gload4f_asm(ssq + (size_t)(row0 + ai * HALF + m * 16) * 16 + 4 * fq);
        PG8_WAIT_PIN8(raw);
#pragma unroll
        for (int ai = 0; ai < 2; ++ai)
#pragma unroll
            for (int m = 0; m < 4; ++m) rsv[ai][m] = rstd_fin(raw[ai][m]);
        if (MODE == 0 && seg < 2) {
            asm volatile("" ::: "memory");
            float invr[2][4], l2g[2];
#pragma unroll
            for (int bj = 0; bj < 2; ++bj) { const int i0 = ((col0 + bj * HALF) & 127) >> 1;
#pragma unroll
                for (int jj = 0; jj < 4; ++jj) invr[bj][jj] = fast_exp2(-(float)(i0 + jj) * (13.287712379549449f / 64.0f)) * 0.15915494309189535f;
                const int hh = ((pn & 3) << 1) + bj; l2g[bj] = __builtin_amdgcn_logf(1.0f - fast_exp2(-5.0f - (float)hh)) * (seg == 0 ? 1.0f : -1.0f); }
            const float kscale = (seg == 1) ? 0.08838834764831845f : 1.0f;
#pragma unroll
            for (int ai = 0; ai < 2; ++ai)
#pragma unroll
                for (int m = 0; m < 4; ++m) {
                    const int row = row0 + ai * HALF + m * 16; const float rs = rsv[ai][m] * (kscale * ascale);
                    const float pf = (float)row_pos(row); const float cl = (float)(row & 127);
#pragma unroll
                    for (int bj = 0; bj < 2; ++bj) {
                        const float ks = NAIVE_RET ? rs : rs * fast_exp2(cl * l2g[bj]);
                        const f32x4 v0 = acc[ai][bj][m][0] * ks, v1 = acc[ai][bj][m][1] * ks;
                        float c[4], sn[4];
#pragma unroll
                        for (int jj = 0; jj < 4; ++jj) { const float rev = __builtin_amdgcn_fractf(pf * invr[bj][jj]); c[jj] = __builtin_amdgcn_cosf(rev); sn[jj] = __builtin_amdgcn_sinf(rev); }
                        u32x4 w;
                        w.x = pk2(v0[0] * c[0] - v0[1] * sn[0], v0[0] * sn[0] + v0[1] * c[0]); w.y = pk2(v0[2] * c[1] - v0[3] * sn[1], v0[2] * sn[1] + v0[3] * c[1]);
                        w.z = pk2(v1[0] * c[2] - v1[1] * sn[2], v1[0] * sn[2] + v1[1] * c[2]); w.w = pk2(v1[2] * c[3] - v1[3] * sn[3], v1[2] * sn[3] + v1[3] * c[3]);
                        *(u32x4*)(base + (size_t)row * ld + col0 + bj * HALF) = w;
                    }
                }
        } else if (MODE == 0 && seg == 3) {
            asm volatile("" ::: "memory");
#pragma unroll
            for (int ai = 0; ai < 2; ++ai)
#pragma unroll
                for (int m = 0; m < 4; ++m) {
                    const int row = row0 + ai * HALF + m * 16; const float rs = rsv[ai][m] * ascale; const float nrs = -1.4426950408889634f * rs;
#pragma unroll
                    for (int bj = 0; bj < 2; ++bj) {
                        const f32x4 a0 = acc[ai][bj][m][0], a1 = acc[ai][bj][m][1];
                        f32x4 e0 = a0 * nrs, e1 = a1 * nrs;
#pragma unroll
                        for (int j = 0; j < 4; ++j) { e0[j] = fast_exp2(e0[j]); e1[j] = fast_exp2(e1[j]); }
                        e0 = e0 + 1.0f; e1 = e1 + 1.0f;
#pragma unroll
                        for (int j = 0; j < 4; ++j) { e0[j] = fast_rcp(e0[j]); e1[j] = fast_rcp(e1[j]); }
                        const f32x4 o0 = a0 * (e0 * rs), o1 = a1 * (e1 * rs);
                        u32x4 w; w.x = pk2(o0[0], o0[1]); w.y = pk2(o0[2], o0[3]); w.z = pk2(o1[0], o1[1]); w.w = pk2(o1[2], o1[3]);
                        *(u32x4*)(base + (size_t)row * ld + col0 + bj * HALF) = w;
                    }
                }
        } else {
            asm volatile("" ::: "memory");
            const float sc = (MODE == 1 && seg == 4) ? 0.18033688011112042f : 1.0f;
#pragma unroll
            for (int ai = 0; ai < 2; ++ai)
#pragma unroll
                for (int m = 0; m < 4; ++m) {
                    const int row = row0 + ai * HALF + m * 16; const float rs = rsv[ai][m] * (sc * ascale);
#pragma unroll
                    for (int bj = 0; bj < 2; ++bj) {
                        const f32x4 v0 = acc[ai][bj][m][0] * rs, v1 = acc[ai][bj][m][1] * rs;
                        u32x4 w; w.x = pk2(v0[0], v0[1]); w.y = pk2(v0[2], v0[3]); w.z = pk2(v1[0], v1[1]); w.w = pk2(v1[2], v1[3]);
                        *(u32x4*)(base + (size_t)row * ld + col0 + bj * HALF) = w;
                    }
                }
        }
    }
    __device__ __forceinline__ void frag(int row, int pn, int wc, int fq, const f32x4 a00, const f32x4 a01, const f32x4 a10, const f32x4 a11) const {
        int seg, colt, ld; size_t boff;
        if (MODE == 0) { if (pn < 4) { seg = 0; colt = pn * 256; ld = 1024; boff = PO_Q; } else if (pn < 8) { seg = 1; colt = (pn - 4) * 256; ld = 1024; boff = PO_K; }
                         else if (pn < 16) { seg = 2; colt = (pn - 8) * 256; ld = 2048; boff = PO_V; } else { seg = 3; colt = (pn - 16) * 256; ld = 2048; boff = PO_G; } }
        else { ld = 1024; if (pn < 4) { seg = 4; colt = pn * 256; boff = PO_Q; } else if (pn < 8) { seg = 2; colt = (pn - 4) * 256; boff = PO_K; } else { seg = 2; colt = (pn - 8) * 256; boff = PO_V; } }
        bf16_t* base = (bf16_t*)((unsigned char*)Q + boff);
        const int col0 = colt + wc * 32 + 8 * fq;
        const float rs = rstd_coop(ssq, row, fq) * ((MODE == 1 && seg == 4) ? 0.18033688011112042f : 1.0f) * ascale;
        const int p = row_pos(row);
#pragma unroll
        for (int bj = 0; bj < 2; ++bj) {
            f32x4 v0 = (bj ? a10 : a00) * rs, v1 = (bj ? a11 : a01) * rs;
            const int col = col0 + bj * HALF;
            if (MODE == 0 && seg < 2) {
                const int i0 = (col & 127) >> 1; const float pf = (float)p;
                f32x4 t0, t1;
#pragma unroll
                for (int jj = 0; jj < 4; ++jj) {
                    const float invr = fast_exp2(-(float)(i0 + jj) * (13.287712379549449f / 64.0f)) * 0.15915494309189535f;
                    const float rev = __builtin_amdgcn_fractf(pf * invr);
                    const float c = __builtin_amdgcn_cosf(rev), sn = __builtin_amdgcn_sinf(rev);
                    if (jj < 2) { t0[2 * jj] = c; t0[2 * jj + 1] = sn; } else { t1[2 * (jj - 2)] = c; t1[2 * (jj - 2) + 1] = sn; }
                }
                f32x4 o0, o1;
                o0[0] = v0[0] * t0[0] - v0[1] * t0[1]; o0[1] = v0[0] * t0[1] + v0[1] * t0[0];
                o0[2] = v0[2] * t0[2] - v0[3] * t0[3]; o0[3] = v0[2] * t0[3] + v0[3] * t0[2];
                o1[0] = v1[0] * t1[0] - v1[1] * t1[1]; o1[1] = v1[0] * t1[1] + v1[1] * t1[0];
                o1[2] = v1[2] * t1[2] - v1[3] * t1[3]; o1[3] = v1[2] * t1[3] + v1[3] * t1[2];
                float ks = (seg == 1) ? 0.08838834764831845f : 1.0f;
                if (!NAIVE_RET) {
                    const int hh = ((pn & 3) << 1) + bj; const float l2g = __builtin_amdgcn_logf(1.0f - fast_exp2(-5.0f - (float)hh));
                    const int cl = row < MREAL ? (row & 127) : 112 + ((row - MREAL) & 15);
                    ks *= fast_exp2((seg == 0 ? (float)cl : -(float)cl) * l2g);
                }
                v0 = o0 * ks; v1 = o1 * ks;
            }
            if (MODE == 0 && seg == 3) {
#pragma unroll
                for (int j = 0; j < 4; ++j) { v0[j] = silu_f(v0[j]); v1[j] = silu_f(v1[j]); }
            }
            u32x4 w; w.x = pk2(v0[0], v0[1]); w.y = pk2(v0[2], v0[3]); w.z = pk2(v1[0], v1[1]); w.w = pk2(v1[2], v1[3]);
            *(u32x4*)(base + (size_t)row * ld + col) = w;
        }
    }
};
struct EpiResid {
    static constexpr bool BATCH = true, HASPRE = false;
    bf16_t* H; float* ssq_out; const float* colscale; unsigned char* H8; float ascale;
    __device__ __forceinline__ void frag_r(int row, int pn, int wc, int fq, const u32x4 hv0, const u32x4 hv1, const f32x4 c00, const f32x4 c01, const f32x4 c10, const f32x4 c11,
                                           const f32x4 a00, const f32x4 a01, const f32x4 a10, const f32x4 a11) const {
        const int col0 = pn * BM + wc * 32 + 8 * fq; float ss = 0.f;
#pragma unroll
        for (int bj = 0; bj < 2; ++bj) {
            f32x4 a0 = (bj ? a10 : a00) * ascale, a1 = (bj ? a11 : a01) * ascale;
            if (colscale) { a0 = a0 * (bj ? c10 : c00); a1 = a1 * (bj ? c11 : c01); }
            bf16_t* hp = H + (size_t)row * D + col0 + bj * HALF;
            const u32x4 hv = bj ? hv1 : hv0;
            u32x4 w;
            w.x = pk2(bflo(hv.x) + a0[0], bfhi(hv.x) + a0[1]); w.y = pk2(bflo(hv.y) + a0[2], bfhi(hv.y) + a0[3]);
            w.z = pk2(bflo(hv.z) + a1[0], bfhi(hv.z) + a1[1]); w.w = pk2(bflo(hv.w) + a1[2], bfhi(hv.w) + a1[3]);
            *(u32x4*)hp = w;
            if (H8) *(u32x2*)(H8 + (size_t)row * D + col0 + bj * HALF) = pack_fp8x8(bflo(w.x), bfhi(w.x), bflo(w.y), bfhi(w.y), bflo(w.z), bfhi(w.z), bflo(w.w), bfhi(w.w));
            ss += bflo(w.x) * bflo(w.x) + bfhi(w.x) * bfhi(w.x) + bflo(w.y) * bflo(w.y) + bfhi(w.y) * bfhi(w.y)
                + bflo(w.z) * bflo(w.z) + bfhi(w.z) * bfhi(w.z) + bflo(w.w) * bflo(w.w) + bfhi(w.w) * bfhi(w.w);
        }
        ss += __shfl_xor(ss, 16); ss += __shfl_xor(ss, 32);
        if (fq == 0) ssq_out[(size_t)row * 16 + pn * 4 + wc] = ss;
    }
    __device__ __forceinline__ void frag(int row, int pn, int wc, int fq, const f32x4 a00, const f32x4 a01, const f32x4 a10, const f32x4 a11) const {
        const int col0 = pn * BM + wc * 32 + 8 * fq;
        const u32x4 hv0 = *(const u32x4*)(H + (size_t)row * D + col0), hv1 = *(const u32x4*)(H + (size_t)row * D + col0 + HALF);
        f32x4 c00 = {1.f, 1.f, 1.f, 1.f}, c01 = c00, c10 = c00, c11 = c00;
        if (colscale) { c00 = *(const f32x4*)(colscale + col0); c01 = *(const f32x4*)(colscale + col0 + 4); c10 = *(const f32x4*)(colscale + col0 + HALF); c11 = *(const f32x4*)(colscale + col0 + HALF + 4); }
        frag_r(row, pn, wc, fq, hv0, hv1, c00, c01, c10, c11, a00, a01, a10, a11);
    }
    __device__ __forceinline__ void tile(const Acc& acc, const Unit& u, int wr, int wc, int fr, int fq) const {
        const int col0 = u.pn * BM + wc * 32 + 8 * fq, row0 = u.pm * BM + wr * 64 + fr;
        f32x4 c00 = {1.f, 1.f, 1.f, 1.f}, c01 = c00, c10 = c00, c11 = c00;
        if (colscale) { c00 = *(const f32x4*)(colscale + col0); c01 = *(const f32x4*)(colscale + col0 + 4); c10 = *(const f32x4*)(colscale + col0 + HALF); c11 = *(const f32x4*)(colscale + col0 + HALF + 4); }
#pragma unroll
        for (int ai = 0; ai < 2; ++ai) {
            f32x4 r[2][4];
#pragma unroll
            for (int m = 0; m < 4; ++m) { const bf16_t* hp = H + (size_t)(row0 + ai * HALF + m * 16) * D + col0; r[0][m] = gload4f_asm((const float*)hp); r[1][m] = gload4f_asm((const float*)(hp + HALF)); }
            PG8_WAIT_PIN8(r);
#pragma unroll
            for (int m = 0; m < 4; ++m) frag_r(row0 + ai * HALF + m * 16, u.pn, wc, fq, __builtin_bit_cast(u32x4, r[0][m]), __builtin_bit_cast(u32x4, r[1][m]), c00, c01, c10, c11,
                                               acc[ai][0][m][0], acc[ai][0][m][1], acc[ai][1][m][0], acc[ai][1][m][1]);
        }
    }
};
template <bool ROWRSTD> struct EpiSwiglu {
    static constexpr bool BATCH = false, HASPRE = true;
    const float* rsrc; bf16_t* HID;
    typedef typename PreRaw<ROWRSTD>::T Raw;
    __device__ __forceinline__ Raw pre_load(int row, int fq) const { if constexpr (ROWRSTD) return gload1_asm(rsrc + row); else return gload4f_asm(rsrc + (size_t)row * 16 + 4 * fq); }
    __device__ __forceinline__ float pre_fin(const Raw r, int fq) const { if constexpr (ROWRSTD) return r; else return rstd_fin(r); }
    __device__ __forceinline__ void frag(int row, int pn, int wc, int fq, const float rs, const f32x4 a00, const f32x4 a01, const f32x4 a10, const f32x4 a11) const {
        const int col0 = pn * HALF + wc * 32 + 8 * fq;
        const float nrs = -1.4426950408889634f * rs, rs2 = rs * rs;
        f32x4 e0 = a00 * nrs, e1 = a01 * nrs;
#pragma unroll
        for (int j = 0; j < 4; ++j) { e0[j] = fast_exp2(e0[j]); e1[j] = fast_exp2(e1[j]); }
        e0 = e0 + 1.0f; e1 = e1 + 1.0f;
#pragma unroll
        for (int j = 0; j < 4; ++j) { e0[j] = fast_rcp(e0[j]); e1[j] = fast_rcp(e1[j]); }
        const f32x4 o0 = (a00 * a10) * (e0 * rs2), o1 = (a01 * a11) * (e1 * rs2);
        u32x4 w; w.x = pk2(o0[0], o0[1]); w.y = pk2(o0[2], o0[3]); w.z = pk2(o1[0], o1[1]); w.w = pk2(o1[2], o1[3]);
        *(u32x4*)(HID + (size_t)row * FF + col0) = w;
    }
};
struct EpiMoeW2 {
    static constexpr bool BATCH = false, HASPRE = true;
    const float* gate; bf16_t* YS;
    typedef float Raw;
    __device__ __forceinline__ Raw pre_load(int row, int fq) const { return gload1_asm(gate + row); }
    __device__ __forceinline__ float pre_fin(const Raw r, int fq) const { return r; }
    __device__ __forceinline__ void frag(int row, int pn, int wc, int fq, const float g, const f32x4 a00, const f32x4 a01, const f32x4 a10, const f32x4 a11) const {
        const int col0 = pn * BM + wc * 32 + 8 * fq;
#pragma unroll
        for (int bj = 0; bj < 2; ++bj) {
            const f32x4 v0 = (bj ? a10 : a00) * g, v1 = (bj ? a11 : a01) * g;
            u32x4 w; w.x = pk2(v0[0], v0[1]); w.y = pk2(v0[2], v0[3]); w.z = pk2(v1[0], v1[1]); w.w = pk2(v1[2], v1[3]);
            *(u32x4*)(YS + (size_t)row * D + col0 + bj * HALF) = w;
        }
    }
};

typedef int v8i __attribute__((ext_vector_type(8)));
typedef int v4i __attribute__((ext_vector_type(4)));
__host__ __device__ __forceinline__ int lds_byte8(int r, int cb) { const int st = (r >> 4) * 2 + (cb >> 6), rr = r & 15, cc = cb & 63, ob = rr * 64 + cc; return st * 1024 + (ob ^ (((ob >> 9) & 1) << 4)); }
__host__ __device__ __forceinline__ void stage_rc8(int b, int& R, int& Cb) { const int st = b / 1024, sb = b % 1024, swz = sb ^ (((sb >> 9) & 1) << 4); R = (st >> 1) * 16 + swz / 64; Cb = (st & 1) * 64 + (swz % 64); }
template <class Epi, class SchedT>
__device__ __forceinline__ void gemm_phase8(LAS unsigned char* lds, const int K  , const int lda  , const SchedT& S, const Epi& E) {
    const int tid = threadIdx.x, wid = __builtin_amdgcn_readfirstlane(tid >> 6), lane = tid & 63, wr = wid >> 2, wc = wid & 3, fr = lane & 15, fq = lane >> 4;
    const int nt = K / 128;
    unsigned voffA[2], voffB[2];
#pragma unroll
    for (int i = 0; i < 2; ++i) { int R, Cb; stage_rc8(tid * 16 + i * 8192, R, Cb); const int Rb = (R & ~31) + perm32(R & 31);
        voffA[i] = (unsigned)(R * lda + Cb); voffB[i] = (unsigned)(Rb * K + Cb); }
    const size_t kstep = 128;
    const size_t hstepA = (size_t)HALF * lda, hstepB = (size_t)HALF * K;
    const unsigned ldsw = (unsigned)wid * 1024u;
    const int a0 = lds_byte8(wr * 64 + fr, 32 * fq), a1 = lds_byte8(wr * 64 + fr, 32 * fq + 16), b0 = lds_byte8(wc * 32 + fr, 32 * fq), b1 = lds_byte8(wc * 32 + fr, 32 * fq + 16);
#define PG8_SA(b, h) (((b) * 2 + (h)) * HTB)
#define PG8_SB(b, h) ((4 + (b) * 2 + (h)) * HTB)
#define PG8_STAGE(bufoff, gbase, voff) do { _Pragma("unroll") for (int _i = 0; _i < 2; ++_i) \
        __builtin_amdgcn_global_load_lds((const unsigned*)((const char*)(gbase) + (voff)[_i]), (LAS unsigned*)(lds + (bufoff) + ldsw + _i * 8192), 16, 0, 0); } while (0)
#define PG8_RD32(o0, o1) __builtin_shufflevector(*(const LAS v4i*)(lds + (o0)), *(const LAS v4i*)(lds + (o1)), 0, 1, 2, 3, 4, 5, 6, 7)
#define PG8_LDA(dst, b, h) do { _Pragma("unroll") for (int m = 0; m < 4; ++m) dst[m] = PG8_RD32(PG8_SA(b, h) + a0 + m * 2048, PG8_SA(b, h) + a1 + m * 2048); } while (0)
#define PG8_LDB(dst, b, h) do { _Pragma("unroll") for (int n = 0; n < 2; ++n) dst[n] = PG8_RD32(PG8_SB(b, h) + b0 + n * 2048, PG8_SB(b, h) + b1 + n * 2048); } while (0)
#define PG8_MMA(ai, bj, At, Bt) do { __builtin_amdgcn_s_setprio(1); _Pragma("unroll") for (int m = 0; m < 4; ++m) _Pragma("unroll") for (int n = 0; n < 2; ++n) \
        asm volatile("v_mfma_scale_f32_16x16x128_f8f6f4 %0, %1, %2, %0, %3, %3 op_sel_hi:[0,0,0]" : "+v"(acc[ai][bj][m][n]) : "v"(Bt[n]), "v"(At[m]), "v"(one8)); __builtin_amdgcn_s_setprio(0); } while (0)
#define PG8_MMA0(ai, bj, At, Bt) do { __builtin_amdgcn_s_setprio(1); _Pragma("unroll") for (int m = 0; m < 4; ++m) _Pragma("unroll") for (int n = 0; n < 2; ++n) \
        asm volatile("v_mfma_scale_f32_16x16x128_f8f6f4 %0, %1, %2, 0, %3, %3 op_sel_hi:[0,0,0]" : "=&v"(acc[ai][bj][m][n]) : "v"(Bt[n]), "v"(At[m]), "v"(one8)); __builtin_amdgcn_s_setprio(0); } while (0)
#define PG8_WAIT_V(n) asm volatile("s_waitcnt vmcnt(" #n ")" ::: "memory")
#define PG8_WAIT_L(n) asm volatile("s_waitcnt lgkmcnt(" #n ")" ::: "memory")
#define PG8_BAR __builtin_amdgcn_s_barrier()
#define PG8_SCHED __builtin_amdgcn_sched_barrier(0)
    int one8 = 0x7f7f7f7f; asm volatile("" : "+v"(one8));
    Unit cur, nxt; int ui = 0;
    if (!S.next(0, cur)) return;
    f32x4 acc[2][2][4][2];
#pragma unroll
    for (int a = 0; a < 2; ++a)
#pragma unroll
        for (int b = 0; b < 2; ++b)
#pragma unroll
            for (int m = 0; m < 4; ++m)
#pragma unroll
                for (int n = 0; n < 2; ++n) acc[a][b][m][n] = (f32x4){0.f, 0.f, 0.f, 0.f};
    v8i At[4], B0[2], B1[2];
    const char* cA = S.aptr(cur); const char* cB = S.bptr(cur);
    PG8_STAGE(PG8_SB(0, 0), cB, voffB); PG8_STAGE(PG8_SB(0, 1), cB + hstepB, voffB); PG8_STAGE(PG8_SA(0, 0), cA, voffA); PG8_STAGE(PG8_SA(0, 1), cA + hstepA, voffA);
    if (wr == 1) PG8_BAR;
    PG8_WAIT_V(2); PG8_BAR;
    PG8_STAGE(PG8_SB(1, 0), cB + kstep, voffB); PG8_STAGE(PG8_SA(1, 0), cA + kstep, voffA); PG8_STAGE(PG8_SB(1, 1), cB + hstepB + kstep, voffB);
    PG8_WAIT_V(6); PG8_BAR;
    for (;;) {
        const bool has_next = S.next(ui + 1, nxt);
        const char* nA = has_next ? S.aptr(nxt) : cA; const char* nB = has_next ? S.bptr(nxt) : cB;
        for (int t = 0; t < nt; t += 2) {
            const bool last = (t == nt - 2);
            const char* a1p = cA + (size_t)(t + 1) * kstep;
            const char* a2 = last ? nA : cA + (size_t)(t + 2) * kstep; const char* b2 = last ? nB : cB + (size_t)(t + 2) * kstep;
            const char* a3 = a2 + kstep; const char* b3 = b2 + kstep;
            PG8_LDB(B0, 0, 0); PG8_LDB(B1, 0, 1); PG8_SCHED; PG8_LDA(At, 0, 0); PG8_STAGE(PG8_SA(1, 1), a1p + hstepA, voffA);
            PG8_WAIT_V(8); PG8_WAIT_L(0); PG8_BAR; if (t == 0) { PG8_MMA0(0, 0, At, B0); PG8_MMA0(0, 1, At, B1); } else { PG8_MMA(0, 0, At, B0); PG8_MMA(0, 1, At, B1); } PG8_BAR; PG8_SCHED;
            PG8_LDA(At, 0, 1); PG8_STAGE(PG8_SB(0, 0), b2, voffB); PG8_STAGE(PG8_SB(0, 1), b2 + hstepB, voffB); PG8_STAGE(PG8_SA(0, 0), a2, voffA);
            PG8_WAIT_V(8); PG8_WAIT_L(0); PG8_BAR; if (t == 0) { PG8_MMA0(1, 0, At, B0); PG8_MMA0(1, 1, At, B1); } else { PG8_MMA(1, 0, At, B0); PG8_MMA(1, 1, At, B1); } PG8_BAR; PG8_SCHED;
            PG8_LDB(B0, 1, 0); PG8_LDB(B1, 1, 1); PG8_SCHED; PG8_LDA(At, 1, 0); PG8_STAGE(PG8_SA(0, 1), a2 + hstepA, voffA);
            PG8_WAIT_V(8); PG8_WAIT_L(0); PG8_BAR; PG8_MMA(0, 0, At, B0); PG8_MMA(0, 1, At, B1); PG8_BAR; PG8_SCHED;
            PG8_LDA(At, 1, 1); PG8_STAGE(PG8_SB(1, 0), b3, voffB); PG8_STAGE(PG8_SB(1, 1), b3 + hstepB, voffB); PG8_STAGE(PG8_SA(1, 0), a3, voffA);
            PG8_WAIT_V(8); PG8_WAIT_L(0); PG8_BAR; PG8_MMA(1, 0, At, B0); PG8_MMA(1, 1, At, B1); PG8_BAR; PG8_SCHED;
        }
        if (wr == 0) PG8_BAR;
        asm volatile("s_nop 15\n\ts_nop 7" ::: "memory");
        epi_tile(E, acc, cur, wr, wc, fr, fq);
        if (!has_next) break;
        cur = nxt; cA = nA; cB = nB; ++ui;
        if (wr == 1) PG8_BAR;
    }
    PG8_WAIT_V(0);
    PG8_BAR;
#undef PG8_SA
#undef PG8_SB
#undef PG8_STAGE
#undef PG8_RD32
#undef PG8_LDA
#undef PG8_LDB
#undef PG8_MMA
#undef PG8_MMA0
#undef PG8_WAIT_V
#undef PG8_WAIT_L
#undef PG8_BAR
#undef PG8_SCHED
}
template <class Epi, class SchedT>
__device__ __forceinline__ void gemm_phase8g(LAS unsigned char* lds, const int K  , const unsigned char* Ag  , const int* srow, const SchedT& S, const Epi& E) {
    const int tid = threadIdx.x, wid = __builtin_amdgcn_readfirstlane(tid >> 6), lane = tid & 63, wr = wid >> 2, wc = wid & 3, fr = lane & 15, fq = lane >> 4;
    const int nt = K / 128;
    unsigned voffB[2];
#pragma unroll
    for (int i = 0; i < 2; ++i) { int R, Cb; stage_rc8(tid * 16 + i * 8192, R, Cb); const int Rb = (R & ~31) + perm32(R & 31); voffB[i] = (unsigned)(Rb * K + Cb); }
    const size_t kstep = 128;
    const size_t hstepB = (size_t)HALF * K;
    LAS int* itab = (LAS int*)(lds + LDSCTL_OFF + 4096);
#define PG8_GFILL(slot0, par) do { if (wid < 4) __builtin_amdgcn_global_load_lds((const unsigned*)(srow + (slot0) + wid * 64 + lane), (LAS unsigned*)(itab + (par) * 256 + wid * 64), 4, 0, 0); } while (0)
#define PG8_GOFFS(dst, par) do { int _t = tid; asm volatile("" : "+v"(_t)); int _R0, _Cb0; stage_rc8(_t * 16, _R0, _Cb0); \
        _Pragma("unroll") for (int _h = 0; _h < 2; ++_h) _Pragma("unroll") for (int _i = 0; _i < 2; ++_i) dst[_h][_i] = (unsigned)itab[(par) * 256 + _h * 128 + _i * 64 + _R0] * (unsigned)K + (unsigned)_Cb0; } while (0)
    const unsigned ldsw = (unsigned)wid * 1024u;
    const int a0 = lds_byte8(wr * 64 + fr, 32 * fq), a1 = lds_byte8(wr * 64 + fr, 32 * fq + 16), b0 = lds_byte8(wc * 32 + fr, 32 * fq), b1 = lds_byte8(wc * 32 + fr, 32 * fq + 16);
#define PG8_SA(b, h) (((b) * 2 + (h)) * HTB)
#define PG8_SB(b, h) ((4 + (b) * 2 + (h)) * HTB)
#define PG8_STAGE(bufoff, gbase, voff) do { _Pragma("unroll") for (int _i = 0; _i < 2; ++_i) \
        __builtin_amdgcn_global_load_lds((const unsigned*)((const char*)(gbase) + (voff)[_i]), (LAS unsigned*)(lds + (bufoff) + ldsw + _i * 8192), 16, 0, 0); } while (0)
#define PG8_RD32(o0, o1) __builtin_shufflevector(*(const LAS v4i*)(lds + (o0)), *(const LAS v4i*)(lds + (o1)), 0, 1, 2, 3, 4, 5, 6, 7)
#define PG8_LDA(dst, b, h) do { _Pragma("unroll") for (int m = 0; m < 4; ++m) dst[m] = PG8_RD32(PG8_SA(b, h) + a0 + m * 2048, PG8_SA(b, h) + a1 + m * 2048); } while (0)
#define PG8_LDB(dst, b, h) do { _Pragma("unroll") for (int n = 0; n < 2; ++n) dst[n] = PG8_RD32(PG8_SB(b, h) + b0 + n * 2048, PG8_SB(b, h) + b1 + n * 2048); } while (0)
#define PG8_MMA(ai, bj, At, Bt) do { __builtin_amdgcn_s_setprio(1); _Pragma("unroll") for (int m = 0; m < 4; ++m) _Pragma("unroll") for (int n = 0; n < 2; ++n) \
        asm volatile("v_mfma_scale_f32_16x16x128_f8f6f4 %0, %1, %2, %0, %3, %3 op_sel_hi:[0,0,0]" : "+v"(acc[ai][bj][m][n]) : "v"(Bt[n]), "v"(At[m]), "v"(one8)); __builtin_amdgcn_s_setprio(0); } while (0)
#define PG8_MMA0(ai, bj, At, Bt) do { __builtin_amdgcn_s_setprio(1); _Pragma("unroll") for (int m = 0; m < 4; ++m) _Pragma("unroll") for (int n = 0; n < 2; ++n) \
        asm volatile("v_mfma_scale_f32_16x16x128_f8f6f4 %0, %1, %2, 0, %3, %3 op_sel_hi:[0,0,0]" : "=&v"(acc[ai][bj][m][n]) : "v"(Bt[n]), "v"(At[m]), "v"(one8)); __builtin_amdgcn_s_setprio(0); } while (0)
#define PG8_WAIT_V(n) asm volatile("s_waitcnt vmcnt(" #n ")" ::: "memory")
#define PG8_WAIT_L(n) asm volatile("s_waitcnt lgkmcnt(" #n ")" ::: "memory")
#define PG8_BAR __builtin_amdgcn_s_barrier()
#define PG8_SCHED __builtin_amdgcn_sched_barrier(0)
    int one8 = 0x7f7f7f7f; asm volatile("" : "+v"(one8));
    Unit cur, nxt; int ui = 0;
    if (!S.next(0, cur)) return;
    f32x4 acc[2][2][4][2];
#pragma unroll
    for (int a = 0; a < 2; ++a)
#pragma unroll
        for (int b = 0; b < 2; ++b)
#pragma unroll
            for (int m = 0; m < 4; ++m)
#pragma unroll
                for (int n = 0; n < 2; ++n) acc[a][b][m][n] = (f32x4){0.f, 0.f, 0.f, 0.f};
    v8i At[4], B0[2], B1[2];
    const char* const A0 = (const char*)Ag; const char* cB = S.bptr(cur);
    unsigned coff[2][2];
    PG8_GFILL(cur.pm * 256, 0); PG8_WAIT_V(0); PG8_BAR;
    PG8_GOFFS(coff, 0);
    PG8_STAGE(PG8_SB(0, 0), cB, voffB); PG8_STAGE(PG8_SB(0, 1), cB + hstepB, voffB); PG8_STAGE(PG8_SA(0, 0), A0, coff[0]); PG8_STAGE(PG8_SA(0, 1), A0, coff[1]);
    if (wr == 1) PG8_BAR;
    PG8_WAIT_V(2); PG8_BAR;
    PG8_STAGE(PG8_SB(1, 0), cB + kstep, voffB); PG8_STAGE(PG8_SA(1, 0), A0 + kstep, coff[0]); PG8_STAGE(PG8_SB(1, 1), cB + hstepB + kstep, voffB);
    PG8_WAIT_V(6); PG8_BAR;
    for (;;) {
        const bool has_next = S.next(ui + 1, nxt);
        const char* nB = has_next ? S.bptr(nxt) : cB;
        if (has_next) PG8_GFILL(nxt.pm * 256, (ui + 1) & 1);
        for (int t = 0; t < nt; t += 2) {
            const bool last = (t == nt - 2);
            const char* a1p = A0 + (size_t)(t + 1) * kstep;
            const bool usen = last && has_next;
            const char* a2 = last ? A0 : A0 + (size_t)(t + 2) * kstep; const char* b2 = last ? nB : cB + (size_t)(t + 2) * kstep;
            const char* a3 = a2 + kstep; const char* b3 = b2 + kstep;
            PG8_LDB(B0, 0, 0); PG8_LDB(B1, 0, 1); PG8_SCHED; PG8_LDA(At, 0, 0); PG8_STAGE(PG8_SA(1, 1), a1p, coff[1]);
            if (usen) PG8_GOFFS(coff, (ui + 1) & 1);
            PG8_WAIT_V(8); PG8_WAIT_L(0); PG8_BAR; if (t == 0) { PG8_MMA0(0, 0, At, B0); PG8_MMA0(0, 1, At, B1); } else { PG8_MMA(0, 0, At, B0); PG8_MMA(0, 1, At, B1); } PG8_BAR; PG8_SCHED;
            PG8_LDA(At, 0, 1); PG8_STAGE(PG8_SB(0, 0), b2, voffB); PG8_STAGE(PG8_SB(0, 1), b2 + hstepB, voffB); PG8_STAGE(PG8_SA(0, 0), a2, coff[0]);
            PG8_WAIT_V(8); PG8_WAIT_L(0); PG8_BAR; if (t == 0) { PG8_MMA0(1, 0, At, B0); PG8_MMA0(1, 1, At, B1); } else { PG8_MMA(1, 0, At, B0); PG8_MMA(1, 1, At, B1); } PG8_BAR; PG8_SCHED;
            PG8_LDB(B0, 1, 0); PG8_LDB(B1, 1, 1); PG8_SCHED; PG8_LDA(At, 1, 0); PG8_STAGE(PG8_SA(0, 1), a2, coff[1]);
            PG8_WAIT_V(8); PG8_WAIT_L(0); PG8_BAR; PG8_MMA(0, 0, At, B0); PG8_MMA(0, 1, At, B1); PG8_BAR; PG8_SCHED;
            PG8_LDA(At, 1, 1); PG8_STAGE(PG8_SB(1, 0), b3, voffB); PG8_STAGE(PG8_SB(1, 1), b3 + hstepB, voffB); PG8_STAGE(PG8_SA(1, 0), a3, coff[0]);
            PG8_WAIT_V(8); PG8_WAIT_L(0); PG8_BAR; PG8_MMA(1, 0, At, B0); PG8_MMA(1, 1, At, B1); PG8_BAR; PG8_SCHED;
        }
        if (wr == 0) PG8_BAR;
        asm volatile("s_nop 15\n\ts_nop 7" ::: "memory");
        epi_tile(E, acc, cur, wr, wc, fr, fq);
        if (!has_next) break;
        cur = nxt; cB = nB; ++ui;
        if (wr == 1) PG8_BAR;
    }
    PG8_WAIT_V(0);
    PG8_BAR;
#undef PG8_GFILL
#undef PG8_GOFFS
#undef PG8_SA
#undef PG8_SB
#undef PG8_STAGE
#undef PG8_RD32
#undef PG8_LDA
#undef PG8_LDB
#undef PG8_MMA
#undef PG8_MMA0
#undef PG8_WAIT_V
#undef PG8_WAIT_L
#undef PG8_BAR
#undef PG8_SCHED
}
constexpr float F8_W13 = 32.0f, F8_W2 = 64.0f, F8_HID = 4.0f;
template <bool ROWRSTD> struct EpiSwigluF8 {
    static constexpr bool BATCH = false, HASPRE = true;
    const float* rstd; unsigned char* HID8;
    typedef typename PreRaw<ROWRSTD>::T Raw;
    __device__ __forceinline__ Raw pre_load(int row, int fq) const { if constexpr (ROWRSTD) return gload1_asm(rstd + row); else return gload4f_asm(rstd + (size_t)row * 16 + 4 * fq); }
    __device__ __forceinline__ float pre_fin(const Raw r, int fq) const { if constexpr (ROWRSTD) return r * (1.0f / F8_W13); else return rstd_fin(r) * (1.0f / F8_W13); }
    __device__ __forceinline__ void frag(int row, int pn, int wc, int fq, const float rs, const f32x4 a00, const f32x4 a01, const f32x4 a10, const f32x4 a11) const {
        const int col0 = pn * HALF + wc * 32 + 8 * fq;
        const float nrs = -1.4426950408889634f * rs, rs2 = rs * rs * F8_HID;
        f32x4 e0 = a00 * nrs, e1 = a01 * nrs;
#pragma unroll
        for (int j = 0; j < 4; ++j) { e0[j] = fast_exp2(e0[j]); e1[j] = fast_exp2(e1[j]); }
        e0 = e0 + 1.0f; e1 = e1 + 1.0f;
#pragma unroll
        for (int j = 0; j < 4; ++j) { e0[j] = fast_rcp(e0[j]); e1[j] = fast_rcp(e1[j]); }
        const f32x4 o0 = (a00 * a10) * (e0 * rs2), o1 = (a01 * a11) * (e1 * rs2);
        *(u32x2*)(HID8 + (size_t)row * FF + col0) = pack_fp8x8(o0[0], o0[1], o0[2], o0[3], o1[0], o1[1], o1[2], o1[3]);
    }
};
template <class Epi> __device__ __forceinline__ void meta_gemm(LAS unsigned char* red, const bf16_t* A, int lda, size_t a_pn_el, const bf16_t* Bt, int K, int N, const Epi& E, int G) {
    const int tid = threadIdx.x, wid = __builtin_amdgcn_readfirstlane(tid >> 6), lane = tid & 63, fr = lane & 15, fq = lane >> 4;
    for (int task = blockIdx.x; task < N / 64; task += G) {
        const int pn = task >> 2, wc = task & 3;
        const bf16_t* ap = A + (size_t)(MREAL + fr) * lda + a_pn_el * pn + 8 * fq;
        const bf16_t* bp = Bt + (size_t)(256 * pn + 32 * wc + 8 * (fr >> 2) + (fr & 3)) * K + 8 * fq;
        f32x4 acc[2][2];
#pragma unroll
        for (int bj = 0; bj < 2; ++bj)
#pragma unroll
            for (int n = 0; n < 2; ++n) acc[bj][n] = (f32x4){0.f, 0.f, 0.f, 0.f};
        const int nst = K / 256;
        for (int s0 = 0; s0 < nst; s0 += 4) {
            bf16x8 af[4], bfr[4][4];
#pragma unroll
            for (int t = 0; t < 4; ++t) if (s0 + t < nst) { const int kk = wid * nst + s0 + t;
                af[t] = *(const bf16x8*)(ap + 32 * kk);
#pragma unroll
                for (int bj = 0; bj < 2; ++bj)
#pragma unroll
                    for (int n = 0; n < 2; ++n) bfr[t][bj * 2 + n] = *(const bf16x8*)(bp + (size_t)(128 * bj + 4 * n) * K + 32 * kk); }
#pragma unroll
            for (int t = 0; t < 4; ++t) if (s0 + t < nst) {
#pragma unroll
                for (int bj = 0; bj < 2; ++bj)
#pragma unroll
                    for (int n = 0; n < 2; ++n) acc[bj][n] = __builtin_amdgcn_mfma_f32_16x16x32_bf16(bfr[t][bj * 2 + n], af[t], acc[bj][n], 0, 0, 0); }
        }
        LAS f32x4* r4 = (LAS f32x4*)red;
#pragma unroll
        for (int bj = 0; bj < 2; ++bj)
#pragma unroll
            for (int n = 0; n < 2; ++n) r4[(wid * 4 + bj * 2 + n) * 64 + lane] = acc[bj][n];
        __syncthreads();
        if (wid == 0) {
            f32x4 s0 = r4[lane], s1 = r4[64 + lane], s2 = r4[128 + lane], s3 = r4[192 + lane];
#pragma unroll
            for (int w = 1; w < 8; ++w) { s0 = s0 + r4[(w * 4) * 64 + lane]; s1 = s1 + r4[(w * 4 + 1) * 64 + lane]; s2 = s2 + r4[(w * 4 + 2) * 64 + lane]; s3 = s3 + r4[(w * 4 + 3) * 64 + lane]; }
            epi_frag(E, MREAL + fr, pn, wc, fq, s0, s1, s2, s3);
        }
        __syncthreads();
    }
}

template <class Epi> __device__ __forceinline__ void meta_gemm8(LAS unsigned char* red, const unsigned char* A, int lda, const unsigned char* Bt, int K, int N, const Epi& E, int G) {
    const int tid = threadIdx.x, wid = __builtin_amdgcn_readfirstlane(tid >> 6), lane = tid & 63, fr = lane & 15, fq = lane >> 4;
    int one8 = 0x7f7f7f7f; asm volatile("" : "+v"(one8));
    for (int task = blockIdx.x; task < N / 64; task += G) {
        const int pn = task >> 2, wc = task & 3;
        const unsigned char* ap = A + (size_t)(MREAL + fr) * lda + 32 * fq;
        const unsigned char* bp = Bt + (size_t)(256 * pn + 32 * wc + 8 * (fr >> 2) + (fr & 3)) * K + 32 * fq;
        f32x4 acc[2][2];
#pragma unroll
        for (int bj = 0; bj < 2; ++bj)
#pragma unroll
            for (int n = 0; n < 2; ++n) acc[bj][n] = (f32x4){0.f, 0.f, 0.f, 0.f};
        asm volatile("s_nop 7" ::: "memory");
        for (int kk = wid; kk < K / 128; kk += 8) {
            const v8i af = __builtin_shufflevector(*(const v4i*)(ap + 128 * kk), *(const v4i*)(ap + 128 * kk + 16), 0, 1, 2, 3, 4, 5, 6, 7);
            v8i bf[2][2];
#pragma unroll
            for (int bj = 0; bj < 2; ++bj)
#pragma unroll
                for (int n = 0; n < 2; ++n) { const unsigned char* q = bp + (size_t)(128 * bj + 4 * n) * K + 128 * kk; bf[bj][n] = __builtin_shufflevector(*(const v4i*)q, *(const v4i*)(q + 16), 0, 1, 2, 3, 4, 5, 6, 7); }
#pragma unroll
            for (int bj = 0; bj < 2; ++bj)
#pragma unroll
                for (int n = 0; n < 2; ++n) asm volatile("v_mfma_scale_f32_16x16x128_f8f6f4 %0, %1, %2, %0, %3, %3 op_sel_hi:[0,0,0]" : "+v"(acc[bj][n]) : "v"(bf[bj][n]), "v"(af), "v"(one8));
        }
        asm volatile("s_nop 15\n\ts_nop 7" ::: "memory");
        LAS f32x4* r4 = (LAS f32x4*)red;
#pragma unroll
        for (int bj = 0; bj < 2; ++bj)
#pragma unroll
            for (int n = 0; n < 2; ++n) r4[(wid * 4 + bj * 2 + n) * 64 + lane] = acc[bj][n];
        __syncthreads();
        if (wid == 0) {
            f32x4 s0 = r4[lane], s1 = r4[64 + lane], s2 = r4[128 + lane], s3 = r4[192 + lane];
#pragma unroll
            for (int w = 1; w < 8; ++w) { s0 = s0 + r4[(w * 4) * 64 + lane]; s1 = s1 + r4[(w * 4 + 1) * 64 + lane]; s2 = s2 + r4[(w * 4 + 2) * 64 + lane]; s3 = s3 + r4[(w * 4 + 3) * 64 + lane]; }
            epi_frag(E, MREAL + fr, pn, wc, fq, s0, s1, s2, s3);
        }
        __syncthreads();
    }
}
}

#define XB_TMO      128
#define XB_XCNT(j)  (256  + 64 * (j))
#define XB_XSUB(j)  (1280 + 64 * (j))
#define XB_XGEN(j)  (2304 + 64 * (j))
#define XB_TOP      3328
#define XB_TOPGEN   3392
#define XCD_BAR_WORDS 3456
#define XB_SPIN_CAP (1u << 18)
__device__ __forceinline__ unsigned xb_ld(unsigned* p)              { return __hip_atomic_load(p, __ATOMIC_RELAXED, __HIP_MEMORY_SCOPE_AGENT); }
__device__ __forceinline__ unsigned xb_add(unsigned* p, unsigned v) { return __hip_atomic_fetch_add(p, v, __ATOMIC_RELAXED, __HIP_MEMORY_SCOPE_AGENT); }
__device__ __forceinline__ unsigned xb_xcc_id() { return (unsigned)__builtin_amdgcn_s_getreg((3 << 11) | 20) & 0xFu; }
#define XB_SPIN(cond, bar) do { unsigned _sp = 0; while (cond) { __builtin_amdgcn_s_sleep(1); \
    if ((++_sp & 255u) == 0u) { if (xb_ld(&(bar)[XB_TMO])) break; if (_sp > XB_SPIN_CAP) { atomicAdd(&(bar)[XB_TMO], 1u); break; } } } } while (0)
struct XcdBarrier { unsigned* bar; unsigned x; volatile LAS unsigned* st; };
__device__ __forceinline__ XcdBarrier xcd_barrier_post(unsigned* bar, volatile LAS unsigned* st) {
    XcdBarrier b; b.bar = bar; b.x = xb_xcc_id(); b.st = st;
    if (threadIdx.x == 0) (void)xb_add(&bar[XB_XCNT(b.x)], 1u);
    return b;
}
__device__ __forceinline__ void xcd_barrier_complete(unsigned* bar, unsigned x, unsigned& nloc, unsigned& nx) {
    const unsigned G = gridDim.x * gridDim.y * gridDim.z;
    unsigned sum, cnt, mine, sp = 0u;
    for (;;) {
        sum = 0u; cnt = 0u; mine = 0u;
#pragma unroll
        for (unsigned j = 0; j < 16; ++j) { const unsigned c = xb_ld(&bar[XB_XCNT(j)]); sum += c; cnt += (c > 0u) ? 1u : 0u; mine = (j == x) ? c : mine; }
        if (sum == G) break;
        __builtin_amdgcn_s_sleep(1);
        if ((++sp & 255u) == 0u) { if (xb_ld(&bar[XB_TMO])) break; if (sp > XB_SPIN_CAP) { atomicAdd(&bar[XB_TMO], 1u); break; } }
    }
    nloc = mine > 0u ? mine : 1u; nx = cnt > 0u ? cnt : 1u;
}
__device__ __forceinline__ void xcd_barrier(const XcdBarrier& b) {
    asm volatile("s_waitcnt vmcnt(0)" ::: "memory");
    __syncthreads();
    if (threadIdx.x == 0) {
        unsigned* bar = b.bar;
        __builtin_amdgcn_s_waitcnt(0);
        unsigned nloc = b.st[0], nx = b.st[1];
        if (nloc == 0u) { xcd_barrier_complete(bar, b.x, nloc, nx); b.st[0] = nloc; b.st[1] = nx; }
        const unsigned old = xb_add(&bar[XB_XSUB(b.x)], 1u);
        const unsigned gen = old / nloc;
        if (old + 1u == (gen + 1u) * nloc) {
            __builtin_amdgcn_fence(__ATOMIC_RELEASE, "agent");
            asm volatile("s_waitcnt vmcnt(0)" ::: "memory");
            const unsigned og = xb_add(&bar[XB_TOP], 1u);
            const unsigned tg = og / nx;
            if (og + 1u == (tg + 1u) * nx) xb_add(&bar[XB_TOPGEN], 1u);
            else XB_SPIN(xb_ld(&bar[XB_TOPGEN]) == tg, bar);
            __builtin_amdgcn_fence(__ATOMIC_ACQUIRE, "agent");
            xb_add(&bar[XB_XGEN(b.x)], 1u);
            asm volatile("s_waitcnt vmcnt(0)" ::: "memory");
        } else {
            XB_SPIN(xb_ld(&bar[XB_XGEN(b.x)]) == gen, bar);
            __builtin_amdgcn_fence(__ATOMIC_ACQUIRE, "agent");
            asm volatile("s_waitcnt vmcnt(0)" ::: "memory");
        }
    }
    __syncthreads();
}

struct Args { const float* in[22]; float* out; unsigned char* ws; int ph_lo, ph_hi; };

template <int MAP> __device__ __forceinline__ int map_row(int n) {
    if (MAP == 1) { const int i = n & 127; return (n & ~127) + 2 * (i & 63) + (i >> 6); }
    if (MAP == 2) return (n >> 7) * 256 + (n & 127);
    if (MAP == 3) return (n >> 7) * 256 + 128 + (n & 127);
    return n;
}
template <int MAP> __device__ __forceinline__ void wt_item(const float* W, int K, int ldw, int N, bf16_t* WT, const float* gain, LAS float* scr, int item, int lane) {
    const int nblk = N / 32, kb = item / nblk, nb = item % nblk, k0 = 64 * kb, n0 = 32 * nb;
    { f32x4 v[8]; float gv[8];
#pragma unroll
      for (int i = 0; i < 8; ++i) { const int kk = 8 * i + (lane >> 3); v[i] = __builtin_nontemporal_load((const f32x4*)(W + (size_t)(k0 + kk) * ldw + n0 + 4 * (lane & 7))); gv[i] = gain ? gain[k0 + kk] : 1.0f; }
#pragma unroll
      for (int i = 0; i < 8; ++i) { const int kk = 8 * i + (lane >> 3); LAS float* d = scr + kk * 33 + 4 * (lane & 7); d[0] = v[i][0] * gv[i]; d[1] = v[i][1] * gv[i]; d[2] = v[i][2] * gv[i]; d[3] = v[i][3] * gv[i]; } }
    LDS_WAIT(); asm volatile("" ::: "memory");
    const int c = lane & 7;
#pragma unroll
    for (int j = 0; j < 4; ++j) { const int n = (lane >> 3) + 8 * j; const LAS float* s = scr + (8 * c) * 33 + n;
        u32x4 o; o.x = pk2(s[0 * 33], s[1 * 33]); o.y = pk2(s[2 * 33], s[3 * 33]); o.z = pk2(s[4 * 33], s[5 * 33]); o.w = pk2(s[6 * 33], s[7 * 33]);
        *(u32x4*)(WT + (size_t)map_row<MAP>(n0 + n) * K + k0 + 8 * c) = o; }
    LDS_WAIT(); asm volatile("" ::: "memory");
}
template <int MAP> __device__ __forceinline__ void wt_item8(const float* W, int K, int ldw, int N, unsigned char* WT, const float* gain, float scale, LAS float* scr, int item, int lane) {
    const int nblk = N / 32, kb = item / nblk, nb = item % nblk, k0 = 64 * kb, n0 = 32 * nb;
    { f32x4 v[8]; float gv[8];
#pragma unroll
      for (int i = 0; i < 8; ++i) { const int kk = 8 * i + (lane >> 3); v[i] = __builtin_nontemporal_load((const f32x4*)(W + (size_t)(k0 + kk) * ldw + n0 + 4 * (lane & 7))); gv[i] = (gain ? gain[k0 + kk] : 1.0f) * scale; }
#pragma unroll
      for (int i = 0; i < 8; ++i) { const int kk = 8 * i + (lane >> 3); LAS float* d = scr + kk * 33 + 4 * (lane & 7); d[0] = v[i][0] * gv[i]; d[1] = v[i][1] * gv[i]; d[2] = v[i][2] * gv[i]; d[3] = v[i][3] * gv[i]; } }
    LDS_WAIT(); asm volatile("" ::: "memory");
    const int c = lane & 7;
#pragma unroll
    for (int j = 0; j < 4; ++j) { const int n = (lane >> 3) + 8 * j; const LAS float* sp = scr + (8 * c) * 33 + n;
        *(u32x2*)(WT + (size_t)map_row<MAP>(n0 + n) * K + k0 + 8 * c) = pg8::pack_fp8x8(sp[0 * 33], sp[1 * 33], sp[2 * 33], sp[3 * 33], sp[4 * 33], sp[5 * 33], sp[6 * 33], sp[7 * 33]); }
    LDS_WAIT(); asm volatile("" ::: "memory");
}
template <int MAP> __device__ __forceinline__ void wt_matrix8(const float* W, int K, int ldw, int N, unsigned char* WT, const float* gain, float scale, LAS float* scr, int gw, int NGW, int lane) {
    const int nitems = (K / 64) * (N / 32);
    for (int it = gw; it < nitems; it += NGW) wt_item8<MAP>(W, K, ldw, N, WT, gain, scale, scr, it, lane);
}
template <int MAP> __device__ __forceinline__ void wt_matrix(const float* W, int K, int ldw, int N, bf16_t* WT, const float* gain, LAS float* scr, int gw, int NGW, int lane) {
    const int nitems = (K / 64) * (N / 32);
    for (int it = gw; it < nitems; it += NGW) wt_item<MAP>(W, K, ldw, N, WT, gain, scr, it, lane);
}

enum Phase { P_PRO = 0,
    P0_QKVG, P0_RET, P0_FIN, P0_WO, P0_W13, P0_W2,
    P1_QKV, P1_SB, P1_WO, P1_RA, P1_RB, P1_M13, P1_M2, P1_CMB,
    P2_PREP, P2_POOL, P2_W13, P2_W2,
    P3_QKVG, P3_RET, P3_FIN, P3_WO, P3_RA, P3_RB, P3_M13, P3_M2, P3_CMB,
    P_FINAL, P_COUNT };

struct Ctx {
    LAS unsigned char* lds; int tid, lane, wave, G, gw, NGW;
    const float* const* in; float* out; unsigned char* ws;
    bf16_t* H; float* ssq; float* gst; bf16_t* WA; bf16_t* WB; unsigned char* pool; unsigned char* misc; f32x2* tab; int* moe;
};

__device__ __forceinline__ void conv_ret(const Ctx& C, int j, int layer, bf16_t* mix, bf16_t* wo) {
    LAS float* scr = (LAS float*)(C.lds + C.wave * 16384);
    const float* g = C.in[2] + (size_t)layer * D;
    wt_matrix<1>(C.in[4] + (size_t)j * D * D, D, D, D, mix, g, scr, C.gw, C.NGW, C.lane);
    wt_matrix<1>(C.in[5] + (size_t)j * D * D, D, D, D, mix + (size_t)1024 * D, g, scr, C.gw, C.NGW, C.lane);
    wt_matrix<0>(C.in[6] + (size_t)j * D * 2 * D, D, 2 * D, 2 * D, mix + (size_t)2048 * D, g, scr, C.gw, C.NGW, C.lane);
    wt_matrix<0>(C.in[7] + (size_t)j * D * 2 * D, D, 2 * D, 2 * D, mix + (size_t)4096 * D, g, scr, C.gw, C.NGW, C.lane);
    wt_matrix<0>(C.in[8] + (size_t)j * 2 * D * D, 2 * D, D, D, wo, nullptr, scr, C.gw, C.NGW, C.lane);
}
constexpr float F8_WP = 32.0f, F8_WO = 32.0f, F8_A2 = 8.0f;
__device__ __forceinline__ void conv_ret8(const Ctx& C, int j, int layer, bf16_t* mix_, bf16_t* wo_) {
    LAS float* scr = (LAS float*)(C.lds + C.wave * 16384);
    const float* g = C.in[2] + (size_t)layer * D;
    unsigned char* mix = (unsigned char*)mix_; unsigned char* wo = (unsigned char*)wo_;
    wt_matrix8<1>(C.in[4] + (size_t)j * D * D, D, D, D, mix, g, F8_WP, scr, C.gw, C.NGW, C.lane);
    wt_matrix8<1>(C.in[5] + (size_t)j * D * D, D, D, D, mix + (size_t)1024 * D, g, F8_WP, scr, C.gw, C.NGW, C.lane);
    wt_matrix8<0>(C.in[6] + (size_t)j * D * 2 * D, D, 2 * D, 2 * D, mix + (size_t)2048 * D, g, F8_WP, scr, C.gw, C.NGW, C.lane);
    wt_matrix8<0>(C.in[7] + (size_t)j * D * 2 * D, D, 2 * D, 2 * D, mix + (size_t)4096 * D, g, F8_WP, scr, C.gw, C.NGW, C.lane);
    wt_matrix8<0>(C.in[8] + (size_t)j * 2 * D * D, 2 * D, D, D, wo, nullptr, F8_WO, scr, C.gw, C.NGW, C.lane);
}
__device__ __forceinline__ void conv_dense(const Ctx& C, int c, int layer, bf16_t* w13_, bf16_t* w2_) {
    LAS float* scr = (LAS float*)(C.lds + C.wave * 16384);
    const float* g = C.in[3] + (size_t)layer * D;
    unsigned char* w13 = (unsigned char*)w13_; unsigned char* w2 = (unsigned char*)w2_;
    wt_matrix8<2>(C.in[14] + (size_t)c * D * FF, D, FF, FF, w13, g, pg8::F8_W13, scr, C.gw, C.NGW, C.lane);
    wt_matrix8<3>(C.in[15] + (size_t)c * D * FF, D, FF, FF, w13, g, pg8::F8_W13, scr, C.gw, C.NGW, C.lane);
    wt_matrix8<0>(C.in[16] + (size_t)c * FF * D, FF, D, D, w2, nullptr, pg8::F8_W2, scr, C.gw, C.NGW, C.lane);
}
__device__ __forceinline__ void conv_dense_bf16(const Ctx& C, int c, int layer, bf16_t* w13, bf16_t* w2) {
    LAS float* scr = (LAS float*)(C.lds + C.wave * 16384);
    const float* g = C.in[3] + (size_t)layer * D;
    wt_matrix<2>(C.in[14] + (size_t)c * D * FF, D, FF, FF, w13, g, scr, C.gw, C.NGW, C.lane);
    wt_matrix<3>(C.in[15] + (size_t)c * D * FF, D, FF, FF, w13, g, scr, C.gw, C.NGW, C.lane);
    wt_matrix<0>(C.in[16] + (size_t)c * FF * D, FF, D, D, w2, nullptr, scr, C.gw, C.NGW, C.lane);
}
__device__ __forceinline__ void conv_moe(const Ctx& C, int c, int layer, bf16_t* w13_, bf16_t* w2_) {
    LAS float* scr = (LAS float*)(C.lds + C.wave * 16384);
    const float* g = C.in[3] + (size_t)layer * D;
    unsigned char* w13 = (unsigned char*)w13_; unsigned char* w2 = (unsigned char*)w2_;
    for (int e = 0; e < NE; ++e) {
        wt_matrix8<2>(C.in[18] + ((size_t)c * NE + e) * D * FF, D, FF, FF, w13 + (size_t)e * 5632 * D, g, pg8::F8_W13, scr, C.gw, C.NGW, C.lane);
        wt_matrix8<3>(C.in[19] + ((size_t)c * NE + e) * D * FF, D, FF, FF, w13 + (size_t)e * 5632 * D, g, pg8::F8_W13, scr, C.gw, C.NGW, C.lane);
        wt_matrix8<0>(C.in[20] + ((size_t)c * NE + e) * FF * D, FF, D, D, w2 + (size_t)e * D * FF, nullptr, pg8::F8_W2, scr, C.gw, C.NGW, C.lane);
    }
}

template <class Epi> __device__ __forceinline__ void run_dense(const Ctx& C, const bf16_t* A, int lda, size_t a_pn_bytes, const bf16_t* Bt, int K, int N, const Epi& E) {
#if PROBE_GROUP == 60
    const unsigned long long _pt0 = __builtin_amdgcn_s_memrealtime();
#endif
    pg8::meta_gemm(C.lds, A, lda, a_pn_bytes / 2, Bt, K, N, E, C.G);
#if PROBE_GROUP == 60
    asm volatile("s_waitcnt vmcnt(0)" ::: "memory"); if (blockIdx.x == 0 && C.tid == 0) *(LAS unsigned long long*)(C.lds + LDSCTL_OFF + 8192) += __builtin_amdgcn_s_memrealtime() - _pt0;
#endif
    pg8::Sched<false> S; S.nM = MREAL / 256; S.nN = N / 256; S.nwg = S.nM * S.nN; S.G = C.G; S.c = (int)blockIdx.x;
    S.A = (const char*)A; S.Bt = (const char*)Bt; S.a_pm = (size_t)256 * lda * 2; S.a_pn = a_pn_bytes; S.b_pn = (size_t)256 * K * 2; S.b_e = 0; S.pexp = nullptr;
    pg8::gemm_phase(C.lds, K, lda, S, E);
}
template <class Epi> __device__ __forceinline__ void run_dense8(const Ctx& C, const unsigned char* A, int lda, const unsigned char* Bt, int K, int N, const Epi& E) {
#if PROBE_GROUP == 60
    const unsigned long long _pt0 = __builtin_amdgcn_s_memrealtime();
#endif
    pg8::meta_gemm8(C.lds, A, lda, Bt, K, N, E, C.G);
#if PROBE_GROUP == 60
    asm volatile("s_waitcnt vmcnt(0)" ::: "memory"); if (blockIdx.x == 0 && C.tid == 0) *(LAS unsigned long long*)(C.lds + LDSCTL_OFF + 8192) += __builtin_amdgcn_s_memrealtime() - _pt0;
#endif
    pg8::Sched<false> S; S.nM = MREAL / 256; S.nN = N / 256; S.nwg = S.nM * S.nN; S.G = C.G; S.c = (int)blockIdx.x;
    S.A = (const char*)A; S.Bt = (const char*)Bt; S.a_pm = (size_t)256 * lda; S.a_pn = 0; S.b_pn = (size_t)256 * K; S.b_e = 0; S.pexp = nullptr;
    pg8::gemm_phase8(C.lds, K, lda, S, E);
}
template <class Epi> __device__ __forceinline__ void run_moe(const Ctx& C, const int* seg, const bf16_t* A, const bf16_t* Bt, size_t b_e_bytes, int K, int N, const Epi& E) {
    LAS int* pexp = (LAS int*)(C.lds + LDS_PEXP);
    const int total = seg[8] / 256;
    for (int p = C.tid; p < total; p += 512) { int e = 0;
#pragma unroll
        for (int j = 1; j < 8; ++j) e += (p * 256 >= seg[j]) ? 1 : 0;
        pexp[p] = e; }
    __syncthreads();
    pg8::Sched<true> S; S.nM = total; S.nN = N / 256; S.nwg = S.nM * S.nN; S.G = C.G; S.c = (int)blockIdx.x;
    S.A = (const char*)A; S.Bt = (const char*)Bt; S.a_pm = (size_t)256 * K * 2; S.a_pn = 0; S.b_pn = (size_t)256 * K * 2; S.b_e = b_e_bytes; S.pexp = pexp;
    pg8::gemm_phase(C.lds, K, K, S, E);
    __syncthreads();
}

template <class Epi> __device__ __forceinline__ void run_moe8(const Ctx& C, const int* seg, const unsigned char* A, const unsigned char* Bt, size_t b_e_bytes, int K, int N, const Epi& E, const int* srow = nullptr) {
    LAS int* pexp = (LAS int*)(C.lds + LDS_PEXP);
    const int total = seg[8] / 256;
    for (int p = C.tid; p < total; p += 512) { int e = 0;
#pragma unroll
        for (int j = 1; j < 8; ++j) e += (p * 256 >= seg[j]) ? 1 : 0;
        pexp[p] = e; }
    __syncthreads();
    pg8::Sched<true> S; S.nM = total; S.nN = N / 256; S.nwg = S.nM * S.nN; S.G = C.G; S.c = (int)blockIdx.x;
    S.A = (const char*)A; S.Bt = (const char*)Bt; S.a_pm = (size_t)256 * K; S.a_pn = 0; S.b_pn = (size_t)256 * K; S.b_e = b_e_bytes; S.pexp = pexp;
    if (srow) pg8::gemm_phase8g(C.lds, K, A, srow, S, E); else pg8::gemm_phase8(C.lds, K, K, S, E);
    __syncthreads();
}
__device__ __forceinline__ void ret_finalize(const Ctx& C, int j, const bf16_t* Y, const bf16_t* YM, bf16_t* Gt, const float* gst, unsigned char* A8 = nullptr) {
    const float* gn = C.in[9] + (size_t)j * 2 * D;
    for (int row = C.gw; row < MVALID; row += C.NGW) {
        const bf16_t* yrow = row < MREAL ? Y + (size_t)row * 2048 : YM + (size_t)(row - MREAL) * 2048;
        u32x4 yv[4], gv[4]; f32x4 ga[4], gb[4];
#pragma unroll
        for (int q = 0; q < 4; ++q) { const int col = q * 512 + C.lane * 8, h = col >> 8;
            yv[q] = *(const u32x4*)(yrow + col); gv[q] = *(const u32x4*)(Gt + (size_t)row * 2048 + col);
            ga[q] = *(const f32x4*)(gst + ((size_t)row * 8 + h) * 8); gb[q] = *(const f32x4*)(gst + ((size_t)row * 8 + h) * 8 + 4); }
#pragma unroll
        for (int q = 0; q < 4; ++q) {
            const int col = q * 512 + C.lane * 8;
            const float s1 = (ga[q][0] + ga[q][2]) + (gb[q][0] + gb[q][2]), s2 = (ga[q][1] + ga[q][3]) + (gb[q][1] + gb[q][3]);
            const float mu = s1 * (1.0f / 256.0f); const float var = fmaxf(s2 * (1.0f / 256.0f) - mu * mu, 0.f); const float rs = __builtin_amdgcn_rsqf(var + EPS);
            const f32x4 g0 = *(const f32x4*)(gn + col) * rs, g1 = *(const f32x4*)(gn + col + 4) * rs;
            if (A8) {
                *(u32x2*)(A8 + (size_t)row * 2048 + col) = pg8::pack_fp8x8(
                    F8_A2 * bflo(gv[q].x) * (bflo(yv[q].x) - mu) * g0[0], F8_A2 * bfhi(gv[q].x) * (bfhi(yv[q].x) - mu) * g0[1], F8_A2 * bflo(gv[q].y) * (bflo(yv[q].y) - mu) * g0[2], F8_A2 * bfhi(gv[q].y) * (bfhi(yv[q].y) - mu) * g0[3],
                    F8_A2 * bflo(gv[q].z) * (bflo(yv[q].z) - mu) * g1[0], F8_A2 * bfhi(gv[q].z) * (bfhi(yv[q].z) - mu) * g1[1], F8_A2 * bflo(gv[q].w) * (bflo(yv[q].w) - mu) * g1[2], F8_A2 * bfhi(gv[q].w) * (bfhi(yv[q].w) - mu) * g1[3]);
                continue;
            }
            u32x4 w;
            w.x = pk2(bflo(gv[q].x) * (bflo(yv[q].x) - mu) * g0[0], bfhi(gv[q].x) * (bfhi(yv[q].x) - mu) * g0[1]);
            w.y = pk2(bflo(gv[q].y) * (bflo(yv[q].y) - mu) * g0[2], bfhi(gv[q].y) * (bfhi(yv[q].y) - mu) * g0[3]);
            w.z = pk2(bflo(gv[q].z) * (bflo(yv[q].z) - mu) * g1[0], bfhi(gv[q].z) * (bfhi(yv[q].z) - mu) * g1[1]);
            w.w = pk2(bflo(gv[q].w) * (bflo(yv[q].w) - mu) * g1[2], bfhi(gv[q].w) * (bfhi(yv[q].w) - mu) * g1[3]);
            *(u32x4*)(Gt + (size_t)row * 2048 + col) = w;
        }
    }
}

__device__ __forceinline__ void ret_naive(const Ctx& C, const bf16_t* Q, const bf16_t* Kk, bf16_t* V, bf16_t* YM, float* gst) {
    for (int item = blockIdx.x; item < NBATCH * 8 * 2; item += C.G) {
        const int half = item & 1, h = (item >> 1) & 7, b = item >> 4;
        if (C.tid < 128) {
            const int e = half * 128 + C.tid;
            const float gamma = 1.0f - exp2f(-5.0f - (float)h);
            float S[128];
#pragma unroll
            for (int d = 0; d < 128; ++d) S[d] = 0.f;
            for (int p = 0; p < LPOS; ++p) {
                const int row = pos_row(b, p);
                const u32x4* qp = (const u32x4*)(Q + (size_t)row * D + h * 128);
                const u32x4* kp = (const u32x4*)(Kk + (size_t)row * D + h * 128);
                bf16_t* vp = V + (size_t)row * 2048 + h * 256 + e;
                const float v = bf1(*vp);
                float y = 0.f;
#pragma unroll
                for (int jj = 0; jj < 16; ++jj) {
                    const u32x4 kq = kp[jj], qq = qp[jj];
                    const unsigned kw[4] = {kq.x, kq.y, kq.z, kq.w}, qw[4] = {qq.x, qq.y, qq.z, qq.w};
#pragma unroll
                    for (int i = 0; i < 4; ++i) {
                        S[8 * jj + 2 * i] = gamma * S[8 * jj + 2 * i] + bflo(kw[i]) * v; y += bflo(qw[i]) * S[8 * jj + 2 * i];
                        S[8 * jj + 2 * i + 1] = gamma * S[8 * jj + 2 * i + 1] + bfhi(kw[i]) * v; y += bfhi(qw[i]) * S[8 * jj + 2 * i + 1];
                    }
                }
                if (p >= NMETA || b == 0) {
                    if (p >= NMETA) *vp = (bf16_t)f2bf(y); else YM[(size_t)p * 2048 + h * 256 + e] = (bf16_t)f2bf(y);
                    const float s1 = wave_sum(y), s2 = wave_sum(y * y);
                    if (C.lane == 0) { *(f32x2*)(gst + ((size_t)row * 8 + h) * 8 + (half * 2 + C.wave) * 2) = (f32x2){s1, s2}; }
                }
            }
        }
    }
}


__device__ __forceinline__ void glds16(const void* gsrc, unsigned lds_dst) { unsigned keep;
    asm volatile("s_mov_b32 %0, m0\n\ts_mov_b32 m0, %2\n\ts_nop 0\n\tglobal_load_lds_dwordx4 %1, off\n\ts_mov_b32 m0, %0" : "=&s"(keep) : "v"(gsrc), "s"(lds_dst) : "memory"); }
__device__ __forceinline__ void gstore8_asm(void* p, u32x2 v) { asm volatile("global_store_dwordx2 %0, %1, off" :: "v"(p), "v"(v) : "memory"); }
__device__ __forceinline__ void gstore16_asm(void* p, f32x4 v) { asm volatile("global_store_dwordx4 %0, %1, off\n\ts_nop 1" :: "v"(p), "v"(v) : "memory"); }
namespace retm {
typedef float f32x16 __attribute__((ext_vector_type(16)));
typedef short s16x4 __attribute__((ext_vector_type(4)));
typedef short v4i16_t __attribute__((ext_vector_type(4)));
constexpr int L_KROW = 0, L_KTR = 32768, L_V = 65536, L_ST = 98304;
__device__ __forceinline__ int crow(int r, int hi) { return (r & 3) + 8 * (r >> 2) + 4 * hi; }
__device__ __forceinline__ s16x4 vtr(const LAS unsigned char* p) { return __builtin_bit_cast(s16x4, __builtin_amdgcn_ds_read_tr16_b64_v4i16((LAS v4i16_t*)p)); }
__device__ __forceinline__ float partner32(float x, int hi) { auto rr = __builtin_amdgcn_permlane32_swap(__float_as_uint(x), __float_as_uint(x), false, false); return __uint_as_float(hi ? rr[0] : rr[1]); }
__device__ __forceinline__ int grow(int b, int i, int j) { return i == 0 ? (j >= 112 ? MREAL + (j - 112) : MVALID) : b * SEQ + (i - 1) * 128 + j; }
__device__ __forceinline__ bf16x8 pack8(const f32x16& v, int o) { u32x4 a; a.x = pk2(v[o], v[o + 1]); a.y = pk2(v[o + 2], v[o + 3]); a.z = pk2(v[o + 4], v[o + 5]); a.w = pk2(v[o + 6], v[o + 7]); return __builtin_bit_cast(bf16x8, a); }
__device__ __forceinline__ bf16x8 trfrag(const LAS unsigned char* p) { const s16x4 a = vtr(p), c = vtr(p + 512); return (bf16x8){a[0], a[1], a[2], a[3], c[0], c[1], c[2], c[3]}; }

__device__ __forceinline__ void stats_flush(const LAS float* st, int b, int h, int half, int i, float* gst, int tid) {
    if (tid < 128) {
        const int j = tid; const bool ok = (i > 0) || (j >= 112 && b == 0);
        if (ok) { const int row = grow(b, i, j);
            const LAS f32x2* p = (const LAS f32x2*)(st + j * 8);
            const f32x2 a = p[0], c = p[1], d = p[2], e = p[3];
            *(f32x4*)(gst + ((size_t)row * 8 + h) * 8 + half * 4) = (f32x4){a[0] + c[0], a[1] + c[1], d[0] + e[0], d[1] + e[1]}; }
    }
}

constexpr int STAGE = 49152, S_K = 0, S_Q = 16384, S_V = 32768;
constexpr int L_ST2 = LDSCTL_OFF + 2048;

__device__ __forceinline__ void stats_flush64(const LAS float* st, int b, int h, int half, int j, float* gst, int tid) {
    if (tid < 64) {
        const int i = j >> 1, jr = 64 * (j & 1) + tid; const bool ok = (i > 0) || (jr >= 112 && b == 0);
        if (ok) { const int row = grow(b, i, jr);
            const LAS f32x2* p = (const LAS f32x2*)(st + tid * 8);
            const f32x2 a = p[0], c = p[1], d = p[2], e = p[3];
            gstore16_asm(gst + ((size_t)row * 8 + h) * 8 + half * 4, (f32x4){a[0] + c[0], a[1] + c[1], d[0] + e[0], d[1] + e[1]}); }
    }
}

__device__ __forceinline__ void ret_item(LAS unsigned char* lds, int b, int h, int half, const bf16_t* Q, const bf16_t* K, bf16_t* V, bf16_t* YM, float* gst, int wid, int lane, int tid) {
    const int r32 = lane & 31, hi = lane >> 5, et = wid & 3, cbl = wid >> 2;
    const float gamma = 1.0f - exp2f(-5.0f - (float)h); const float g128 = exp2f(128.0f * log2f(gamma));
    f32x16 T[4];
#pragma unroll
    for (int d = 0; d < 4; ++d) T[d] = (f32x16){};
    LAS float* st = (LAS float*)(lds + L_ST2);
    const unsigned lds0 = (unsigned)(size_t)lds;
    const int trq = (lane & 15) >> 2, trp = lane & 3, trb = (lane >> 4) & 1;
    const int troff = (4 * hi + trq) * 64 + trb * 32 + trp * 8;
    const int trp2 = ((trp & 1) << 1) | (trp >> 1);
    const int ktr_ch = 2 * trb + (trp2 >> 1);
    const int ktr_lane = ktr_ch * 1024 + (trp2 & 1) * 8;
    const int ktr_r0 = ((4 * hi + trq) ^ (4 * ktr_ch)) * 16, ktr_r1 = ((4 * hi + 8 + trq) ^ (4 * ktr_ch)) * 16;
    const int krA = hi * 1024 + (r32 ^ (4 * hi)) * 16, krB = hi * 1024 + (r32 ^ (8 + 4 * hi)) * 16;
    const int qro = hi * 1024 + (32 * cbl + r32) * 16;
    const int vrow = lane >> 2;
#define RET_DMA(jj, stg) do { const int _i = (jj) >> 1, _r0 = 64 * ((jj) & 1); const unsigned _base = lds0 + (stg) * STAGE; \
        _Pragma("unroll") for (int u = 0; u < 2; ++u) { const int pc = wid * 2 + u; \
            { const int rowk = grow(b, _i, _r0 + (lane ^ (4 * (pc & 3)))); glds16(K + (size_t)rowk * D + h * 128 + pc * 8, (unsigned)__builtin_amdgcn_readfirstlane(_base + S_K + pc * 1024)); } \
            { const int rowq = grow(b, _i, _r0 + lane); glds16(Q + (size_t)rowq * D + h * 128 + pc * 8, (unsigned)__builtin_amdgcn_readfirstlane(_base + S_Q + pc * 1024)); } \
            { const int rowv = grow(b, _i, _r0 + (pc & 3) * 16 + vrow); glds16(V + (size_t)rowv * 2048 + h * 256 + half * 128 + (pc >> 2) * 32 + (lane & 3) * 8, (unsigned)__builtin_amdgcn_readfirstlane(_base + S_V + pc * 1024)); } } } while (0)
    const bf16_t* kpt[2]; const bf16_t* qpt[2]; const bf16_t* vpt[2];
#pragma unroll
    for (int u = 0; u < 2; ++u) { const int pc = wid * 2 + u;
        kpt[u] = K + (size_t)(b * SEQ + (lane ^ (4 * (pc & 3)))) * D + h * 128 + pc * 8;
        qpt[u] = Q + (size_t)(b * SEQ + lane) * D + h * 128 + pc * 8;
        vpt[u] = V + (size_t)(b * SEQ + (pc & 3) * 16 + vrow) * 2048 + h * 256 + half * 128 + (pc >> 2) * 32 + (lane & 3) * 8; }
#define RET_DMA_FAST(stg) do { const unsigned _base = lds0 + (stg) * STAGE; \
        _Pragma("unroll") for (int u = 0; u < 2; ++u) { const int pc = wid * 2 + u; \
            glds16(kpt[u], (unsigned)__builtin_amdgcn_readfirstlane(_base + S_K + pc * 1024)); glds16(qpt[u], (unsigned)__builtin_amdgcn_readfirstlane(_base + S_Q + pc * 1024)); \
            glds16(vpt[u], (unsigned)__builtin_amdgcn_readfirstlane(_base + S_V + pc * 1024)); \
            kpt[u] += (size_t)64 * D; qpt[u] += (size_t)64 * D; vpt[u] += (size_t)64 * 2048; } } while (0)
    __builtin_amdgcn_s_waitcnt(0);
    RET_DMA(1, 1); RET_DMA_FAST(2);
    for (int j = 1; j < 34; ++j) {
#if PROBE_GROUP == 10 || PROBE_GROUP == 11
        const unsigned long long _pt0 = __builtin_amdgcn_s_memrealtime();
#endif
        if (j < 33) asm volatile("s_waitcnt vmcnt(6) lgkmcnt(0)" ::: "memory"); else asm volatile("s_waitcnt vmcnt(0) lgkmcnt(0)" ::: "memory");
        __builtin_amdgcn_s_barrier(); asm volatile("" ::: "memory");
#if PROBE_GROUP == 10
        if (blockIdx.x == 0 && tid == 0) *(LAS unsigned long long*)(lds + LDSCTL_OFF + 8192) += __builtin_amdgcn_s_memrealtime() - _pt0;
#endif
#if PROBE_GROUP == 11
        if (blockIdx.x == 0 && tid == 256) *(LAS unsigned long long*)(lds + LDSCTL_OFF + 8192) += __builtin_amdgcn_s_memrealtime() - _pt0;
#endif
        if (j > 1) stats_flush64(st, b, h, half, j - 1, gst, tid);
        const LAS unsigned char* sb_ = lds + (j % 3) * STAGE;
        const int i = j >> 1, hh = j & 1;
        if (hh == 0) {
#pragma unroll
            for (int d = 0; d < 4; ++d) T[d] *= g128;
        }
        bf16x8 qf[8];
#pragma unroll
        for (int ks = 0; ks < 8; ++ks) qf[ks] = *(const LAS bf16x8*)(sb_ + S_Q + (2 * ks) * 1024 + qro);
        __builtin_amdgcn_sched_barrier(0);
        f32x16 yT = {};
#pragma unroll
        for (int db = 0; db < 4; ++db) {
            yT = __builtin_amdgcn_mfma_f32_32x32x16_bf16(pack8(T[db], 0), qf[2 * db], yT, 0, 0, 0);
            yT = __builtin_amdgcn_mfma_f32_32x32x16_bf16(pack8(T[db], 8), qf[2 * db + 1], yT, 0, 0, 0);
        }
        for (int sb = 0; sb <= cbl; ++sb) {
            f32x16 sc = {};
            bf16x8 kfr[8];
#pragma unroll
            for (int ks = 0; ks < 8; ++ks) kfr[ks] = *(const LAS bf16x8*)(sb_ + S_K + sb * 512 + (2 * ks) * 1024 + ((ks & 1) ? krB : krA));
            const LAS unsigned char* vb = sb_ + S_V + et * 4096 + (32 * sb) * 64 + troff;
            const bf16x8 vf0 = trfrag(vb), vf1 = trfrag(vb + 1024);
            __builtin_amdgcn_sched_barrier(0);
#pragma unroll
            for (int ks = 0; ks < 8; ++ks) sc = __builtin_amdgcn_mfma_f32_32x32x16_bf16(kfr[ks], qf[ks], sc, 0, 0, 0);
            if (sb == cbl) {
#pragma unroll
                for (int r = 0; r < 16; ++r) if (crow(r, hi) > r32) sc[r] = 0.f;
            }
            yT = __builtin_amdgcn_mfma_f32_32x32x16_bf16(vf0, pack8(sc, 0), yT, 0, 0, 0);
            yT = __builtin_amdgcn_mfma_f32_32x32x16_bf16(vf1, pack8(sc, 8), yT, 0, 0, 0);
        }
        {
            const int jl = 32 * cbl + r32, jrow = 64 * hh + jl; const int row = grow(b, i, jrow);
            float s1 = 0.f, s2 = 0.f;
#pragma unroll
            for (int r = 0; r < 16; ++r) { s1 += yT[r]; s2 += yT[r] * yT[r]; }
            s1 += partner32(s1, hi); s2 += partner32(s2, hi);
            if (hi == 0) *(LAS f32x2*)(st + jl * 8 + et * 2) = (f32x2){s1, s2};
            const bool ok = (i > 0) || (jrow >= 112 && b == 0);
            if (ok) {
                bf16_t* yp = (i > 0 ? V + (size_t)row * 2048 : YM + (size_t)(row - MREAL) * 2048) + h * 256 + half * 128 + et * 32 + 4 * hi;
#pragma unroll
                for (int g = 0; g < 4; ++g) { u32x2 w; w.x = pk2(yT[4 * g], yT[4 * g + 1]); w.y = pk2(yT[4 * g + 2], yT[4 * g + 3]); gstore8_asm(yp + 8 * g, w); }
            }
        }
#pragma unroll
        for (int ks = 0; ks < 4; ++ks) {
            const bf16x8 vf = trfrag(sb_ + S_V + et * 4096 + (16 * ks) * 64 + troff);
            bf16x8 kf[4];
#pragma unroll
            for (int db = 0; db < 4; ++db) {
                const LAS unsigned char* kb = sb_ + S_K + db * 4096 + ks * 256 + ktr_lane;
                const s16x4 a = vtr(kb + ktr_r0), c = vtr(kb + ktr_r1);
                kf[db] = (bf16x8){a[0], a[1], a[2], a[3], c[0], c[1], c[2], c[3]};
            }
            __builtin_amdgcn_sched_barrier(0);
#pragma unroll
            for (int db = 0; db < 4; ++db) T[db] = __builtin_amdgcn_mfma_f32_32x32x16_bf16(kf[db], vf, T[db], 0, 0, 0);
        }
        if (j + 2 < 34) RET_DMA_FAST((j + 2) % 3);
    }
#undef RET_DMA
#undef RET_DMA_FAST
    asm volatile("s_waitcnt vmcnt(0) lgkmcnt(0)" ::: "memory"); __builtin_amdgcn_s_barrier(); asm volatile("" ::: "memory");
    stats_flush64(st, b, h, half, 33, gst, tid);
}

constexpr int STAGE5 = 57344, S5_K = 0, S5_Q = 16384, S5_V = 24576;
constexpr int L_ST5 = LDSCTL_OFF + 2048;
constexpr int S5_G = 2 * 57344;
static_assert(S5_G + 2 * 16384 <= RING_BYTES, "gate tiles");
__device__ __forceinline__ u32x2 gload8_asm(const void* p) { u32x2 v; asm volatile("global_load_dwordx2 %0, %1, off" : "=v"(v) : "v"(p) : "memory"); return v; }
__device__ __forceinline__ void gstore4_asm(void* p, unsigned v) { asm volatile("global_store_dword %0, %1, off" :: "v"(p), "v"(v) : "memory"); }

template <bool F8OUT>
__device__ __forceinline__ void ret_item5(LAS unsigned char* lds, int b, int h, int rh, const bf16_t* Q, const bf16_t* K, const bf16_t* V, bf16_t* Gt, unsigned char* A8, const float* gn, int wid, int lane) {
    const int r32 = lane & 31, hi = lane >> 5, et = wid;
    const float gamma = 1.0f - exp2f(-5.0f - (float)h); const float g128 = exp2f(128.0f * log2f(gamma));
    f32x16 T[4];
#pragma unroll
    for (int d = 0; d < 4; ++d) T[d] = (f32x16){};
    LAS float* st = (LAS float*)(lds + L_ST5);
    const unsigned lds0 = (unsigned)(size_t)lds;
    const int trq = (lane & 15) >> 2, trp = lane & 3, trb = (lane >> 4) & 1;
    const int troff = (4 * hi + trq) * 64 + trb * 32 + trp * 8;
    const int trp2 = ((trp & 1) << 1) | (trp >> 1);
    const int ktr_ch = 2 * trb + (trp2 >> 1);
    const int ktr_lane = (trp2 & 1) * 8;
    const int ktr_r0 = (4 * hi + trq) * 64 + ((ktr_ch ^ hi) * 16), ktr_r1 = (4 * hi + 8 + trq) * 64 + ((ktr_ch ^ (hi + 2)) * 16);
    const int swz = (r32 >> 2) & 3;
    const int krA = r32 * 64 + ((hi ^ swz) * 16), krB = r32 * 64 + (((2 + hi) ^ swz) * 16);
    LAS float* gnl = (LAS float*)(lds + L_ST5 + 4096);
    if (threadIdx.x < 256) gnl[threadIdx.x] = gn[h * 256 + threadIdx.x];
    const bf16_t* kpt[2]; const bf16_t* qpt; const bf16_t* vpt[4];
    const int dch = (lane & 3) ^ ((lane >> 4) & 3), drow = lane >> 2;
#pragma unroll
    for (int u = 0; u < 2; ++u) { const int pc = wid * 2 + u; kpt[u] = K + (size_t)(b * SEQ + 16 * (pc & 3) + drow) * D + h * 128 + (4 * (pc >> 2) + dch) * 8; }
    qpt = Q + (size_t)(b * SEQ + 32 * rh + 16 * (wid & 1) + drow) * D + h * 128 + (4 * (wid >> 1) + dch) * 8;
#pragma unroll
    for (int u = 0; u < 4; ++u) vpt[u] = V + (size_t)(b * SEQ + 16 * u + (lane >> 2)) * 2048 + h * 256 + 32 * wid + 8 * (lane & 3);
#define R5_DMA_FAST(stg) do { const unsigned _base = lds0 + (stg) * STAGE5; \
        _Pragma("unroll") for (int u = 0; u < 2; ++u) { glds16(kpt[u], (unsigned)__builtin_amdgcn_readfirstlane(_base + S5_K + (wid * 2 + u) * 1024)); kpt[u] += (size_t)64 * D; } \
        glds16(qpt, (unsigned)__builtin_amdgcn_readfirstlane(_base + S5_Q + wid * 1024)); qpt += (size_t)64 * D; \
        _Pragma("unroll") for (int u = 0; u < 4; ++u) { glds16(vpt[u], (unsigned)__builtin_amdgcn_readfirstlane(_base + S5_V + (wid * 4 + u) * 1024)); vpt[u] += (size_t)64 * 2048; } } while (0)
#define R5_DMA_META(stg) do { const unsigned _base = lds0 + (stg) * STAGE5; \
        _Pragma("unroll") for (int u = 0; u < 2; ++u) { const int pc = wid * 2 + u; const int rowk = grow(b, 0, 64 + 16 * (pc & 3) + drow); \
            glds16(K + (size_t)rowk * D + h * 128 + (4 * (pc >> 2) + dch) * 8, (unsigned)__builtin_amdgcn_readfirstlane(_base + S5_K + pc * 1024)); } \
        { const int rowq = grow(b, 0, 64 + 32 * rh + 16 * (wid & 1) + drow); glds16(Q + (size_t)rowq * D + h * 128 + (4 * (wid >> 1) + dch) * 8, (unsigned)__builtin_amdgcn_readfirstlane(_base + S5_Q + wid * 1024)); } \
        _Pragma("unroll") for (int u = 0; u < 4; ++u) { const int rowv = grow(b, 0, 64 + 16 * u + (lane >> 2)); \
            glds16(V + (size_t)rowv * 2048 + h * 256 + 32 * wid + 8 * (lane & 3), (unsigned)__builtin_amdgcn_readfirstlane(_base + S5_V + (wid * 4 + u) * 1024)); } } while (0)
#define R5_FINALIZE(jp) do { const int _ip = (jp) >> 1, _jr = 64 * ((jp) & 1) + 32 * rh + r32; const bool _ok = (_ip > 0) || (_jr >= 112 && b == 0); const int _row = grow(b, _ip, _jr); \
        asm volatile("" : "+v"(yp) :: "memory");     \
        const LAS unsigned char* _gl = lds + S5_G + ((jp) & 1) * 16384 + et * 2048 + r32 * 64 + 8 * hi; u32x2 gq[4]; _Pragma("unroll") for (int g = 0; g < 4; ++g) gq[g] = *(const LAS u32x2*)(_gl + 16 * g); \
        asm volatile("" : "+v"(gq[0]), "+v"(gq[1]), "+v"(gq[2]), "+v"(gq[3]) :: "memory");     \
        const LAS f32x4* sp = (const LAS f32x4*)(st + (((jp) & 1) * 32 + r32) * 16); const f32x4 q0 = sp[0], q1 = sp[1], q2 = sp[2], q3 = sp[3]; \
        const float s1 = ((q0[0] + q0[2]) + (q1[0] + q1[2])) + ((q2[0] + q2[2]) + (q3[0] + q3[2])), s2 = ((q0[1] + q0[3]) + (q1[1] + q1[3])) + ((q2[1] + q2[3]) + (q3[1] + q3[3])); \
        const float mu = s1 * (1.0f / 256.0f); const float rsd = __builtin_amdgcn_rsqf(fmaxf(s2 * (1.0f / 256.0f) - mu * mu, 0.f) + EPS); \
        _Pragma("unroll") for (int g = 0; g < 4; ++g) { const f32x4 gv = *(const LAS f32x4*)(gnl + 32 * et + 8 * g + 4 * hi) * rsd; \
            const float o0 = bflo(gq[g].x) * (yp[4 * g] - mu) * gv[0], o1 = bfhi(gq[g].x) * (yp[4 * g + 1] - mu) * gv[1]; \
            const float o2 = bflo(gq[g].y) * (yp[4 * g + 2] - mu) * gv[2], o3 = bfhi(gq[g].y) * (yp[4 * g + 3] - mu) * gv[3]; \
              \
            if (F8OUT) { int pk = __builtin_amdgcn_cvt_pk_fp8_f32(pg8::clamp8(F8_A2 * o0), pg8::clamp8(F8_A2 * o1), 0, false); pk = __builtin_amdgcn_cvt_pk_fp8_f32(pg8::clamp8(F8_A2 * o2), pg8::clamp8(F8_A2 * o3), pk, true); \
                         *(LAS unsigned*)(lds + S5_G + ((jp) & 1) * 16384 + et * 2048 + r32 * 32 + 8 * g + 4 * hi) = (unsigned)pk; } \
            else { u32x2 w; w.x = pk2(o0, o1); w.y = pk2(o2, o3); *(LAS u32x2*)(lds + S5_G + ((jp) & 1) * 16384 + et * 2048 + r32 * 64 + 8 * hi + 16 * g) = w; } } \
        } while (0)
#define R5_FINALIZE_B(jp) do { const int _ip = (jp) >> 1; \
        asm volatile("" ::: "memory");     \
        if (F8OUT) { const int _r2 = lane >> 1, _jr2 = 64 * ((jp) & 1) + 32 * rh + _r2; const f32x4 ov = *(const LAS f32x4*)(lds + S5_G + ((jp) & 1) * 16384 + et * 2048 + lane * 16); \
                     if ((_ip > 0) || (_jr2 >= 112 && b == 0)) gstore16_asm(A8 + (size_t)grow(b, _ip, _jr2) * 2048 + h * 256 + 32 * et + 16 * (lane & 1), ov); } \
        else { _Pragma("unroll") for (int u = 0; u < 2; ++u) { const int _r2 = 16 * u + (lane >> 2), _jr2 = 64 * ((jp) & 1) + 32 * rh + _r2; const f32x4 ov = *(const LAS f32x4*)(lds + S5_G + ((jp) & 1) * 16384 + et * 2048 + u * 1024 + lane * 16); \
                     if ((_ip > 0) || (_jr2 >= 112 && b == 0)) gstore16_asm(Gt + (size_t)grow(b, _ip, _jr2) * 2048 + h * 256 + 32 * et + 8 * (lane & 3), ov); } } } while (0)
#define R5_GLOAD(jp) do { const int _ip = (jp) >> 1; _Pragma("unroll") for (int u = 0; u < 2; ++u) { const int _row = grow(b, _ip, 64 * ((jp) & 1) + 32 * rh + 16 * u + (lane >> 2)); \
        glds16(Gt + (size_t)_row * 2048 + h * 256 + 32 * et + 8 * (lane & 3), (unsigned)__builtin_amdgcn_readfirstlane(lds0 + S5_G + ((jp) & 1) * 16384 + et * 2048 + u * 1024)); } } while (0)
    __builtin_amdgcn_s_waitcnt(0);
    R5_DMA_META(1);
    f32x16 yp = {};
    for (int j = 1; j < 34; ++j) {
#if PROBE_GROUP >= 70 && PROBE_GROUP <= 79
        unsigned long long _ts = __builtin_amdgcn_s_memrealtime();
#define R5_STAMP(k) do { asm volatile("" ::: "memory"); const unsigned long long _tn = __builtin_amdgcn_s_memrealtime(); if (PROBE_GROUP == 70 + (k) && blockIdx.x == 0 && threadIdx.x == 0) *(LAS unsigned long long*)(lds + LDSCTL_OFF + 8192) += _tn - _ts; _ts = _tn; } while (0)
#else
#define R5_STAMP(k) do { } while (0)
#endif
        asm volatile("s_waitcnt vmcnt(0) lgkmcnt(0)" ::: "memory"); __builtin_amdgcn_s_barrier(); asm volatile("" ::: "memory");
        R5_STAMP(0);
        if (j + 1 < 34) R5_DMA_FAST((j + 1) & 1);
        R5_GLOAD(j);
        R5_STAMP(1);
        if (j > 1) R5_FINALIZE(j - 1);
        R5_STAMP(2);
        const LAS unsigned char* sb_ = lds + (j & 1) * STAGE5;
        const int hh = j & 1;
        if (hh == 0) {
#pragma unroll
            for (int d = 0; d < 4; ++d) T[d] *= g128;
        }
        bf16x8 qf[8];
#pragma unroll
        for (int ks = 0; ks < 8; ++ks) qf[ks] = *(const LAS bf16x8*)(sb_ + S5_Q + (ks >> 1) * 2048 + ((ks & 1) ? krB : krA));
        __builtin_amdgcn_sched_barrier(0);
        f32x16 yT = {};
#pragma unroll
        for (int db = 0; db < 4; ++db) {
            yT = __builtin_amdgcn_mfma_f32_32x32x16_bf16(pack8(T[db], 0), qf[2 * db], yT, 0, 0, 0);
            yT = __builtin_amdgcn_mfma_f32_32x32x16_bf16(pack8(T[db], 8), qf[2 * db + 1], yT, 0, 0, 0);
        }
        if (j > 1) R5_FINALIZE_B(j - 1);
        R5_STAMP(3);
        for (int sb = 0; sb <= rh; ++sb) {
            f32x16 sc = {};
            bf16x8 kfr[8];
#pragma unroll
            for (int ks = 0; ks < 8; ++ks) kfr[ks] = *(const LAS bf16x8*)(sb_ + S5_K + sb * 2048 + (ks >> 1) * 4096 + ((ks & 1) ? krB : krA));
            const LAS unsigned char* vb = sb_ + S5_V + et * 4096 + (32 * sb) * 64 + troff;
            const bf16x8 vf0 = trfrag(vb), vf1 = trfrag(vb + 1024);
            __builtin_amdgcn_sched_barrier(0);
#pragma unroll
            for (int ks = 0; ks < 8; ++ks) sc = __builtin_amdgcn_mfma_f32_32x32x16_bf16(kfr[ks], qf[ks], sc, 0, 0, 0);
            if (sb == rh) {
#pragma unroll
                for (int r = 0; r < 16; ++r) if (crow(r, hi) > r32) sc[r] = 0.f;
            }
            yT = __builtin_amdgcn_mfma_f32_32x32x16_bf16(vf0, pack8(sc, 0), yT, 0, 0, 0);
            yT = __builtin_amdgcn_mfma_f32_32x32x16_bf16(vf1, pack8(sc, 8), yT, 0, 0, 0);
        }
        R5_STAMP(4);
        {
            float s1 = 0.f, s2 = 0.f;
#pragma unroll
            for (int r = 0; r < 16; ++r) { s1 += yT[r]; s2 += yT[r] * yT[r]; }
            s1 += partner32(s1, hi); s2 += partner32(s2, hi);
            if (hi == 0) *(LAS f32x2*)(st + ((hh * 32 + r32) * 8 + et) * 2) = (f32x2){s1, s2};
        }
        yp = yT;
        R5_STAMP(5);
#pragma unroll
        for (int ks = 0; ks < 4; ++ks) {
            const bf16x8 vf = trfrag(sb_ + S5_V + et * 4096 + (16 * ks) * 64 + troff);
            bf16x8 kf[4];
#pragma unroll
            for (int db = 0; db < 4; ++db) {
                const LAS unsigned char* kb = sb_ + S5_K + db * 4096 + ks * 1024 + ktr_lane;
                const s16x4 a = vtr(kb + ktr_r0), c = vtr(kb + ktr_r1);
                kf[db] = (bf16x8){a[0], a[1], a[2], a[3], c[0], c[1], c[2], c[3]};
            }
            __builtin_amdgcn_sched_barrier(0);
#pragma unroll
            for (int db = 0; db < 4; ++db) T[db] = __builtin_amdgcn_mfma_f32_32x32x16_bf16(kf[db], vf, T[db], 0, 0, 0);
        }
        R5_STAMP(6);
    }
#undef R5_STAMP
    asm volatile("s_waitcnt vmcnt(0) lgkmcnt(0)" ::: "memory"); __builtin_amdgcn_s_barrier(); asm volatile("" ::: "memory");
    R5_FINALIZE(33); R5_FINALIZE_B(33);
#undef R5_DMA_FAST
#undef R5_DMA_META
#undef R5_FINALIZE
#undef R5_FINALIZE_B
#undef R5_GLOAD
}
}
__device__ __forceinline__ void ret_mfma(const Ctx& C, const bf16_t* Q, const bf16_t* Kk, bf16_t* V, bf16_t* YM, float* gst) {
    const int bx = (int)blockIdx.x, vcu = (C.G % 8 == 0) ? (bx % 8) * (C.G / 8) + bx / 8 : bx;
    for (int item = vcu; item < NBATCH * 8 * 2; item += C.G) {
        const int half = item & 1, h = (item >> 1) & 7, b = item >> 4;
        retm::ret_item(C.lds, b, h, half, Q, Kk, V, YM, gst, C.wave, C.lane, C.tid);
    }
    asm volatile("s_waitcnt vmcnt(0)" ::: "memory");
    __syncthreads();
}


template <bool F8OUT> __device__ __forceinline__ void ret_mfma5(const Ctx& C, const bf16_t* Q, const bf16_t* Kk, const bf16_t* V, bf16_t* Gt, unsigned char* A8, const float* gn) {
    const int bx = (int)blockIdx.x, vcu = (C.G % 8 == 0) ? (bx % 8) * (C.G / 8) + bx / 8 : bx;
    for (int item = vcu; item < NBATCH * 8 * 2; item += C.G) {
        const int rh = item & 1, h = (item >> 1) & 7, b = item >> 4;
        retm::ret_item5<F8OUT>(C.lds, b, h, rh, Q, Kk, V, Gt, A8, gn, C.wave, C.lane);
    }
    asm volatile("s_waitcnt vmcnt(0)" ::: "memory");
    __syncthreads();
}
__device__ __forceinline__ void sb_naive(const Ctx& C, bf16_t* Q, const bf16_t* Kk, const bf16_t* V) {
    const int NIT = NBATCH * 16 * 32 + 16;
    for (int it = (NAIVE_SB ? C.gw : NBATCH * 16 * 32 + C.gw); it < NIT; it += C.NGW) {
        int b, h, p0, nq;
        if (it < NBATCH * 16 * 32) { const int bh = it & 255, qb = it >> 8; b = bh >> 4; h = bh & 15; p0 = NMETA + qb * 64; nq = 64; }
        else { b = 0; h = it - NBATCH * 16 * 32; p0 = 0; nq = 16; }
        const int p = p0 + C.lane; const bool valid = C.lane < nq;
        const int row = pos_row(b, valid ? p : p0);
        float q[64], o[64];
        { const u32x4* qp = (const u32x4*)(Q + (size_t)row * D + h * 64);
#pragma unroll
          for (int jj = 0; jj < 8; ++jj) { const u32x4 t = qp[jj]; q[8 * jj] = bflo(t.x); q[8 * jj + 1] = bfhi(t.x); q[8 * jj + 2] = bflo(t.y); q[8 * jj + 3] = bfhi(t.y); q[8 * jj + 4] = bflo(t.z); q[8 * jj + 5] = bfhi(t.z); q[8 * jj + 6] = bflo(t.w); q[8 * jj + 7] = bfhi(t.w); } }
#pragma unroll
        for (int d = 0; d < 64; ++d) o[d] = 0.f;
        float P = 1.0f;
        for (int s = p0 + nq - 2; s >= 0; --s) {
            const int krow = pos_row(b, s);
            const u32x4* kp = (const u32x4*)(Kk + (size_t)krow * D + h * 64);
            const u32x4* vp = (const u32x4*)(V + (size_t)krow * D + h * 64);
            float z = 0.f;
#pragma unroll
            for (int jj = 0; jj < 8; ++jj) { const u32x4 t = kp[jj];
                z += q[8 * jj] * bflo(t.x) + q[8 * jj + 1] * bfhi(t.x) + q[8 * jj + 2] * bflo(t.y) + q[8 * jj + 3] * bfhi(t.y) + q[8 * jj + 4] * bflo(t.z) + q[8 * jj + 5] * bfhi(t.z) + q[8 * jj + 6] * bflo(t.w) + q[8 * jj + 7] * bfhi(t.w); }
            z = fminf(z, 100.f);
            const float E = fast_exp2(z), r = fast_rcp(1.0f + E);
            const bool act = valid && (s < p);
            const float w = act ? E * r * P : 0.f;
            P = act ? P * r : P;
#pragma unroll
            for (int jj = 0; jj < 8; ++jj) { const u32x4 t = vp[jj];
                o[8 * jj] += w * bflo(t.x); o[8 * jj + 1] += w * bfhi(t.x); o[8 * jj + 2] += w * bflo(t.y); o[8 * jj + 3] += w * bfhi(t.y); o[8 * jj + 4] += w * bflo(t.z); o[8 * jj + 5] += w * bfhi(t.z); o[8 * jj + 6] += w * bflo(t.w); o[8 * jj + 7] += w * bfhi(t.w); }
        }
        if (valid) { u32x4* op = (u32x4*)(Q + (size_t)row * D + h * 64);
#pragma unroll
            for (int jj = 0; jj < 8; ++jj) { u32x4 t; t.x = pk2(o[8 * jj], o[8 * jj + 1]); t.y = pk2(o[8 * jj + 2], o[8 * jj + 3]); t.z = pk2(o[8 * jj + 4], o[8 * jj + 5]); t.w = pk2(o[8 * jj + 6], o[8 * jj + 7]); op[jj] = t; } }
    }
}


__device__ __forceinline__ void sb_meta(const Ctx& C, bf16_t* Q, const bf16_t* Kk, const bf16_t* V) {
    if (C.gw >= 16) return;
    const int h = C.gw; int lane = C.lane; asm volatile("" : "+v"(lane));
    LAS unsigned char* sk = C.lds + 98304 + C.wave * 4096; LAS unsigned char* sv = sk + 2048;
#pragma unroll
    for (int u = 0; u < 2; ++u) { const int c = lane + 64 * u, key = c >> 3, part = c & 7;
        *(LAS u32x4*)(sk + key * 128 + part * 16) = *(const u32x4*)(Kk + (size_t)(MREAL + key) * D + h * 64 + part * 8);
        *(LAS u32x4*)(sv + key * 128 + part * 16) = *(const u32x4*)(V + (size_t)(MREAL + key) * D + h * 64 + part * 8); }
    const bool valid = lane < NMETA; const int p = valid ? lane : 0; const int row = MREAL + p;
    float q[64], o[64];
    { const u32x4* qp = (const u32x4*)(Q + (size_t)row * D + h * 64);
#pragma unroll
      for (int jj = 0; jj < 8; ++jj) { const u32x4 t = qp[jj]; q[8 * jj] = bflo(t.x); q[8 * jj + 1] = bfhi(t.x); q[8 * jj + 2] = bflo(t.y); q[8 * jj + 3] = bfhi(t.y); q[8 * jj + 4] = bflo(t.z); q[8 * jj + 5] = bfhi(t.z); q[8 * jj + 6] = bflo(t.w); q[8 * jj + 7] = bfhi(t.w); } }
#pragma unroll
    for (int d = 0; d < 64; ++d) o[d] = 0.f;
    LDS_WAIT();
    float P = 1.0f;
    for (int s_ = NMETA - 2; s_ >= 0; --s_) {
        const LAS u32x4* kp = (const LAS u32x4*)(sk + s_ * 128); const LAS u32x4* vp = (const LAS u32x4*)(sv + s_ * 128);
        float z = 0.f;
#pragma unroll
        for (int jj = 0; jj < 8; ++jj) { const u32x4 t = kp[jj];
            z += q[8 * jj] * bflo(t.x) + q[8 * jj + 1] * bfhi(t.x) + q[8 * jj + 2] * bflo(t.y) + q[8 * jj + 3] * bfhi(t.y) + q[8 * jj + 4] * bflo(t.z) + q[8 * jj + 5] * bfhi(t.z) + q[8 * jj + 6] * bflo(t.w) + q[8 * jj + 7] * bfhi(t.w); }
        z = fminf(z, 100.f);
        const float E = fast_exp2(z), r = fast_rcp(1.0f + E);
        const bool act = valid && (s_ < p);
        const float w = act ? E * r * P : 0.f;
        P = act ? P * r : P;
#pragma unroll
        for (int jj = 0; jj < 8; ++jj) { const u32x4 t = vp[jj];
            o[8 * jj] += w * bflo(t.x); o[8 * jj + 1] += w * bfhi(t.x); o[8 * jj + 2] += w * bflo(t.y); o[8 * jj + 3] += w * bfhi(t.y); o[8 * jj + 4] += w * bflo(t.z); o[8 * jj + 5] += w * bfhi(t.z); o[8 * jj + 6] += w * bflo(t.w); o[8 * jj + 7] += w * bfhi(t.w); }
    }
    if (valid) { u32x4* op = (u32x4*)(Q + (size_t)row * D + h * 64);
#pragma unroll
        for (int jj = 0; jj < 8; ++jj) { u32x4 t; t.x = pk2(o[8 * jj], o[8 * jj + 1]); t.y = pk2(o[8 * jj + 2], o[8 * jj + 3]); t.z = pk2(o[8 * jj + 4], o[8 * jj + 5]); t.w = pk2(o[8 * jj + 6], o[8 * jj + 7]); op[jj] = t; } }
    LDS_WAIT();
}

namespace sbm {
typedef float f32x16 __attribute__((ext_vector_type(16)));
typedef short s16x4 __attribute__((ext_vector_type(4)));
typedef short v4i16_t __attribute__((ext_vector_type(4)));
constexpr int SLOTB = 8192, LDS_K = 0, LDS_V = 3 * SLOTB;
__device__ __forceinline__ int crow(int r, int hi) { return (r & 3) + 8 * (r >> 2) + 4 * hi; }
__device__ __forceinline__ s16x4 vtr(const LAS unsigned char* p) { return __builtin_bit_cast(s16x4, __builtin_amdgcn_ds_read_tr16_b64_v4i16((LAS v4i16_t*)p)); }
__device__ __forceinline__ float partner32(float x, int hi) { auto rr = __builtin_amdgcn_permlane32_swap(__float_as_uint(x), __float_as_uint(x), false, false); return __uint_as_float(hi ? rr[0] : rr[1]); }

__device__ __forceinline__ void sb_block(const f32x16& p, float& Pin, int hi, bf16x8& f0, bf16x8& f1) {
    float rr[16];
#pragma unroll
    for (int r = 0; r < 16; ++r) { const float E = fast_exp2(p[r]); rr[r] = fast_rcp(1.0f + E); }
    float G[4], PG[4];
#pragma unroll
    for (int g = 0; g < 4; ++g) { G[g] = (rr[4 * g] * rr[4 * g + 1]) * (rr[4 * g + 2] * rr[4 * g + 3]); PG[g] = partner32(G[g], hi); }
    float R[4]; R[3] = 1.0f; R[2] = G[3] * PG[3]; R[1] = R[2] * (G[2] * PG[2]); R[0] = R[1] * (G[1] * PG[1]);
    const float tot = R[0] * (G[0] * PG[0]);
    float w[16];
#pragma unroll
    for (int g = 0; g < 4; ++g) {
        float sfx = Pin * R[g] * (hi ? 1.0f : PG[g]), nx;
        nx = sfx * rr[4 * g + 3]; w[4 * g + 3] = sfx - nx; sfx = nx;
        nx = sfx * rr[4 * g + 2]; w[4 * g + 2] = sfx - nx; sfx = nx;
        nx = sfx * rr[4 * g + 1]; w[4 * g + 1] = sfx - nx; sfx = nx;
        nx = sfx * rr[4 * g];     w[4 * g] = sfx - nx;
    }
    Pin *= tot;
    u32x4 a, b;
    a.x = pk2(w[0], w[1]); a.y = pk2(w[2], w[3]); a.z = pk2(w[4], w[5]); a.w = pk2(w[6], w[7]);
    b.x = pk2(w[8], w[9]); b.y = pk2(w[10], w[11]); b.z = pk2(w[12], w[13]); b.w = pk2(w[14], w[15]);
    f0 = __builtin_bit_cast(bf16x8, a); f1 = __builtin_bit_cast(bf16x8, b);
}

__device__ __forceinline__ void sb_tile(const LAS unsigned char* kbase, const LAS unsigned char* vbase, const bf16x8 q0f, const bf16x8 q1f, const bf16x8 q2f, const bf16x8 q3f, f32x16& o0, f32x16& o1, float& Pin, int mode, int jb, int qrel, int r32, int hi, int lane) {
    const int kswz = (r32 >> 2) & 3;
    const LAS unsigned char* kbA = kbase + r32 * 64 + ((hi ^ kswz) * 16); const LAS unsigned char* kbB = kbase + r32 * 64 + (((2 + hi) ^ kswz) * 16);
    const LAS unsigned char* vb = vbase + ((lane >> 4) & 1) * 32 + (lane & 3) * 8 + (4 * hi + ((lane & 15) >> 2)) * 64;
    f32x16 p0 = {}, p1 = {};
#pragma unroll
    for (int d0 = 0; d0 < 4; ++d0) {
        const LAS unsigned char* kb = ((d0 & 1) ? kbB : kbA) + (d0 >> 1) * 4096;
        const bf16x8 k0 = *(const LAS bf16x8*)kb, k1 = *(const LAS bf16x8*)(kb + 2048);
        const bf16x8 qd = d0 == 0 ? q0f : d0 == 1 ? q1f : d0 == 2 ? q2f : q3f;
        p0 = __builtin_amdgcn_mfma_f32_32x32x16_bf16(k0, qd, p0, 0, 0, 0);
        p1 = __builtin_amdgcn_mfma_f32_32x32x16_bf16(k1, qd, p1, 0, 0, 0);
    }
    if (mode != 0) {
        asm volatile("" : "+v"(p0), "+v"(p1));
        const int kofs = (mode == 1) ? 64 * jb : 0, qlim = (mode == 1) ? qrel : NMETA, lim1 = (mode == 1) ? qrel : -1000000;
#pragma unroll
        for (int r = 0; r < 16; ++r) { const int kv = kofs + crow(r, hi); if (kv >= qlim) p0[r] = -1.0e30f; if (kv + 32 >= lim1) p1[r] = -1.0e30f; }
    }
    bf16x8 pf[4];
    sb_block(p1, Pin, hi, pf[2], pf[3]);
    sb_block(p0, Pin, hi, pf[0], pf[1]);
#pragma unroll
    for (int ks = 0; ks < 4; ++ks) {
        const s16x4 a0 = vtr(vb + ks * 1024), a1 = vtr(vb + ks * 1024 + 512), c0 = vtr(vb + 4096 + ks * 1024), c1 = vtr(vb + 4096 + ks * 1024 + 512);
        const bf16x8 va = {a0[0], a0[1], a0[2], a0[3], a1[0], a1[1], a1[2], a1[3]}, vc = {c0[0], c0[1], c0[2], c0[3], c1[0], c1[1], c1[2], c1[3]};
        o0 = __builtin_amdgcn_mfma_f32_32x32x16_bf16(va, pf[ks], o0, 0, 0, 0);
        o1 = __builtin_amdgcn_mfma_f32_32x32x16_bf16(vc, pf[ks], o1, 0, 0, 0);
    }
}
constexpr int SLOT2 = 32768;
__device__ __forceinline__ void sb_unit(LAS unsigned char* lds, int b, int h, int qi, bf16_t* Q, const bf16_t* K, const bf16_t* V, int wid, int lane) {
    const int r32 = lane & 31, hi = lane >> 5;
    const size_t rowbase = (size_t)b * SEQ;
    const unsigned lds0 = (unsigned)(size_t)lds;
    const int q0 = qi * 256, NS = 2 * (qi + 1);
    bf16_t* qrow = Q + (rowbase + q0 + wid * 32 + r32) * D + h * 64;
    bf16x8 qf[4];
#pragma unroll
    for (int d0 = 0; d0 < 4; ++d0) qf[d0] = *(const bf16x8*)(qrow + d0 * 16 + hi * 8);
    const int vkey = 16 * (wid & 3) + (lane >> 2);
    const int kdrow = 16 * (wid & 3) + (lane >> 2), kdch = 4 * (wid >> 2) + ((lane & 3) ^ ((lane >> 4) & 3));
    const bf16_t* ksrc = K + (rowbase + kdrow) * D + h * 64 + kdch * 8;
    const bf16_t* vsrc = V + (rowbase + vkey) * D + h * 64 + (wid >> 2) * 32 + (lane & 3) * 8;
    const bf16_t* ksrc_m = K + (size_t)(MREAL + (kdrow < 16 ? kdrow : 15)) * D + h * 64 + kdch * 8;
    const bf16_t* vsrc_m = V + (size_t)(MREAL + (vkey < 16 ? vkey : 15)) * D + h * 64 + (wid >> 2) * 32 + (lane & 3) * 8;
#define SB_ISSUE(step) do { const int _st = (step); const unsigned _sl = lds0 + (_st % 3) * SLOT2 + wid * 1024; \
        if (_st < NS) { const int _t1 = 2 * (NS - 1 - _st) + 1; \
            glds16(ksrc + (size_t)_t1 * 64 * D, (unsigned)__builtin_amdgcn_readfirstlane(_sl)); glds16(ksrc + (size_t)(_t1 - 1) * 64 * D, (unsigned)__builtin_amdgcn_readfirstlane(_sl + 8192)); \
            glds16(vsrc + (size_t)_t1 * 64 * D, (unsigned)__builtin_amdgcn_readfirstlane(_sl + 16384)); glds16(vsrc + (size_t)(_t1 - 1) * 64 * D, (unsigned)__builtin_amdgcn_readfirstlane(_sl + 24576)); } \
        else { glds16(ksrc_m, (unsigned)__builtin_amdgcn_readfirstlane(_sl)); glds16(vsrc_m, (unsigned)__builtin_amdgcn_readfirstlane(_sl + 16384)); } } while (0)
    SB_ISSUE(0); SB_ISSUE(1);
    f32x16 o0 = {}, o1 = {};
    float Pin = 1.0f;
    const int qrel = wid * 32 + r32;
    LAS int* dflag = (LAS int*)(lds + LDSCTL_OFF + 12288);
    bool wdone = false;
    for (int st = 0; st <= NS; ++st) {
        if (st + 1 < NS) asm volatile("s_waitcnt vmcnt(4) lgkmcnt(0)" ::: "memory"); else if (st + 1 == NS) asm volatile("s_waitcnt vmcnt(2) lgkmcnt(0)" ::: "memory"); else asm volatile("s_waitcnt vmcnt(0) lgkmcnt(0)" ::: "memory");
        __builtin_amdgcn_s_barrier(); asm volatile("" ::: "memory");
        if (st > 0) {
            const LAS int* df = dflag + ((st - 1) & 1) * 8;
            if ((df[0] & df[1] & df[2] & df[3] & df[4] & df[5] & df[6] & df[7]) != 0) break;
        }
        if (st + 2 <= NS) SB_ISSUE(st + 2);
        const LAS unsigned char* sl = lds + (st % 3) * SLOT2;
        const int nsub = (st == NS) ? 1 : 2;
#pragma unroll 1
        for (int sub = 0; sub < nsub; ++sub) {
            const int mode = (st == NS) ? 2 : (st < 2 ? 1 : 0);
            const int jb = 3 - 2 * st - sub;
            if (mode == 1 && 64 * jb > wid * 32 + 31) continue;
            if (wdone) continue;
            sb_tile(sl + sub * 8192, sl + 16384 + sub * 8192, qf[0], qf[1], qf[2], qf[3], o0, o1, Pin, mode, jb, qrel, r32, hi, lane);
        }
        { const int dn = __all(Pin < 9.0e-13f) ? 1 : 0; wdone = dn != 0; if (lane == 0) dflag[(st & 1) * 8 + wid] = dn; }
    }
    asm volatile("s_waitcnt vmcnt(0)" ::: "memory");
#undef SB_ISSUE
#pragma unroll
    for (int g = 0; g < 4; ++g) {
        u32x2 w0, w1; w0.x = pk2(o0[4 * g], o0[4 * g + 1]); w0.y = pk2(o0[4 * g + 2], o0[4 * g + 3]); w1.x = pk2(o1[4 * g], o1[4 * g + 1]); w1.y = pk2(o1[4 * g + 2], o1[4 * g + 3]);
        *(u32x2*)(qrow + 8 * g + 4 * hi) = w0; *(u32x2*)(qrow + 32 + 8 * g + 4 * hi) = w1;
    }
    asm volatile("s_waitcnt lgkmcnt(0)" ::: "memory");
    __builtin_amdgcn_s_barrier(); asm volatile("" ::: "memory");
}
}
__device__ __forceinline__ void sb_mfma(const Ctx& C, bf16_t* Q, const bf16_t* Kk, const bf16_t* V) {
    const int bx = (int)blockIdx.x, vcu = (C.G % 8 == 0) ? (bx % 8) * (C.G / 8) + bx / 8 : bx;
    for (int pi = vcu; pi < NBATCH * 16 * 4; pi += C.G) {
        const int bh = pi >> 2, s4 = pi & 3;
        sbm::sb_unit(C.lds, bh >> 4, bh & 15, 7 - s4, Q, Kk, V, C.wave, C.lane);
        sbm::sb_unit(C.lds, bh >> 4, bh & 15, s4, Q, Kk, V, C.wave, C.lane);
    }
    asm volatile("s_waitcnt vmcnt(0)" ::: "memory");
    __syncthreads();
}

constexpr int ROWS_PER_WG = 129;
__device__ __forceinline__ void router_a(const Ctx& C, int c, int layer, const float* ssq, int* cnt_wg) {
    LAS unsigned char* bimg = C.lds;
    LAS int* lcnt = (LAS int*)(C.lds + 32768);
    LAS float* tile = (LAS float*)(C.lds + 33792 + C.wave * 1024);
    const float* Wr = C.in[17] + (size_t)c * D * NE; const float* g = C.in[3] + (size_t)layer * D;
    int tid_ = C.tid; asm volatile("" : "+v"(tid_));
    const int lane_ = tid_ & 63;
    for (int k = tid_; k < D; k += 512) {
        const f32x4 w0 = *(const f32x4*)(Wr + (size_t)k * NE), w1 = *(const f32x4*)(Wr + (size_t)k * NE + 4); const float gk = g[k];
        const int s_ = k >> 5, fq_ = (k >> 3) & 3, j_ = k & 7;
#pragma unroll
        for (int e = 0; e < NE; ++e) {
            const float w = (e < 4 ? w0[e & 3] : w1[e & 3]) * gk;
            const unsigned hi = pk2(w, 0.f) & 0xffffu; const float lo = w - bflo(hi);
            *(LAS unsigned short*)(bimg + ((s_ * 64 + fq_ * 16 + e) * 16) + 2 * j_) = (unsigned short)hi;
            *(LAS unsigned short*)(bimg + ((s_ * 64 + fq_ * 16 + e + 8) * 16) + 2 * j_) = (unsigned short)(pk2(lo, 0.f) & 0xffffu);
        }
    }
    if (tid_ < NE) lcnt[tid_] = 0;
    __syncthreads();
    int2* toke = (int2*)(C.misc + MISC_TOKE); f32x2* tokg = (f32x2*)(C.misc + MISC_TOKG); int2* tokr = (int2*)(C.misc + MISC_TOKR);
    const int r0 = (int)blockIdx.x * ROWS_PER_WG, rend = (r0 + ROWS_PER_WG < MVALID) ? r0 + ROWS_PER_WG : MVALID;
    const int fr = lane_ & 15, fq = lane_ >> 4;
    for (int grp = C.wave; grp < 9; grp += 8) {
        const int rbase = r0 + grp * 16; if (rbase >= rend) break;
        const int row = rbase + fr; const bool valid = row < rend; const int lrow = valid ? row : rbase;
        const float rs = pg8::rstd_of(ssq, lrow);
        const bf16_t* ap = C.H + (size_t)lrow * D + 8 * fq;
        f32x4 acc = {0.f, 0.f, 0.f, 0.f};
#pragma unroll
        for (int s0 = 0; s0 < 32; s0 += 8) {
            bf16x8 af[8], bfr[8];
#pragma unroll
            for (int t = 0; t < 8; ++t) af[t] = *(const bf16x8*)(ap + 32 * (s0 + t));
#pragma unroll
            for (int t = 0; t < 8; ++t) bfr[t] = *(const LAS bf16x8*)(bimg + ((s0 + t) * 64 + lane_) * 16);
#pragma unroll
            for (int t = 0; t < 8; ++t) acc = __builtin_amdgcn_mfma_f32_16x16x32_bf16(af[t], bfr[t], acc, 0, 0, 0);
        }
#pragma unroll
        for (int i = 0; i < 4; ++i) tile[(4 * fq + i) * 16 + fr] = acc[i];
        LDS_WAIT();
        if (lane_ < 16 && valid) {
            const f32x4 t0 = *(const LAS f32x4*)(tile + lane_ * 16), t1 = *(const LAS f32x4*)(tile + lane_ * 16 + 4), t2 = *(const LAS f32x4*)(tile + lane_ * 16 + 8), t3 = *(const LAS f32x4*)(tile + lane_ * 16 + 12);
            const float lg[NE] = {t0[0] + t2[0], t0[1] + t2[1], t0[2] + t2[2], t0[3] + t2[3], t1[0] + t3[0], t1[1] + t3[1], t1[2] + t3[2], t1[3] + t3[3]};
            int e0 = 0; float v0 = lg[0];
#pragma unroll
            for (int e = 1; e < NE; ++e) if (lg[e] > v0) { v0 = lg[e]; e0 = e; }
            int e1 = -1; float v1 = -3.0e38f;
#pragma unroll
            for (int e = 0; e < NE; ++e) if (e != e0 && lg[e] > v1) { v1 = lg[e]; e1 = e; }
            const float g1 = fast_rcp(1.0f + __expf((v0 - v1) * rs)), g0 = 1.0f - g1;
            const int k0 = atomicAdd((int*)&lcnt[e0], 1), k1 = atomicAdd((int*)&lcnt[e1], 1);
            toke[row] = make_int2(e0, e1); tokg[row] = (f32x2){g0, g1}; tokr[row] = make_int2(k0, k1);
        }
        LDS_WAIT();
    }
    __syncthreads();
    if (tid_ < NE) cnt_wg[(int)blockIdx.x * NE + tid_] = lcnt[tid_];
    __syncthreads();
}
__device__ __forceinline__ void router_b(const Ctx& C, const float* ssq, const int* cnt_wg, int* seg_out, int* srow) {
    LAS int* tot = (LAS int*)C.lds;
    LAS int* part = (LAS int*)(C.lds + 1024);
    { const int e = C.tid & 7, sl = C.tid >> 3; int all = 0, before = 0;
#pragma unroll
      for (int j = 0; j < 4; ++j) { const int w = sl * 4 + j; const int v = cnt_wg[w * NE + e]; all += v; before += (w < (int)blockIdx.x) ? v : 0; }
      all += __shfl_xor(all, 8); all += __shfl_xor(all, 16); all += __shfl_xor(all, 32);
      before += __shfl_xor(before, 8); before += __shfl_xor(before, 16); before += __shfl_xor(before, 32);
      if (C.lane < 8) { part[C.wave * 16 + C.lane] = all; part[C.wave * 16 + 8 + C.lane] = before; } }
    __syncthreads();
    if (C.tid < NE) { int all = 0, before = 0;
#pragma unroll
        for (int w = 0; w < 8; ++w) { all += part[w * 16 + C.tid]; before += part[w * 16 + 8 + C.tid]; }
        tot[C.tid] = all; tot[8 + C.tid] = before; }
    __syncthreads();
    if (C.tid == 0) { int s = 0;
        for (int e = 0; e < NE; ++e) { tot[16 + e] = s; s += (tot[e] + 255) & ~255; }
        tot[24] = s;
        if (blockIdx.x == 0) for (int e = 0; e <= NE; ++e) seg_out[e] = tot[16 + e]; }
    __syncthreads();
    const int2* toke = (const int2*)(C.misc + MISC_TOKE); const f32x2* tokg = (const f32x2*)(C.misc + MISC_TOKG); const int2* tokr = (const int2*)(C.misc + MISC_TOKR);
    int2* tokp = (int2*)(C.misc + MISC_TOKP); float* rstds = (float*)(C.misc + MISC_RSTDS); float* gates = (float*)(C.misc + MISC_GATES);
    const int r0 = (int)blockIdx.x * ROWS_PER_WG;
    int tid_ = C.tid; asm volatile("" : "+v"(tid_));
    if (tid_ < ROWS_PER_WG) {
        const int row = r0 + tid_;
        if (row < MVALID) {
            const int2 e = toke[row], k = tokr[row]; const f32x2 g = tokg[row];
            const int p0 = tot[16 + e.x] + tot[8 + e.x] + k.x, p1 = tot[16 + e.y] + tot[8 + e.y] + k.y;
            const float rs = pg8::rstd_of(ssq, row);
            tokp[row] = make_int2(p0, p1); rstds[p0] = rs; rstds[p1] = rs; srow[p0] = row; srow[p1] = row;
            gates[p0] = g.x * (1.0f / (pg8::F8_W2 * pg8::F8_HID)); gates[p1] = g.y * (1.0f / (pg8::F8_W2 * pg8::F8_HID));
        }
    }
    __syncthreads();
}
__device__ __forceinline__ void moe_combine(const Ctx& C, const bf16_t* YS, float* ssq_out) {
    const int2* tokp = (const int2*)(C.misc + MISC_TOKP);
    for (int row = C.gw; row < MVALID; row += C.NGW) {
        const int2 p = tokp[row]; float ss = 0.f;
        u32x4 hvv[2], y0v[2], y1v[2];
#pragma unroll
        for (int q = 0; q < 2; ++q) { const int col = q * 512 + C.lane * 8; hvv[q] = *(const u32x4*)(C.H + (size_t)row * D + col); y0v[q] = __builtin_nontemporal_load((const u32x4*)(YS + (size_t)p.x * D + col)); y1v[q] = __builtin_nontemporal_load((const u32x4*)(YS + (size_t)p.y * D + col)); }
#pragma unroll
        for (int q = 0; q < 2; ++q) {
            const int col = q * 512 + C.lane * 8;
            const u32x4 hv = hvv[q], y0 = y0v[q], y1 = y1v[q];
            u32x4 w;
            w.x = pk2(bflo(hv.x) + bflo(y0.x) + bflo(y1.x), bfhi(hv.x) + bfhi(y0.x) + bfhi(y1.x));
            w.y = pk2(bflo(hv.y) + bflo(y0.y) + bflo(y1.y), bfhi(hv.y) + bfhi(y0.y) + bfhi(y1.y));
            w.z = pk2(bflo(hv.z) + bflo(y0.z) + bflo(y1.z), bfhi(hv.z) + bfhi(y0.z) + bfhi(y1.z));
            w.w = pk2(bflo(hv.w) + bflo(y0.w) + bflo(y1.w), bfhi(hv.w) + bfhi(y0.w) + bfhi(y1.w));
            *(u32x4*)(C.H + (size_t)row * D + col) = w;
            ss += bflo(w.x) * bflo(w.x) + bfhi(w.x) * bfhi(w.x) + bflo(w.y) * bflo(w.y) + bfhi(w.y) * bfhi(w.y) + bflo(w.z) * bflo(w.z) + bfhi(w.z) * bfhi(w.z) + bflo(w.w) * bflo(w.w) + bfhi(w.w) * bfhi(w.w);
        }
        ss = wave_sum(ss);
        pg8::ssq_store_single(ssq_out, row, ss, C.lane);
    }
}
__device__ __forceinline__ void moe_combine_final(const Ctx& C, const bf16_t* YS, const float* g, float* out) {
    const int2* tokp = (const int2*)(C.misc + MISC_TOKP);
    for (int row = C.gw; row < MREAL; row += C.NGW) {
        const int2 p = tokp[row]; float ss = 0.f; float v[16];
#pragma unroll
        for (int q = 0; q < 2; ++q) {
            const int col = q * 512 + C.lane * 8;
            const u32x4 hv = __builtin_nontemporal_load((const u32x4*)(C.H + (size_t)row * D + col)), y0 = __builtin_nontemporal_load((const u32x4*)(YS + (size_t)p.x * D + col)), y1 = __builtin_nontemporal_load((const u32x4*)(YS + (size_t)p.y * D + col));
            v[8 * q + 0] = bflo(hv.x) + bflo(y0.x) + bflo(y1.x); v[8 * q + 1] = bfhi(hv.x) + bfhi(y0.x) + bfhi(y1.x);
            v[8 * q + 2] = bflo(hv.y) + bflo(y0.y) + bflo(y1.y); v[8 * q + 3] = bfhi(hv.y) + bfhi(y0.y) + bfhi(y1.y);
            v[8 * q + 4] = bflo(hv.z) + bflo(y0.z) + bflo(y1.z); v[8 * q + 5] = bfhi(hv.z) + bfhi(y0.z) + bfhi(y1.z);
            v[8 * q + 6] = bflo(hv.w) + bflo(y0.w) + bflo(y1.w); v[8 * q + 7] = bfhi(hv.w) + bfhi(y0.w) + bfhi(y1.w);
#pragma unroll
            for (int j = 0; j < 8; ++j) ss += v[8 * q + j] * v[8 * q + j];
        }
        ss = wave_sum(ss);
        const float rs = __builtin_amdgcn_rsqf(ss * (1.0f / D) + EPS);
#pragma unroll
        for (int q = 0; q < 2; ++q) {
            const int col = q * 512 + C.lane * 8;
            const f32x4 g0 = *(const f32x4*)(g + col), g1 = *(const f32x4*)(g + col + 4);
            const f32x4 o0 = {v[8 * q] * rs * g0[0], v[8 * q + 1] * rs * g0[1], v[8 * q + 2] * rs * g0[2], v[8 * q + 3] * rs * g0[3]};
            const f32x4 o1 = {v[8 * q + 4] * rs * g1[0], v[8 * q + 5] * rs * g1[1], v[8 * q + 6] * rs * g1[2], v[8 * q + 7] * rs * g1[3]};
            __builtin_nontemporal_store(o0, (f32x4*)(out + (size_t)row * D + col)); __builtin_nontemporal_store(o1, (f32x4*)(out + (size_t)row * D + col + 4));
        }
    }
}
constexpr int PP_RUN = 9;
template <int Q> __device__ __forceinline__ void pool_half(const bf16_t* H, const float* gain, bf16_t* Dm, int b, int p0, int n, float rs_l, int lane) {
    constexpr int WMAX = Q ? 16 : 4, J0 = 16 - WMAX;
    const int col = Q * 512 + lane * 8; const bool wide = (lane & 32) != 0;
    const int w = wide ? WMAX : WMAX / 2;
    constexpr int NR = 15 + PP_RUN; u32x4 t[NR];
#define PP_RS(j) __builtin_bit_cast(float, __builtin_amdgcn_readlane(__builtin_bit_cast(int, rs_l), (j)))
#pragma unroll
    for (int j = J0; j < NR; ++j) { const int pj = p0 - 15 + j; const bool ok = pj >= 0 && j < 15 + n;
        t[j] = *(const u32x4*)(H + (size_t)(ok ? pos_row(b, pj) : 0) * D + col); }
    const f32x4 g0 = *(const f32x4*)(gain + col), g1 = *(const f32x4*)(gain + col + 4);
    float S[8];
#pragma unroll
    for (int c = 0; c < 8; ++c) S[c] = 0.f;
#define PP_ACC(sign, tv, rv) do { const float _r = (rv); S[0] += sign bflo((tv).x) * _r; S[1] += sign bfhi((tv).x) * _r; S[2] += sign bflo((tv).y) * _r; S[3] += sign bfhi((tv).y) * _r; \
        S[4] += sign bflo((tv).z) * _r; S[5] += sign bfhi((tv).z) * _r; S[6] += sign bflo((tv).w) * _r; S[7] += sign bfhi((tv).w) * _r; } while (0)
#pragma unroll
    for (int j = J0; j < 15; ++j) { const float r = (j >= 16 - WMAX / 2 || wide) ? PP_RS(j) : 0.f; PP_ACC(+, t[j], r); }
#pragma unroll
    for (int i = 0; i < PP_RUN; ++i) if (i < n) {
        const int p = p0 + i; const int cnt = (p + 1 < w) ? p + 1 : w; const float ic = 1.0f / (float)cnt;
        const u32x4 tv = t[15 + i]; const float r = PP_RS(15 + i);
        PP_ACC(+, tv, r);
        const float s0 = bflo(tv.x) * r, s1 = bfhi(tv.x) * r, s2 = bflo(tv.y) * r, s3 = bfhi(tv.y) * r, s4 = bflo(tv.z) * r, s5 = bfhi(tv.z) * r, s6 = bflo(tv.w) * r, s7 = bfhi(tv.w) * r;
        u32x4 o;
        o.x = pk2((S[0] * ic - s0) * g0[0], (S[1] * ic - s1) * g0[1]); o.y = pk2((S[2] * ic - s2) * g0[2], (S[3] * ic - s3) * g0[3]);
        o.z = pk2((S[4] * ic - s4) * g1[0], (S[5] * ic - s5) * g1[1]); o.w = pk2((S[6] * ic - s6) * g1[2], (S[7] * ic - s7) * g1[3]);
        *(u32x4*)(Dm + (size_t)pos_row(b, p) * D + col) = o;
        u32x4 la = t[16 + i - WMAX], lb = t[16 + i - WMAX / 2]; asm volatile("" : "+v"(la), "+v"(lb));
        const u32x4 lv = wide ? la : lb; const float lr = wide ? PP_RS(16 + i - WMAX) : PP_RS(16 + i - WMAX / 2);
        PP_ACC(-, lv, lr);
    }
#undef PP_ACC
#undef PP_RS
}
__device__ __forceinline__ void pool_prep(const Ctx& C, const float* ssq, const float* gain, bf16_t* Dm) {
    constexpr int RUN = PP_RUN, RPB = (SEQ + RUN - 1) / RUN, NT = NBATCH * RPB + 2;
    int lane = C.lane; asm volatile("" : "+v"(lane));
    for (int task = C.gw; task < NT; task += C.NGW) {
        int b = 0, p0, n;
        if (task < NT - 2) { b = task / RPB; const int k = task - b * RPB; p0 = NMETA + k * RUN; n = (SEQ - k * RUN < RUN) ? SEQ - k * RUN : RUN; }
        else { p0 = (task - (NT - 2)) * RUN; n = (NMETA - p0 < RUN) ? NMETA - p0 : RUN; }
        float rs_l = 0.f;
        { const int j = lane & 31, pj = p0 - 15 + j; if (pj >= 0 && j < 15 + n) rs_l = pg8::rstd_of(ssq, pos_row(b, pj)); }
        pool_half<1>(C.H, gain, Dm, b, p0, n, rs_l, lane);
        pool_half<0>(C.H, gain, Dm, b, p0, n, rs_l, lane);
    }
    if (C.gw >= C.NGW - 240) {
        const u32x4 z = {0u, 0u, 0u, 0u}; const int row = MVALID + (C.gw - (C.NGW - 240));
        *(u32x4*)(Dm + (size_t)row * D + lane * 8) = z; *(u32x4*)(Dm + (size_t)row * D + 512 + lane * 8) = z;
    }
}

__global__ void __launch_bounds__(512, 2) fwd_kernel(Args args) {
    extern __shared__ __attribute__((aligned(16))) unsigned char lds_raw[];
    Ctx C;
    C.lds = (LAS unsigned char*)lds_raw;
    C.tid = threadIdx.x; C.lane = C.tid & 63; C.wave = __builtin_amdgcn_readfirstlane(C.tid >> 6);
    C.G = gridDim.x; C.gw = (int)blockIdx.x * 8 + C.wave; C.NGW = C.G * 8;
    C.in = args.in; C.out = args.out; C.ws = args.ws;
    C.H = (bf16_t*)(args.ws + WS_H); C.ssq = (float*)(args.ws + WS_SSQ); C.gst = (float*)(args.ws + WS_GST);
    C.WA = (bf16_t*)(args.ws + WS_WA); C.WB = (bf16_t*)(args.ws + WS_WB); C.pool = args.ws + WS_POOL; C.misc = args.ws + WS_MISC; C.tab = (f32x2*)(args.ws + WS_TAB);
    C.moe = (int*)(args.ws + WS_CTL + CTL_MOE);
    for (int u = C.tid; u < (LDS_BYTES - LDSCTL_OFF) / 4; u += 512) ((LAS unsigned*)(C.lds + LDSCTL_OFF))[u] = 0u;
    __syncthreads();
    unsigned* barw = (unsigned*)(args.ws + WS_CTL) + CW_BAR;
    XcdBarrier bar; bar.bar = barw; bar.x = 0; bar.st = nullptr;
    if (!MK_PER_PHASE) bar = xcd_barrier_post(barw, (volatile LAS unsigned*)(C.lds + LDSCTL_OFF + 32));
    const int lo = args.ph_lo, hi = args.ph_hi;
#define IN(k) (lo <= (k) && (k) < hi)
#if PROBE_GROUP
    unsigned long long pr_last = __builtin_amdgcn_s_memrealtime(); const unsigned long long pr_t0 = pr_last; unsigned long long pr_acc = 0ull;
    constexpr unsigned long long PR_MASK =
        PROBE_GROUP == 1 ? (1ull << P_PRO) :
        PROBE_GROUP == 2 ? ((1ull << P0_QKVG) | (1ull << P0_WO) | (1ull << P0_W13) | (1ull << P0_W2) | (1ull << P1_QKV) | (1ull << P1_WO) | (1ull << P1_M13) | (1ull << P1_M2) | (1ull << P2_POOL) | (1ull << P2_W13) | (1ull << P2_W2) | (1ull << P3_QKVG) | (1ull << P3_WO) | (1ull << P3_M13) | (1ull << P3_M2)) :
        PROBE_GROUP == 3 ? (1ull << P1_SB) :
        PROBE_GROUP == 4 ? ((1ull << P0_RET) | (1ull << P3_RET)) :
        PROBE_GROUP == 5 ? ((1ull << P0_FIN) | (1ull << P3_FIN) | (1ull << P1_RA) | (1ull << P1_RB) | (1ull << P1_CMB) | (1ull << P3_RA) | (1ull << P3_RB) | (1ull << P3_CMB) | (1ull << P2_PREP)) :
        PROBE_GROUP == 6 ? ((1ull << P1_M13) | (1ull << P3_M13)) :
        PROBE_GROUP == 7 ? ((1ull << P1_M2) | (1ull << P3_M2)) :
        PROBE_GROUP == 8 ? ((1ull << P0_QKVG) | (1ull << P3_QKVG)) :
        PROBE_GROUP == 12 ? ((1ull << P0_FIN) | (1ull << P3_FIN)) :
        PROBE_GROUP == 13 ? ((1ull << P1_RA) | (1ull << P3_RA)) :
        PROBE_GROUP == 14 ? ((1ull << P1_RB) | (1ull << P3_RB)) :
        PROBE_GROUP == 15 ? ((1ull << P1_CMB) | (1ull << P3_CMB)) :
        PROBE_GROUP == 16 ? ((1ull << P2_PREP) | (1ull << P2_POOL)) :
        PROBE_GROUP == 30 ? (1ull << P1_RA) : PROBE_GROUP == 31 ? (1ull << P1_RB) : PROBE_GROUP == 32 ? (1ull << P1_CMB) : PROBE_GROUP == 33 ? (1ull << P3_RA) : PROBE_GROUP == 34 ? (1ull << P3_RB) : PROBE_GROUP == 35 ? (1ull << P3_CMB) :
        PROBE_GROUP == 36 ? (1ull << P2_PREP) : PROBE_GROUP == 37 ? (1ull << P2_POOL) : PROBE_GROUP == 38 ? (1ull << P1_M13) : PROBE_GROUP == 39 ? (1ull << P1_M2) : PROBE_GROUP == 40 ? (1ull << P0_QKVG) : PROBE_GROUP == 41 ? (1ull << P0_W13) :
        PROBE_GROUP == 42 ? (1ull << P0_WO) : PROBE_GROUP == 43 ? (1ull << P0_W2) : PROBE_GROUP == 44 ? (1ull << P3_QKVG) : PROBE_GROUP == 45 ? (1ull << P2_W13) : PROBE_GROUP == 46 ? (1ull << P0_RET) : PROBE_GROUP == 47 ? (1ull << P3_RET) :
        PROBE_GROUP == 48 ? (1ull << P1_QKV) : PROBE_GROUP == 49 ? (1ull << P1_WO) : PROBE_GROUP == 50 ? (1ull << P2_W2) : PROBE_GROUP == 51 ? (1ull << P3_WO) : PROBE_GROUP == 52 ? (1ull << P3_M13) : PROBE_GROUP == 53 ? (1ull << P3_M2) : 0ull;
#define PR_STAMP(k) do { const unsigned long long _t = __builtin_amdgcn_s_memrealtime(); if ((PR_MASK >> (k)) & 1ull) pr_acc += _t - pr_last; pr_last = _t; } while (0)
#else
#define PR_STAMP(k) do { } while (0)
#endif
#define SEAM(k) do { if (!MK_PER_PHASE && (k) + 1 < hi) xcd_barrier(bar); PR_STAMP(k); } while (0)

    bf16_t* const PQ = (bf16_t*)(C.pool + PO_Q); bf16_t* const PK = (bf16_t*)(C.pool + PO_K); bf16_t* const PV = (bf16_t*)(C.pool + PO_V); bf16_t* const PG = (bf16_t*)(C.pool + PO_G);
    bf16_t* const HID = (bf16_t*)(C.pool + PO_HID); bf16_t* const XS = (bf16_t*)(C.pool + PO_XS); bf16_t* const MHID = (bf16_t*)(C.pool + PO_MHID);
    bf16_t* const YM = (bf16_t*)(C.misc + MISC_YM);
    float* const rstds = (float*)(C.misc + MISC_RSTDS); float* const gates = (float*)(C.misc + MISC_GATES);
#define SSQ(i) (C.ssq + (size_t)(i) * MROWS * 16)
    unsigned char* const H8P = (unsigned char*)(C.pool + 100 * MiB);
    unsigned char* const H8L3 = (unsigned char*)(C.pool + 387 * MiB);
    unsigned char* const H8M = (unsigned char*)(C.pool + 320 * MiB);
    int* const srow = (int*)(args.ws + WS_CTL + CTL_SROW);
    unsigned char* const A28 = (unsigned char*)(C.pool + 420 * MiB);

    if (IN(P_PRO)) {
        conv_ret(C, 0, 0, C.WB + WB_MIX, C.WB + WB_WO);
        conv_dense_bf16(C, 0, 0, C.WB + WB_W13, C.WB + WB_W2);
        { LAS float* scr = (LAS float*)(C.lds + C.wave * 16384);
          wt_matrix<0>(C.in[10], D, 3 * D, 3 * D, C.WA + WA_MIX, C.in[2] + 1 * D, scr, C.gw, C.NGW, C.lane);
          wt_matrix<0>(C.in[11], D, D, D, C.WA + WA_MIX_WO_SB, nullptr, scr, C.gw, C.NGW, C.lane); }
        conv_moe(C, 0, 1, C.WA + WA_MOE13, C.WA + WA_MOE2);
        for (int row = C.gw; row < MROWS; row += C.NGW) {
            float ss = 0.f;
            if (row < MVALID) {
                const float* src = row < MREAL ? C.in[0] + (size_t)row * D : C.in[1] + (size_t)(row - MREAL) * D;
#pragma unroll
                for (int q = 0; q < 2; ++q) { const int col = q * 512 + C.lane * 8; const f32x4 a = __builtin_nontemporal_load((const f32x4*)(src + col)), b2 = __builtin_nontemporal_load((const f32x4*)(src + col + 4));
                    u32x4 w; w.x = pk2(a[0], a[1]); w.y = pk2(a[2], a[3]); w.z = pk2(b2[0], b2[1]); w.w = pk2(b2[2], b2[3]);
                    *(u32x4*)(C.H + (size_t)row * D + col) = w;
                    ss += bflo(w.x) * bflo(w.x) + bfhi(w.x) * bfhi(w.x) + bflo(w.y) * bflo(w.y) + bfhi(w.y) * bfhi(w.y) + bflo(w.z) * bflo(w.z) + bfhi(w.z) * bfhi(w.z) + bflo(w.w) * bflo(w.w) + bfhi(w.w) * bfhi(w.w); }
                ss = wave_sum(ss);
            } else { const u32x4 z = {0u, 0u, 0u, 0u}; *(u32x4*)(C.H + (size_t)row * D + C.lane * 8) = z; *(u32x4*)(C.H + (size_t)row * D + 512 + C.lane * 8) = z; }
            pg8::ssq_store_single(SSQ(0), row, ss, C.lane);
        }
        SEAM(P_PRO);
    }
#define ZERO_ROWS() do { if (blockIdx.x == 0) { const u32x4 z = {0u, 0u, 0u, 0u}; if (C.tid < 128) { *(u32x4*)(PQ + (size_t)MVALID * D + C.tid * 8) = z; *(u32x4*)(PK + (size_t)MVALID * D + C.tid * 8) = z; } \
        if (C.tid < 256) *(u32x4*)(PV + (size_t)MVALID * 2048 + C.tid * 8) = z; } } while (0)
    if (IN(P0_QKVG)) { ZERO_ROWS(); pg8::EpiProj<0> E{SSQ(0), C.tab, PQ, PK, PV, PG, 1.0f}; run_dense(C, C.H, D, 0, C.WB + WB_MIX, D, 6144, E); SEAM(P0_QKVG); }
    if (IN(P0_RET)) { ret_mfma5<false>(C, PQ, PK, PV, PG, nullptr, C.in[9]); SEAM(P0_RET); }
    if (IN(P0_FIN)) { PR_STAMP(P0_FIN); }
    if (IN(P0_WO)) { pg8::EpiResid E{C.H, SSQ(1), nullptr, nullptr, 1.0f}; run_dense(C, PG, 2048, 0, C.WB + WB_WO, 2048, 1024, E); SEAM(P0_WO); }
    if (IN(P0_W13)) { pg8::EpiSwiglu<false> E{SSQ(1), HID}; run_dense(C, C.H, D, 0, C.WB + WB_W13, D, 5632, E); SEAM(P0_W13); }
    if (IN(P0_W2)) { pg8::EpiResid E{C.H, SSQ(2), nullptr, nullptr, 1.0f}; run_dense(C, HID, FF, 0, C.WB + WB_W2, FF, 1024, E); SEAM(P0_W2); }
    if (IN(P1_QKV)) { pg8::EpiProj<1> E{SSQ(2), C.tab, PQ, PK, PV, PG, 1.0f}; run_dense(C, C.H, D, 0, C.WA + WA_MIX, D, 3072, E); SEAM(P1_QKV); }
    if (IN(P1_SB)) { if (NAIVE_SB) sb_naive(C, PQ, PK, PV); else { sb_meta(C, PQ, PK, PV); sb_mfma(C, PQ, PK, PV); } SEAM(P1_SB); }
    if (IN(P1_WO)) { pg8::EpiResid E{C.H, SSQ(3), nullptr, H8M, 1.0f}; run_dense(C, PQ, D, 0, C.WA + WA_MIX_WO_SB, D, 1024, E); SEAM(P1_WO); }
    if (IN(P1_RA)) {
        router_a(C, 0, 1, SSQ(3), C.moe);
        { LAS float* scr = (LAS float*)(C.lds + C.wave * 16384);
          for (int g = 0; g < 4; ++g) wt_matrix<0>(C.in[12] + (size_t)g * 256 * 256, 256, 256, 256, C.WB + WB_MIX + (size_t)g * 256 * 256, nullptr, scr, C.gw, C.NGW, C.lane); }
        conv_dense(C, 1, 2, C.WB + WB_W13, C.WB + WB_W2);
        SEAM(P1_RA);
    }
    if (IN(P1_RB)) { router_b(C, SSQ(3), C.moe, C.moe + 2 * 256 * NE, srow); SEAM(P1_RB); }
    if (IN(P1_M13)) { pg8::EpiSwigluF8<true> E{rstds, (unsigned char*)MHID}; run_moe8(C, C.moe + 2 * 256 * NE, H8M, (const unsigned char*)(C.WA + WA_MOE13), (size_t)5632 * D, D, 5632, E, srow); SEAM(P1_M13); }
    if (IN(P1_M2)) { pg8::EpiMoeW2 E{gates, XS}; run_moe8(C, C.moe + 2 * 256 * NE, (const unsigned char*)MHID, (const unsigned char*)(C.WA + WA_MOE2), (size_t)D * FF, FF, 1024, E); SEAM(P1_M2); }
    if (IN(P1_CMB)) {
        moe_combine(C, XS, SSQ(4));
        conv_ret8(C, 1, 3, C.WA + WA_MIX, C.WA + WA_MIX_WO_RET);
        conv_moe(C, 1, 3, C.WA + WA_MOE13, C.WA + WA_MOE2);
        SEAM(P1_CMB);
    }
    if (IN(P2_PREP)) { pool_prep(C, SSQ(4), C.in[2] + 2 * D, PQ); SEAM(P2_PREP); }
    if (IN(P2_POOL)) { pg8::EpiResid E{C.H, SSQ(5), C.in[13], H8P, 1.0f}; run_dense(C, PQ, D, 512, C.WB + WB_MIX, 256, 1024, E); SEAM(P2_POOL); }
    if (IN(P2_W13)) { pg8::EpiSwigluF8<false> E{SSQ(5), (unsigned char*)HID}; run_dense8(C, H8P, D, (const unsigned char*)(C.WB + WB_W13), D, 5632, E); SEAM(P2_W13); }
    if (IN(P2_W2)) { pg8::EpiResid E{C.H, SSQ(6), nullptr, H8L3, 1.0f / (pg8::F8_W2 * pg8::F8_HID)}; run_dense8(C, (const unsigned char*)HID, FF, (const unsigned char*)(C.WB + WB_W2), FF, 1024, E); SEAM(P2_W2); }
    if (IN(P3_QKVG)) { ZERO_ROWS(); pg8::EpiProj<0> E{SSQ(6), C.tab, PQ, PK, PV, PG, 1.0f / F8_WP}; run_dense8(C, H8L3, D, (const unsigned char*)(C.WA + WA_MIX), D, 6144, E); SEAM(P3_QKVG); }
    if (IN(P3_RET)) { ret_mfma5<true>(C, PQ, PK, PV, PG, A28, C.in[9] + 2 * D); SEAM(P3_RET); }
    if (IN(P3_FIN)) { PR_STAMP(P3_FIN); }
    if (IN(P3_WO)) { pg8::EpiResid E{C.H, SSQ(7), nullptr, H8M, 1.0f / (F8_WO * F8_A2)}; run_dense8(C, A28, 2048, (const unsigned char*)(C.WA + WA_MIX_WO_RET), 2048, 1024, E); SEAM(P3_WO); }
    if (IN(P3_RA)) { router_a(C, 1, 3, SSQ(7), C.moe + 256 * NE); SEAM(P3_RA); }
    if (IN(P3_RB)) { router_b(C, SSQ(7), C.moe + 256 * NE, C.moe + 2 * 256 * NE + 16, srow); SEAM(P3_RB); }
    if (IN(P3_M13)) { pg8::EpiSwigluF8<true> E{rstds, (unsigned char*)MHID}; run_moe8(C, C.moe + 2 * 256 * NE + 16, H8M, (const unsigned char*)(C.WA + WA_MOE13), (size_t)5632 * D, D, 5632, E, srow); SEAM(P3_M13); }
    if (IN(P3_M2)) { pg8::EpiMoeW2 E{gates, XS}; run_moe8(C, C.moe + 2 * 256 * NE + 16, (const unsigned char*)MHID, (const unsigned char*)(C.WA + WA_MOE2), (size_t)D * FF, FF, 1024, E); SEAM(P3_M2); }
    if (IN(P3_CMB)) { moe_combine_final(C, XS, C.in[21], C.out); PR_STAMP(P3_CMB); }
    if (IN(P_FINAL)) {
#if PROBE_GROUP
        __syncthreads();
        if (blockIdx.x == 0 && C.tid == 0) { const unsigned long long tot = __builtin_amdgcn_s_memrealtime() - pr_t0; asm volatile("s_waitcnt vmcnt(0)" ::: "memory");
            if ((PROBE_GROUP >= 9 && PROBE_GROUP <= 11) || PROBE_GROUP == 60 || PROBE_GROUP == 61 || (PROBE_GROUP >= 70 && PROBE_GROUP <= 79)) pr_acc = *(LAS unsigned long long*)(C.lds + LDSCTL_OFF + 8192);
            C.out[0] = 4.0f + __builtin_rintf(PROBE_GAIN * (float)pr_acc / (float)tot); }
#endif
    }
#undef IN
#undef SEAM
#undef SSQ
}

extern "C" void kernel_launch(void* const* d_in, const int* in_sizes, int n_in, void* d_out, int out_size, void* d_ws, size_t ws_size, hipStream_t stream) {
    static int grid = 0;
    if (grid == 0) {
        if (n_in != 22 || out_size != MREAL * D || ws_size < WS_END) { fprintf(stderr, "kernel_launch: unexpected shapes (n_in %d out %d ws %zu)\n", n_in, out_size, ws_size); grid = -1; return; }
        int dev = 0, cus = 0;
        if (hipGetDevice(&dev) != hipSuccess || hipDeviceGetAttribute(&cus, hipDeviceAttributeMultiprocessorCount, dev) != hipSuccess) { grid = -1; return; }
        if (hipFuncSetAttribute((const void*)fwd_kernel, hipFuncAttributeMaxDynamicSharedMemorySize, LDS_BYTES) != hipSuccess) { grid = -1; return; }
        int per_cu = 0;
        if (hipOccupancyMaxActiveBlocksPerMultiprocessor(&per_cu, (const void*)fwd_kernel, 512, LDS_BYTES) != hipSuccess || per_cu < 1) { fprintf(stderr, "kernel_launch: occupancy query says %d\n", per_cu); }
        (void)hipGetLastError();
        grid = cus;
    }
    if (grid < 0) return;
    (void)hipMemsetAsync((char*)d_ws + WS_CTL, 0, CTL_BYTES, stream);
    Args a{};
    for (int i = 0; i < 22; ++i) a.in[i] = (const float*)d_in[i];
    a.out = (float*)d_out; a.ws = (unsigned char*)d_ws;
#if MK_PER_PHASE
    for (int k = 0; k < P_COUNT; ++k) { a.ph_lo = k; a.ph_hi = k + 1; hipLaunchKernelGGL(fwd_kernel, dim3(grid), dim3(512), LDS_BYTES, stream, a); }
#else
    a.ph_lo = 0; a.ph_hi = P_COUNT;
    hipLaunchKernelGGL(fwd_kernel, dim3(grid), dim3(512), LDS_BYTES, stream, a);
#endif
}
```
